# Optimizing an MI355X kernel written in HIP

```python
import math
import jax, jax.numpy as jnp
from jax import lax
import numpy as np

D_MODEL = 2048
BATCH = 4
SEQ = 2048
DEPTH = 4
DEC_BATCH = 128
DEC_SEQ = 4
PAST_LEN = 16384
PAGE_SIZE = 128

N_EVEN = (DEPTH + 1) // 2
N_ODD = DEPTH // 2
D_FF = 5632
RW_WIDTH = D_MODEL // 2
RW_HEAD = 64
RW_HEADS = RW_WIDTH // RW_HEAD
D_DECAY_LORA = 96
D_AAA_LORA = 96
D_GATE_LORA = 256
P_RW = 3 * RW_WIDTH + D_DECAY_LORA + D_AAA_LORA + D_GATE_LORA
RW_GN_EPS = 64e-5
HG_WIDTH = D_MODEL // 2
HG_EXPAND = 128
HG_HEADS = HG_WIDTH // HG_EXPAND
HG_VDIM = HG_WIDTH // HG_HEADS
HG_KEY_WIDTH = HG_HEADS * HG_EXPAND
P_HG = 2 * HG_KEY_WIDTH + 2 * HG_WIDTH
P_EVEN = P_RW + P_HG
HG_CHUNK = 64
HG_NORM_EPS = 1e-5
LRU_WIDTH = D_MODEL
LRU_BLOCKS = 8
LRU_BLOCK = LRU_WIDTH // LRU_BLOCKS
CONV_W = 4
LRU_C = 8.0
NORM_EPS = 1e-6

kernel_name = "rwkv7_hgrn2_rglru_macaron_step"


def rmsnorm(x, g, eps=NORM_EPS):
    xf = x.astype(jnp.float32)
    y = xf * lax.rsqrt(jnp.mean(xf * xf, axis=-1, keepdims=True) + eps)
    return (y * g.astype(jnp.float32)).astype(x.dtype)


def swiglu_half(x, norm_g, w_gu, w_down):
    h = rmsnorm(x, norm_g) @ w_gu
    gate, up = jnp.split(h, 2, axis=-1)
    return (jax.nn.silu(gate) * up) @ w_down


def rwkv7_scan(S0, r, w, k, v, kk, b):
    def step(S, inp):
        r_t, w_t, k_t, v_t, kk_t, b_t = inp
        sa = jnp.einsum('bhvk,bhk->bhv', S, -kk_t)
        S = (S * w_t[:, :, None, :] + sa[..., None] * b_t[:, :, None, :]
             + v_t[..., None] * k_t[:, :, None, :])
        return S, jnp.einsum('bhvk,bhk->bhv', S, r_t)
    xs = tuple(jnp.moveaxis(a, 1, 0) for a in (r, w, k, v, kk, b))
    S, o = lax.scan(step, S0, xs)
    return jnp.moveaxis(o, 0, 1), S


def hgrn2_chunked(S0, q, k, v, logf):
    B, T, H, _ = q.shape
    c = math.gcd(T, HG_CHUNK)
    n = T // c

    def to_chunks(a):
        return a.reshape(B, n, c, H, a.shape[-1]).transpose(1, 0, 3, 2, 4)

    mask = jnp.tril(jnp.ones((c, c), dtype=bool))

    def step(S, inp):
        qc, kc, vc, gc = inp
        G = jnp.cumsum(gc, axis=2)
        diff = G[:, :, :, None, :] - G[:, :, None, :, :]
        decay = jnp.exp(jnp.where(mask[:, :, None], diff, -jnp.inf))
        A = jnp.einsum('bhtk,bhsk,bhtsk->bhts', qc, kc, decay)
        o = (jnp.einsum('bhts,bhsv->bhtv', A, vc)
             + jnp.einsum('bhtk,bhkv->bhtv', qc * jnp.exp(G), S))
        G_last = G[:, :, -1:, :]
        S = (jnp.exp(G_last[:, :, 0, :])[..., None] * S
             + jnp.einsum('bhsk,bhsv->bhkv', kc * jnp.exp(G_last - G), vc))
        return S, o

    S, o = lax.scan(step, S0, tuple(to_chunks(a) for a in (q, k, v, logf)))
    o = o.transpose(1, 0, 3, 2, 4).reshape(B, T, H, -1)
    return o, S


def rglru_scan(h0, a, b):
    def comb(x, y):
        a1, b1 = x
        a2, b2 = y
        return a1 * a2, a2 * b1 + b2
    A, Bc = lax.associative_scan(comb, (a, b), axis=1)
    h = A * h0[:, None, :] + Bc
    return h, h[:, -1]


def even_mixer(xn, shift, S_rw, S_hg, p, e):
    f32 = jnp.float32
    B, T, _ = xn.shape
    dt = xn.dtype
    proj = xn @ p['ev_w_in'][e]
    p_rw, p_hg = proj[..., :P_RW], proj[..., P_RW:]
    prev = jnp.concatenate([shift[:, None].astype(dt), p_rw[:, :-1]], axis=1)
    z = p_rw + (prev - p_rw) * p['rw_mu'][e]
    new_shift = p_rw[:, -1]
    idx = [RW_WIDTH, 2 * RW_WIDTH, 3 * RW_WIDTH, 3 * RW_WIDTH + D_DECAY_LORA,
           3 * RW_WIDTH + D_DECAY_LORA + D_AAA_LORA]
    r, k, v, zw, za, zg = jnp.split(z, idx, axis=-1)
    w_log = -jax.nn.softplus(-(p['rw_w0'][e] + jnp.tanh(zw) @ p['rw_w2'][e])) - 0.5
    decay = jnp.exp(-jnp.exp(w_log.astype(f32)))
    a = jax.nn.sigmoid(p['rw_a0'][e] + za @ p['rw_a2'][e])
    g = jax.nn.sigmoid(zg) @ p['rw_g2'][e]

    def heads(t):
        return t.reshape(B, T, RW_HEADS, RW_HEAD).astype(f32)

    r_h, k_h, v_h, a_h, w_h = heads(r), heads(k), heads(v), heads(a), heads(decay)
    kk = k_h * p['rw_k_k'][e].reshape(RW_HEADS, RW_HEAD).astype(f32)
    kk = kk / jnp.maximum(jnp.sqrt(jnp.sum(kk * kk, axis=-1, keepdims=True)), 1e-12)
    k_h = k_h * (1.0 + (a_h - 1.0) * p['rw_k_a'][e].reshape(RW_HEADS, RW_HEAD).astype(f32))
    o, S_rw_new = rwkv7_scan(S_rw.astype(f32), r_h, w_h, k_h, v_h, kk, kk * a_h)
    mu = jnp.mean(o, axis=-1, keepdims=True)
    var = jnp.mean(jnp.square(o - mu), axis=-1, keepdims=True)
    o = ((o - mu) * lax.rsqrt(var + RW_GN_EPS)
         * p['rw_ln_w'][e].reshape(RW_HEADS, RW_HEAD).astype(f32)
         + p['rw_ln_b'][e].reshape(RW_HEADS, RW_HEAD).astype(f32))
    bonus = jnp.sum(r_h * k_h * p['rw_r_k'][e].astype(f32), axis=-1, keepdims=True)
    o = o + bonus * v_h
    o_rw = o.reshape(B, T, RW_WIDTH).astype(dt) * g
    q, f, i, og = jnp.split(p_hg, [HG_KEY_WIDTH, 2 * HG_KEY_WIDTH, 2 * HG_KEY_WIDTH + HG_WIDTH], axis=-1)
    lbs = jnp.cumsum(jax.nn.softmax(p['hg_lb'].astype(f32), axis=0), axis=0)
    lb = (lbs - lbs[0])[e]
    logf = jnp.logaddexp(jnp.log(lb), jnp.log1p(-lb) + jax.nn.log_sigmoid(f.astype(f32)))
    k_hg = -jnp.expm1(logf)
    qh = jax.nn.silu(q.astype(f32)).reshape(B, T, HG_HEADS, HG_EXPAND)
    o_hg, S_hg_new = hgrn2_chunked(
        S_hg.astype(f32), qh, k_hg.reshape(B, T, HG_HEADS, HG_EXPAND),
        i.astype(f32).reshape(B, T, HG_HEADS, HG_VDIM), logf.reshape(B, T, HG_HEADS, HG_EXPAND))
    o_hg = (o_hg * lax.rsqrt(jnp.mean(o_hg * o_hg, axis=-1, keepdims=True) + HG_NORM_EPS)
            * p['hg_norm'][e].reshape(HG_HEADS, HG_VDIM).astype(f32))
    o_hg = o_hg.reshape(B, T, HG_WIDTH).astype(dt) * jax.nn.silu(og)
    y = jnp.concatenate([o_rw, o_hg], axis=-1) @ p['ev_w_out'][e]
    return y, new_shift, S_rw_new, S_hg_new


def odd_mixer(xn, conv_buf, h0, p, o_i):
    f32 = jnp.float32
    B, T, _ = xn.shape
    dt = xn.dtype
    proj = xn @ p['od_w_in'][o_i]
    gate, xb = jnp.split(proj, 2, axis=-1)
    xc = jnp.concatenate([conv_buf.astype(dt), xb], axis=1)
    w = p['conv_w'][o_i]
    xconv = p['conv_b'][o_i] + sum(xc[:, j:j + T] * w[j] for j in range(CONV_W))
    new_buf = xc[:, -(CONV_W - 1):]
    blocks = xconv.reshape(B, T, LRU_BLOCKS, LRU_BLOCK)
    ga = jnp.einsum('btnj,njk->btnk', blocks, p['lru_wa'][o_i]).reshape(B, T, LRU_WIDTH) + p['lru_ba'][o_i]
    gx = jnp.einsum('btnj,njk->btnk', blocks, p['lru_wx'][o_i]).reshape(B, T, LRU_WIDTH) + p['lru_bx'][o_i]
    log_a = (-LRU_C * jax.nn.sigmoid(ga.astype(f32))
             * jax.nn.softplus(-p['lru_lambda'][o_i].astype(f32)))
    a = jnp.exp(log_a)
    mult = jnp.sqrt(-jnp.expm1(2.0 * log_a))
    b = mult * jax.nn.sigmoid(gx.astype(f32)) * xconv.astype(f32)
    h, h_last = rglru_scan(h0.astype(f32), a, b)
    y = (h.astype(dt) * jax.nn.gelu(gate)) @ p['od_w_out'][o_i]
    return y, new_buf, h_last


def trunk(x, shift, S_rw, S_hg, conv_buf, h_lru, p):
    shifts, rws, hgs, convs, lrus = [], [], [], [], []
    for l in range(DEPTH):
        x = x + 0.5 * swiglu_half(x, p['ffn1_norm'][l], p['ffn1_w_gu'][l], p['ffn1_w_down'][l])
        xn = rmsnorm(x, p['mix_norm'][l])
        if l % 2 == 0:
            e = l // 2
            y, s_new, rw_new, hg_new = even_mixer(xn, shift[:, e], S_rw[:, e], S_hg[:, e], p, e)
            shifts.append(s_new)
            rws.append(rw_new)
            hgs.append(hg_new)
        else:
            o_i = l // 2
            y, c_new, h_new = odd_mixer(xn, conv_buf[:, o_i], h_lru[:, o_i], p, o_i)
            convs.append(c_new)
            lrus.append(h_new)
        x = x + y
        x = x + 0.5 * swiglu_half(x, p['ffn2_norm'][l], p['ffn2_w_gu'][l], p['ffn2_w_down'][l])
    y = rmsnorm(x, p['final_norm'])
    return (y,
            jnp.stack(shifts, axis=1).astype(shift.dtype),
            jnp.stack(rws, axis=1).astype(S_rw.dtype),
            jnp.stack(hgs, axis=1).astype(S_hg.dtype),
            jnp.stack(convs, axis=1).astype(conv_buf.dtype),
            jnp.stack(lrus, axis=1).astype(h_lru.dtype))


def setup_inputs(seed: int = 0) -> dict:
    key = jax.random.key(seed)
    ks = iter(jax.random.split(key, 48))

    def nrm(shape, scale):
        return jax.random.normal(next(ks), shape, jnp.float32) * scale

    def gain(shape):
        return 1.0 + nrm(shape, 0.01)

    a0 = jax.random.uniform(next(ks), (N_ODD, LRU_WIDTH), jnp.float32, 0.9, 0.999)
    s = a0 ** (1.0 / LRU_C)
    lru_lambda = jnp.log(s) - jnp.log1p(-s)
    return {
        'x_prompt': nrm((BATCH, SEQ, D_MODEL), 1.0),
        'x_sample': nrm((DEC_BATCH, DEC_SEQ, D_MODEL), 1.0),
        'state_rwkv_shift': nrm((DEC_BATCH, N_EVEN, P_RW), 1.0),
        'state_rwkv': nrm((DEC_BATCH, N_EVEN, RW_HEADS, RW_HEAD, RW_HEAD), 0.3),
        'state_hgrn': nrm((DEC_BATCH, N_EVEN, HG_HEADS, HG_EXPAND, HG_VDIM), 0.3),
        'state_conv': nrm((DEC_BATCH, N_ODD, CONV_W - 1, LRU_WIDTH), 1.0),
        'state_lru': nrm((DEC_BATCH, N_ODD, LRU_WIDTH), 0.5),
        'ffn1_norm': gain((DEPTH, D_MODEL)),
        'ffn1_w_gu': nrm((DEPTH, D_MODEL, 2 * D_FF), D_MODEL ** -0.5),
        'ffn1_w_down': nrm((DEPTH, D_FF, D_MODEL), D_FF ** -0.5),
        'mix_norm': gain((DEPTH, D_MODEL)),
        'ffn2_norm': gain((DEPTH, D_MODEL)),
        'ffn2_w_gu': nrm((DEPTH, D_MODEL, 2 * D_FF), D_MODEL ** -0.5),
        'ffn2_w_down': nrm((DEPTH, D_FF, D_MODEL), D_FF ** -0.5),
        'ev_w_in': nrm((N_EVEN, D_MODEL, P_EVEN), D_MODEL ** -0.5),
        'rw_mu': jax.random.uniform(next(ks), (N_EVEN, P_RW), jnp.float32),
        'rw_w0': jax.random.uniform(next(ks), (N_EVEN, RW_WIDTH), jnp.float32, -6.0, 1.0),
        'rw_w2': nrm((N_EVEN, D_DECAY_LORA, RW_WIDTH), 0.5 * D_DECAY_LORA ** -0.5),
        'rw_a0': nrm((N_EVEN, RW_WIDTH), 0.1),
        'rw_a2': nrm((N_EVEN, D_AAA_LORA, RW_WIDTH), D_AAA_LORA ** -0.5),
        'rw_g2': nrm((N_EVEN, D_GATE_LORA, RW_WIDTH), D_GATE_LORA ** -0.5),
        'rw_k_k': 0.85 + nrm((N_EVEN, RW_WIDTH), 0.05),
        'rw_k_a': 1.0 + nrm((N_EVEN, RW_WIDTH), 0.05),
        'rw_r_k': nrm((N_EVEN, RW_HEADS, RW_HEAD), 0.1),
        'rw_ln_w': gain((N_EVEN, RW_WIDTH)),
        'rw_ln_b': nrm((N_EVEN, RW_WIDTH), 0.01),
        'hg_lb': nrm((N_EVEN, HG_KEY_WIDTH), 0.5),
        'hg_norm': gain((N_EVEN, HG_WIDTH)),
        'ev_w_out': nrm((N_EVEN, RW_WIDTH + HG_WIDTH, D_MODEL), (RW_WIDTH + HG_WIDTH) ** -0.5),
        'od_w_in': nrm((N_ODD, D_MODEL, 2 * LRU_WIDTH), D_MODEL ** -0.5),
        'conv_w': nrm((N_ODD, CONV_W, LRU_WIDTH), CONV_W ** -0.5),
        'conv_b': nrm((N_ODD, LRU_WIDTH), 0.01),
        'lru_wa': nrm((N_ODD, LRU_BLOCKS, LRU_BLOCK, LRU_BLOCK), LRU_BLOCK ** -0.5),
        'lru_ba': nrm((N_ODD, LRU_WIDTH), 0.01),
        'lru_wx': nrm((N_ODD, LRU_BLOCKS, LRU_BLOCK, LRU_BLOCK), LRU_BLOCK ** -0.5),
        'lru_bx': nrm((N_ODD, LRU_WIDTH), 0.01),
        'lru_lambda': lru_lambda,
        'od_w_out': nrm((N_ODD, LRU_WIDTH, D_MODEL), LRU_WIDTH ** -0.5),
        'final_norm': gain((D_MODEL,)),
    }


def reference(x_prompt, x_sample, state_rwkv_shift, state_rwkv, state_hgrn, state_conv, state_lru,
              ffn1_norm, ffn1_w_gu, ffn1_w_down, mix_norm, ffn2_norm, ffn2_w_gu, ffn2_w_down,
              ev_w_in, rw_mu, rw_w0, rw_w2, rw_a0, rw_a2, rw_g2, rw_k_k, rw_k_a, rw_r_k,
              rw_ln_w, rw_ln_b, hg_lb, hg_norm, ev_w_out,
              od_w_in, conv_w, conv_b, lru_wa, lru_ba, lru_wx, lru_bx, lru_lambda, od_w_out,
              final_norm):
    p = dict(ffn1_norm=ffn1_norm, ffn1_w_gu=ffn1_w_gu, ffn1_w_down=ffn1_w_down, mix_norm=mix_norm,
             ffn2_norm=ffn2_norm, ffn2_w_gu=ffn2_w_gu, ffn2_w_down=ffn2_w_down,
             ev_w_in=ev_w_in, rw_mu=rw_mu, rw_w0=rw_w0, rw_w2=rw_w2, rw_a0=rw_a0, rw_a2=rw_a2,
             rw_g2=rw_g2, rw_k_k=rw_k_k, rw_k_a=rw_k_a, rw_r_k=rw_r_k, rw_ln_w=rw_ln_w,
             rw_ln_b=rw_ln_b, hg_lb=hg_lb, hg_norm=hg_norm, ev_w_out=ev_w_out,
             od_w_in=od_w_in, conv_w=conv_w, conv_b=conv_b, lru_wa=lru_wa, lru_ba=lru_ba,
             lru_wx=lru_wx, lru_bx=lru_bx, lru_lambda=lru_lambda, od_w_out=od_w_out,
             final_norm=final_norm)
    Bp = x_prompt.shape[0]
    dt = x_prompt.dtype
    z_shift = jnp.zeros((Bp,) + state_rwkv_shift.shape[1:], dt)
    z_rw = jnp.zeros((Bp,) + state_rwkv.shape[1:], dt)
    z_hg = jnp.zeros((Bp,) + state_hgrn.shape[1:], dt)
    z_conv = jnp.zeros((Bp,) + state_conv.shape[1:], dt)
    z_lru = jnp.zeros((Bp,) + state_lru.shape[1:], dt)
    y_prompt, p_shift, p_rwkv, p_hgrn, p_conv, p_lru = trunk(
        x_prompt, z_shift, z_rw, z_hg, z_conv, z_lru, p)
    y_sample, s_shift, s_rwkv, s_hgrn, s_conv, s_lru = trunk(
        x_sample, state_rwkv_shift, state_rwkv, state_hgrn, state_conv, state_lru, p)
    return (y_prompt, y_sample, p_shift, p_rwkv, p_hgrn, p_conv, p_lru,
            s_shift, s_rwkv, s_hgrn, s_conv, s_lru)
```

```cpp
#include <hip/hip_runtime.h>
#include <cstdio>
#include <cstdint>

#ifndef EPI_REP
#define EPI_REP 1
#endif
constexpr int D = 2048, MP = 8192, MS = 512, M = MP + MS, FF = 5632;
constexpr int TP = 2048, BP = 4, TS = 4, BS = 128, NSEQ = BP + BS;
constexpr int RW = 1024, RH = 16, PRW = 3520, PEV = 7616, NEV = 7680;
constexpr int HGH = 8;
constexpr int NLORA = 3072, KLORA = 512;
constexpr int NWAVES = 8, NTHR = 512;

namespace pg8 {
#define PG8_LAS __attribute__((address_space(3)))
typedef unsigned short bf16_t;
typedef short bf16x8 __attribute__((ext_vector_type(8)));
typedef float f32x4 __attribute__((ext_vector_type(4)));
typedef float f32x2 __attribute__((ext_vector_type(2)));
typedef unsigned u32x4 __attribute__((ext_vector_type(4)));
typedef unsigned u32x2 __attribute__((ext_vector_type(2)));
constexpr int BM = 256, BK = 64, HALF = 128, HTB = HALF * BK * 2  , STAGE_BYTES = 8 * HTB, NXCD = 8, WGM = 8;

__host__ __device__ __forceinline__ int lds_byte(int r, int c) { const int st = (r >> 4) * 2 + (c >> 5), rr = r & 15, cc = c & 31, ob = rr * 64 + cc * 2; return st * 1024 + (ob ^ (((ob >> 9) & 1) << 5)); }
__host__ __device__ __forceinline__ void stage_rc(int b, int& R, int& C) { const int st = b / 1024, sb = b % 1024, swz = sb ^ (((sb >> 9) & 1) << 5); R = (st >> 1) * 16 + swz / 64; C = (st & 1) * 32 + (swz % 64) / 2; }
__host__ __device__ __forceinline__ int perm32(int rho) { const int n = rho >> 4, i = rho & 15; return 8 * (i >> 2) + 4 * n + (i & 3); }

struct Unit { int pm, pn, ka, kb, nt, slab; };
struct Gemm { const bf16_t* A; const bf16_t* Bt; int lda, ldb; };

struct StaticOrder {
    int nM, nN, nwg, G, c, nt;
    __device__ void init(int Mr, int N, int K, int G_, int c_) { nM = Mr / BM; nN = N / BM; nwg = nM * nN; G = G_; c = c_; nt = K / BK; }
    __device__ bool next(int i, Unit& u) const {
        const long L = (long)i * G + c; if (L >= nwg) return false;
        int wgid = (int)L; { const int q = nwg / NXCD, r = nwg % NXCD, xcd = wgid % NXCD, off = wgid / NXCD; wgid = (xcd < r ? xcd * (q + 1) : r * (q + 1) + (xcd - r) * q) + off; }
        const int nig = WGM * nN, gid = wgid / nig, fm = gid * WGM, gsz = (nM - fm) < WGM ? (nM - fm) : WGM;
        u.pm = fm + ((wgid % nig) % gsz); u.pn = (wgid % nig) / gsz; u.ka = 0; u.kb = 0; u.nt = nt; u.slab = -1; return true;
    }
    __device__ __forceinline__ void a_ready(const Unit&) const {}
    __device__ __forceinline__ void done(const Unit&) const {}
};
__device__ __forceinline__ void resid_tile(int L, int& pm, int& pn) {
    if (L >= 256) { pm = 32 + ((L - 256) >> 3); pn = (L - 256) & 7; return; }
    const int wgid = (L % NXCD) * 32 + L / NXCD; pm = 8 * (wgid / 64) + ((wgid % 64) % 8); pn = (wgid % 64) / 8;
}
struct ResidOrder {
    StaticOrder so; int SF, PU; bool split;
    __device__ void init(int K, int G_, int c_) { so.init(M, 2048, K, G_, c_); PU = K / 128; SF = (PU / 2) < 16 ? (PU / 2) : 16; split = (G_ == 256); }
    __device__ bool next(int i, Unit& u) const {
        if (!split) return so.next(i, u);
        const int j = so.c / SF, p = so.c % SF; const bool piece = j < 16;
        if ((i == 0 && !piece) || (i == 1 && piece)) { resid_tile(so.c, u.pm, u.pn); u.ka = 0; u.kb = 0; u.nt = so.nt; u.slab = -1; return true; }
        if (i == 0) { resid_tile(256 + j, u.pm, u.pn); const int p0 = (p * PU) / SF, p1 = ((p + 1) * PU) / SF; u.ka = p0 * 128; u.kb = p0 * 128; u.nt = (p1 - p0) * 2; u.slab = j * SF + p; return true; }
        return false;
    }
    __device__ __forceinline__ void a_ready(const Unit&) const {}
    __device__ __forceinline__ void done(const Unit&) const {}
};
struct OddInOrder {
    StaticOrder so; bool split;
    __device__ void init(int G_, int c_) { so.init(M, 4096, 2048, G_, c_); split = (G_ == 256); }
    __device__ bool next(int i, Unit& u) const {
        if (!split) return so.next(i, u);
        if (i == 0) { const int j = so.c >> 3, p = so.c & 7; u.pm = 32 + (j >> 4); u.pn = j & 15; u.ka = p * 256; u.kb = p * 256; u.nt = 4; u.slab = so.c; return true; }
        if (i > 2) return false;
        const int L = (i - 1) * 256 + so.c, wgid = (L % NXCD) * 64 + L / NXCD;
        u.pm = 8 * (wgid / 128) + ((wgid % 128) % 8); u.pn = (wgid % 128) / 8; u.ka = 0; u.kb = 0; u.nt = so.nt; u.slab = -1; return true;
    }
    __device__ __forceinline__ void a_ready(const Unit&) const {}
    __device__ __forceinline__ void done(const Unit&) const {}
};
struct LruOrder {
    int G, c, nt;
    __device__ bool next(int i, Unit& u) const {
        const int L = i * G + c; if (L >= (M / BM) * 16) return false;
        u.pm = L >> 4; u.pn = L & 15; u.ka = 256 * (u.pn >> 1); u.kb = 0; u.nt = nt; u.slab = -1; return true;
    }
    __device__ __forceinline__ void a_ready(const Unit&) const {}
    __device__ __forceinline__ void done(const Unit&) const {}
};

__device__ __forceinline__ unsigned cvt_pk_bf16(float lo, float hi) {
    typedef float f2_ __attribute__((ext_vector_type(2))); typedef __bf16 b2_ __attribute__((ext_vector_type(2)));
    return __builtin_bit_cast(unsigned, __builtin_convertvector((f2_){lo, hi}, b2_));
}
__device__ __forceinline__ float sigm(float x) { return __builtin_amdgcn_rcpf(1.0f + __expf(-x)); }
__device__ __forceinline__ float log1p_pos(float t) { return t < 0.01f ? t * (1.0f - t * (0.5f - t * 0.33333333f)) : __logf(1.0f + t); }
__device__ __forceinline__ float softplus_(float y) { return fmaxf(y, 0.0f) + log1p_pos(__expf(-fabsf(y))); }
__device__ __forceinline__ float silu_(float x) { return x * sigm(x); }
__device__ __forceinline__ float gelu_tanh(float x) { return x * sigm(1.5957691216057308f * (x + 0.044715f * x * x * x)); }
__device__ __forceinline__ float neg_expm1(float x) {
    if (x > -0.25f) { return -x * (1.0f + x * (0.5f + x * (0.16666667f + x * (0.041666668f + x * (0.0083333338f + x * 0.0013888889f))))); }
    return 1.0f - __expf(x);
}

struct EpiSwiGLU {
    static constexpr bool PERM = true, AFTER_DRAIN = false;
    bf16_t* H; int ldh; const float* rstd;
    __device__ __forceinline__ void operator()(const f32x4 (&acc)[2][2][4][2], const Unit& u, int wr, int wc, int fr, int fq) const {
        const int row0 = u.pm * BM + wr * 64 + fr, col0 = u.pn * HALF + wc * 32 + 8 * fq;
        float rsv[2][4];
#pragma unroll
        for (int ai = 0; ai < 2; ++ai)
#pragma unroll
            for (int m = 0; m < 4; ++m) rsv[ai][m] = rstd[row0 + ai * HALF + m * 16];
#pragma unroll
        for (int ai = 0; ai < 2; ++ai)
#pragma unroll
            for (int m = 0; m < 4; ++m) {
                bf16_t* rowp = H + (size_t)(row0 + ai * HALF + m * 16) * ldh + col0;
                const float rs = rsv[ai][m];
                const f32x4 g0 = acc[ai][0][m][0] * rs, g1 = acc[ai][0][m][1] * rs, u0 = acc[ai][1][m][0] * rs, u1 = acc[ai][1][m][1] * rs;
                u32x4 w;
                w.x = cvt_pk_bf16(silu_(g0[0]) * u0[0], silu_(g0[1]) * u0[1]); w.y = cvt_pk_bf16(silu_(g0[2]) * u0[2], silu_(g0[3]) * u0[3]);
                w.z = cvt_pk_bf16(silu_(g1[0]) * u1[0], silu_(g1[1]) * u1[1]); w.w = cvt_pk_bf16(silu_(g1[2]) * u1[2], silu_(g1[3]) * u1[3]);
                *(u32x4*)rowp = w;
            }
    }
};
struct EpiResid {
    static constexpr bool PERM = true, AFTER_DRAIN = false;
    float* X; int ldx; float scale; float* SLAB; bf16_t* XR; const float* gain; float* SSP;
    __device__ __forceinline__ void operator()(const f32x4 (&acc)[2][2][4][2], const Unit& u, int wr, int wc, int fr, int fq) const {
        if (u.slab >= 0) {
            bf16_t* base = (bf16_t*)SLAB + (size_t)u.slab * 65536 + (wr * 64 + fr) * 256 + wc * 32 + 8 * fq;
#pragma unroll
            for (int ai = 0; ai < 2; ++ai)
#pragma unroll
                for (int m = 0; m < 4; ++m)
#pragma unroll
                    for (int bj = 0; bj < 2; ++bj)
#pragma unroll
                        for (int n = 0; n < 2; ++n) { const f32x4 v = acc[ai][bj][m][n]; u32x2 w2; w2.x = cvt_pk_bf16(v[0], v[1]); w2.y = cvt_pk_bf16(v[2], v[3]); *(u32x2*)(base + (ai * HALF + m * 16) * 256 + bj * HALF + n * 4) = w2; }
            return;
        }
        const int row0 = u.pm * BM + wr * 64 + fr, col0 = u.pn * BM + wc * 32 + 8 * fq;
        f32x4 gv[2][2];
#pragma unroll
        for (int bj = 0; bj < 2; ++bj)
#pragma unroll
            for (int n = 0; n < 2; ++n) gv[bj][n] = gain ? *(const f32x4*)(gain + col0 + bj * HALF + n * 4) : (f32x4){0.f, 0.f, 0.f, 0.f};
#pragma unroll
        for (int aim = 0; aim < 4; ++aim) { const int ai = aim >> 1, mb = (aim & 1) * 2;
            f32x4 xv[4][2][2];
#pragma unroll
            for (int m = mb; m < mb + 2; ++m)
#pragma unroll
                for (int bj = 0; bj < 2; ++bj)
#pragma unroll
                    for (int n = 0; n < 2; ++n) xv[m][bj][n] = *(const f32x4*)(X + (size_t)(row0 + ai * HALF + m * 16) * ldx + col0 + bj * HALF + n * 4);
#pragma unroll
            for (int m = mb; m < mb + 2; ++m) {
                const int row = row0 + ai * HALF + m * 16;
                float* rowp = X + (size_t)row * ldx + col0; float ssq = 0.f;
#pragma unroll
                for (int bj = 0; bj < 2; ++bj)
#pragma unroll
                    for (int n = 0; n < 2; ++n) { f32x4* p = (f32x4*)(rowp + bj * HALF + n * 4); const f32x4 o = xv[m][bj][n] + acc[ai][bj][m][n] * scale; *p = o;
                        if (gain) { ssq += (o[0] * o[0] + o[1] * o[1]) + (o[2] * o[2] + o[3] * o[3]); const f32x4 y = o * gv[bj][n];
                            u32x2 w2; w2.x = cvt_pk_bf16(y[0], y[1]); w2.y = cvt_pk_bf16(y[2], y[3]); *(u32x2*)(XR + (size_t)row * ldx + col0 + bj * HALF + n * 4) = w2; } }
                if (gain) { ssq += __shfl_xor(ssq, 16); ssq += __shfl_xor(ssq, 32); if (fq == 0) SSP[(size_t)row * 32 + u.pn * 4 + wc] = ssq; }
            }
        }
    }
};
struct EpiStoreBf16 {
    static constexpr bool PERM = true, AFTER_DRAIN = false;
    bf16_t* O; int ldo; const float* rstd;
    __device__ __forceinline__ void operator()(const f32x4 (&acc)[2][2][4][2], const Unit& u, int wr, int wc, int fr, int fq) const {
        const int row0 = u.pm * BM + wr * 64 + fr, col0 = u.pn * BM + wc * 32 + 8 * fq;
        float rsv[2][4];
#pragma unroll
        for (int ai = 0; ai < 2; ++ai)
#pragma unroll
            for (int m = 0; m < 4; ++m) rsv[ai][m] = rstd[row0 + ai * HALF + m * 16];
#pragma unroll
        for (int ai = 0; ai < 2; ++ai)
#pragma unroll
            for (int m = 0; m < 4; ++m) {
                bf16_t* rowp = O + (size_t)(row0 + ai * HALF + m * 16) * ldo + col0; const float rs = rsv[ai][m];
#pragma unroll
                for (int bj = 0; bj < 2; ++bj) { const f32x4 v0 = acc[ai][bj][m][0] * rs, v1 = acc[ai][bj][m][1] * rs;
                    u32x4 w; w.x = cvt_pk_bf16(v0[0], v0[1]); w.y = cvt_pk_bf16(v0[2], v0[3]); w.z = cvt_pk_bf16(v1[0], v1[1]); w.w = cvt_pk_bf16(v1[2], v1[3]);
                    *(u32x4*)(rowp + bj * HALF) = w; }
            }
    }
};
struct EpiLora {
    static constexpr bool PERM = true, AFTER_DRAIN = false;
    bf16_t* O; const float* w0; const float* a0;
    __device__ __forceinline__ void operator()(const f32x4 (&acc)[2][2][4][2], const Unit& u, int wr, int wc, int fr, int fq) const {
        const int row0 = u.pm * BM + wr * 64 + fr, col0 = u.pn * BM + wc * 32 + 8 * fq, ty = u.pn >> 2;
        f32x4 bv[2][2];
#pragma unroll
        for (int bj = 0; bj < 2; ++bj)
#pragma unroll
            for (int n = 0; n < 2; ++n) { const int c = (col0 + bj * HALF + n * 4) & 1023; bv[bj][n] = ty == 0 ? *(const f32x4*)(w0 + c) : (ty == 1 ? *(const f32x4*)(a0 + c) : (f32x4){0.f, 0.f, 0.f, 0.f}); }
#pragma unroll
        for (int ai = 0; ai < 2; ++ai)
#pragma unroll
            for (int m = 0; m < 4; ++m) {
                bf16_t* rowp = O + (size_t)(row0 + ai * HALF + m * 16) * NLORA + col0;
#pragma unroll
                for (int bj = 0; bj < 2; ++bj)
#pragma unroll
                    for (int n = 0; n < 2; ++n) {
                        f32x4 v = acc[ai][bj][m][n] + bv[bj][n];
                        if (ty == 0) {
#pragma unroll
                            for (int i = 0; i < 4; ++i) v[i] = -0.60653065971f * sigm(v[i]);
                        } else if (ty == 1) {
#pragma unroll
                            for (int i = 0; i < 4; ++i) v[i] = sigm(v[i]);
                        }
                        u32x2 w2_; w2_.x = cvt_pk_bf16(v[0], v[1]); w2_.y = cvt_pk_bf16(v[2], v[3]); *(u32x2*)(rowp + bj * HALF + n * 4) = w2_;
                    }
            }
    }
};
struct EpiOddIn {
    static constexpr bool PERM = true, AFTER_DRAIN = false;
    bf16_t* GATE; bf16_t* XB; const float* rstd; bf16_t* SLAB;
    __device__ __forceinline__ void operator()(const f32x4 (&acc)[2][2][4][2], const Unit& u, int wr, int wc, int fr, int fq) const {
        if (u.slab >= 0) {
            bf16_t* base = SLAB + (size_t)u.slab * 65536 + (wr * 64 + fr) * 256 + wc * 32 + 8 * fq;
#pragma unroll
            for (int ai = 0; ai < 2; ++ai)
#pragma unroll
                for (int m = 0; m < 4; ++m)
#pragma unroll
                    for (int bj = 0; bj < 2; ++bj) { const f32x4 v0 = acc[ai][bj][m][0], v1 = acc[ai][bj][m][1];
                        u32x4 w; w.x = cvt_pk_bf16(v0[0], v0[1]); w.y = cvt_pk_bf16(v0[2], v0[3]); w.z = cvt_pk_bf16(v1[0], v1[1]); w.w = cvt_pk_bf16(v1[2], v1[3]);
                        *(u32x4*)(base + (ai * HALF + m * 16) * 256 + bj * HALF) = w; }
            return;
        }
        const int row0 = u.pm * BM + wr * 64 + fr, col0 = (u.pn & 7) * BM + wc * 32 + 8 * fq; const bool isg = u.pn < 8;
        bf16_t* dst = isg ? GATE : XB;
        float rsv[2][4];
#pragma unroll
        for (int ai = 0; ai < 2; ++ai)
#pragma unroll
            for (int m = 0; m < 4; ++m) rsv[ai][m] = rstd[row0 + ai * HALF + m * 16];
#pragma unroll
        for (int ai = 0; ai < 2; ++ai)
#pragma unroll
            for (int m = 0; m < 4; ++m) {
                const size_t ro = (size_t)(row0 + ai * HALF + m * 16) * 2048 + col0; const float rs = rsv[ai][m];
#pragma unroll
                for (int bj = 0; bj < 2; ++bj) {
                    f32x4 v0 = acc[ai][bj][m][0] * rs, v1 = acc[ai][bj][m][1] * rs;
                    if (isg) {
#pragma unroll
                        for (int q = 0; q < 4; ++q) { v0[q] = gelu_tanh(v0[q]); v1[q] = gelu_tanh(v1[q]); } }
                    u32x4 w; w.x = cvt_pk_bf16(v0[0], v0[1]); w.y = cvt_pk_bf16(v0[2], v0[3]); w.z = cvt_pk_bf16(v1[0], v1[1]); w.w = cvt_pk_bf16(v1[2], v1[3]);
                    *(u32x4*)(dst + ro + bj * HALF) = w;
                }
            }
    }
};
struct EpiLru {
    static constexpr bool PERM = true, AFTER_DRAIN = false;
    const bf16_t* XC; bf16_t* OA; bf16_t* OB; const float* ba; const float* bx; const float* lam;
    __device__ __forceinline__ void operator()(const f32x4 (&acc)[2][2][4][2], const Unit& u, int wr, int wc, int fr, int fq) const {
        const int row0 = u.pm * BM + wr * 64 + fr, ch0 = u.pn * HALF + wc * 32 + 8 * fq;
#pragma unroll
        for (int n = 0; n < 2; ++n) {
            const f32x4 vba = *(const f32x4*)(ba + ch0 + n * 4), vbx = *(const f32x4*)(bx + ch0 + n * 4), l = *(const f32x4*)(lam + ch0 + n * 4); f32x4 vsl;
#pragma unroll
            for (int i = 0; i < 4; ++i) vsl[i] = -8.0f * softplus_(-l[i]);
            u32x2 xw[2][4];
#pragma unroll
            for (int ai = 0; ai < 2; ++ai)
#pragma unroll
                for (int m = 0; m < 4; ++m) xw[ai][m] = *(const u32x2*)(XC + (size_t)(row0 + ai * HALF + m * 16) * 2048 + ch0 + n * 4);
#pragma unroll
            for (int ai = 0; ai < 2; ++ai)
#pragma unroll
                for (int m = 0; m < 4; ++m) {
                    const size_t ro = (size_t)(row0 + ai * HALF + m * 16) * 2048 + ch0 + n * 4;
                    const f32x4 ga = acc[ai][0][m][n] + vba, gx = acc[ai][1][m][n] + vbx; const u32x2 w2 = xw[ai][m];
                    const f32x4 xc = {__builtin_bit_cast(float, w2.x << 16), __builtin_bit_cast(float, w2.x & 0xffff0000u), __builtin_bit_cast(float, w2.y << 16), __builtin_bit_cast(float, w2.y & 0xffff0000u)};
                    f32x4 la, b;
#pragma unroll
                    for (int i = 0; i < 4; ++i) { la[i] = vsl[i] * sigm(ga[i]); b[i] = sqrtf(neg_expm1(2.0f * la[i])) * sigm(gx[i]) * xc[i]; }
                    u32x2 wa_, wb_; wa_.x = cvt_pk_bf16(la[0], la[1]); wa_.y = cvt_pk_bf16(la[2], la[3]); wb_.x = cvt_pk_bf16(b[0], b[1]); wb_.y = cvt_pk_bf16(b[2], b[3]);
                    *(u32x2*)(OA + ro) = wa_; *(u32x2*)(OB + ro) = wb_;
                }
        }
    }
};

template <class Epi, class Sched, bool ALIGN_EPI = false, bool SP2 = false>
__device__ __forceinline__ void gemm_phase(PG8_LAS unsigned char* lds, const Gemm g, const Sched& S, const Epi& E) {
    int tid_ = threadIdx.x; asm volatile("" : "+v"(tid_));
    const int tid = tid_, wid = __builtin_amdgcn_readfirstlane(tid >> 6), lane = tid & 63, wr = wid >> 2, wc = wid & 3, fr = lane & 15, fq = lane >> 4;
    const int lda = g.lda, ldb = g.ldb;
    unsigned voffA[2], voffB[2];
#pragma unroll
    for (int i = 0; i < 2; ++i) { int R, C; stage_rc(tid * 16 + i * 8192, R, C); const int Rb = Epi::PERM ? ((R & ~31) + perm32(R & 31)) : R;
        voffA[i] = (unsigned)(R * lda + C) * 2u; voffB[i] = (unsigned)(Rb * ldb + C) * 2u; }
    const size_t kstep = (size_t)(BK * 2);
    const size_t hstepA = (size_t)HALF * lda * 2, hstepB = (size_t)HALF * ldb * 2;
    const size_t tstepA = 2 * hstepA, tstepB = 2 * hstepB;
    const unsigned ldsw = (unsigned)wid * 1024u;
    const int aoff = lds_byte(wr * 64 + fr, fq * 8), boff = lds_byte(wc * 32 + fr, fq * 8);
#define PG8_SA(b, h) (((b) * 2 + (h)) * HTB)
#define PG8_SB(b, h) ((4 + (b) * 2 + (h)) * HTB)
#define PG8_STAGE(bufoff, gbase, voff) do { _Pragma("unroll") for (int _i = 0; _i < 2; ++_i) \
        __builtin_amdgcn_global_load_lds((const unsigned*)((const char*)(gbase) + (voff)[_i]), (PG8_LAS unsigned*)(lds + (bufoff) + ldsw + _i * 8192), 16, 0, 0); } while (0)
#define PG8_LDA(dst, b, h) do { _Pragma("unroll") for (int m = 0; m < 4; ++m) _Pragma("unroll") for (int k = 0; k < 2; ++k) dst[m][k] = *(const PG8_LAS bf16x8*)(lds + PG8_SA(b, h) + aoff + m * 2048 + k * 1024); } while (0)
#define PG8_LDB(dst, b, h) do { _Pragma("unroll") for (int n = 0; n < 2; ++n) _Pragma("unroll") for (int k = 0; k < 2; ++k) dst[n][k] = *(const PG8_LAS bf16x8*)(lds + PG8_SB(b, h) + boff + n * 2048 + k * 1024); } while (0)
#define PG8_MMA(ai, bj, At, Bt) do { __builtin_amdgcn_s_setprio(1); _Pragma("unroll") for (int m = 0; m < 4; ++m) _Pragma("unroll") for (int n = 0; n < 2; ++n) _Pragma("unroll") for (int k = 0; k < 2; ++k) \
        acc[ai][bj][m][n] = __builtin_amdgcn_mfma_f32_16x16x32_bf16(Bt[n][k], At[m][k], acc[ai][bj][m][n], 0, 0, 0); __builtin_amdgcn_s_setprio(0); } while (0)
#define PG8_WAIT_V(n) asm volatile("s_waitcnt vmcnt(" #n ")" ::: "memory")
#define PG8_WAIT_L(n) asm volatile("s_waitcnt lgkmcnt(" #n ")" ::: "memory")
#define PG8_BAR __builtin_amdgcn_s_barrier()
#define PG8_SCHED __builtin_amdgcn_sched_barrier(0)
    Unit cur, nxt; int ui = 0;
    if (!S.next(0, cur)) return;
    f32x4 acc[2][2][4][2];
#pragma unroll
    for (int a = 0; a < 2; ++a)
#pragma unroll
        for (int b = 0; b < 2; ++b)
#pragma unroll
            for (int m = 0; m < 4; ++m)
#pragma unroll
                for (int n = 0; n < 2; ++n) acc[a][b][m][n] = (f32x4){0.f, 0.f, 0.f, 0.f};
    bf16x8 At[4][2], B0[2][2], B1[2][2];
    const char* cA = (const char*)g.A + (size_t)cur.pm * tstepA + (size_t)cur.ka * 2; const char* cB = (const char*)g.Bt + (size_t)cur.pn * tstepB + (size_t)cur.kb * 2; int nt = cur.nt;
    S.a_ready(cur);
    if constexpr (SP2) {
        PG8_STAGE(PG8_SB(0, 0), cB, voffB); PG8_STAGE(PG8_SB(0, 1), cB + hstepB, voffB); PG8_STAGE(PG8_SA(0, 0), cA, voffA); PG8_STAGE(PG8_SA(0, 1), cA + hstepA, voffA);
        if (wr == 1) PG8_BAR;
        PG8_WAIT_V(2); PG8_BAR;
        PG8_STAGE(PG8_SB(1, 0), cB + kstep, voffB); PG8_STAGE(PG8_SA(1, 0), cA + kstep, voffA); PG8_STAGE(PG8_SB(1, 1), cB + hstepB + kstep, voffB);
        PG8_WAIT_V(6); PG8_BAR;
    } else {
        PG8_STAGE(PG8_SB(0, 0), cB, voffB); PG8_STAGE(PG8_SA(0, 0), cA, voffA); PG8_STAGE(PG8_SB(0, 1), cB + hstepB, voffB); PG8_STAGE(PG8_SA(0, 1), cA + hstepA, voffA);
        if (wr == 1) PG8_BAR;
        PG8_WAIT_V(4); PG8_BAR;
        PG8_STAGE(PG8_SB(1, 0), cB + kstep, voffB); PG8_STAGE(PG8_SA(1, 0), cA + kstep, voffA); PG8_STAGE(PG8_SB(1, 1), cB + hstepB + kstep, voffB);
        PG8_WAIT_V(6); PG8_BAR;
    }
    for (;;) {
        const bool has_next = S.next(ui + 1, nxt);
        const char* nA = has_next ? (const char*)g.A + (size_t)nxt.pm * tstepA + (size_t)nxt.ka * 2 : cA; const char* nB = has_next ? (const char*)g.Bt + (size_t)nxt.pn * tstepB + (size_t)nxt.kb * 2 : cB;
        for (int t = 0; t < nt; t += 2) {
            const bool last = (t == nt - 2);
            const char* a1 = cA + (size_t)(t + 1) * kstep;
            const char* a2 = last ? nA : cA + (size_t)(t + 2) * kstep; const char* b2 = last ? nB : cB + (size_t)(t + 2) * kstep;
            const char* a3 = a2 + kstep; const char* b3 = b2 + kstep;
            if (last && has_next) S.a_ready(nxt);
            if constexpr (SP2) {
            PG8_LDB(B0, 0, 0); PG8_LDB(B1, 0, 1); PG8_SCHED; PG8_LDA(At, 0, 0); PG8_STAGE(PG8_SA(1, 1), a1 + hstepA, voffA);
            PG8_WAIT_V(8); PG8_WAIT_L(0); PG8_BAR; PG8_MMA(0, 0, At, B0); PG8_MMA(0, 1, At, B1); PG8_BAR; PG8_SCHED;
            PG8_LDA(At, 0, 1); PG8_STAGE(PG8_SB(0, 0), b2, voffB); PG8_STAGE(PG8_SB(0, 1), b2 + hstepB, voffB); PG8_STAGE(PG8_SA(0, 0), a2, voffA);
            PG8_WAIT_V(8); PG8_WAIT_L(0); PG8_BAR; PG8_MMA(1, 0, At, B0); PG8_MMA(1, 1, At, B1); PG8_BAR; PG8_SCHED;
            PG8_LDB(B0, 1, 0); PG8_LDB(B1, 1, 1); PG8_SCHED; PG8_LDA(At, 1, 0); PG8_STAGE(PG8_SA(0, 1), a2 + hstepA, voffA);
            PG8_WAIT_V(8); PG8_WAIT_L(0); PG8_BAR; PG8_MMA(0, 0, At, B0); PG8_MMA(0, 1, At, B1); PG8_BAR; PG8_SCHED;
            PG8_LDA(At, 1, 1); PG8_STAGE(PG8_SB(1, 0), b3, voffB); PG8_STAGE(PG8_SB(1, 1), b3 + hstepB, voffB); PG8_STAGE(PG8_SA(1, 0), a3, voffA);
            PG8_WAIT_V(8); PG8_WAIT_L(0); PG8_BAR; PG8_MMA(1, 0, At, B0); PG8_MMA(1, 1, At, B1); PG8_BAR; PG8_SCHED;
            } else {
            PG8_LDB(B0, 0, 0); PG8_SCHED; PG8_LDA(At, 0, 0); PG8_STAGE(PG8_SA(1, 1), a1 + hstepA, voffA);
            PG8_WAIT_L(8); PG8_BAR; PG8_WAIT_L(0); PG8_MMA(0, 0, At, B0); PG8_BAR; PG8_SCHED;
            PG8_LDB(B1, 0, 1); PG8_STAGE(PG8_SB(0, 0), b2, voffB);
            PG8_BAR; PG8_WAIT_L(0); PG8_MMA(0, 1, At, B1); PG8_BAR;
            PG8_LDA(At, 0, 1); PG8_STAGE(PG8_SA(0, 0), a2, voffA);
            PG8_BAR; PG8_WAIT_L(0); PG8_MMA(1, 0, At, B0); PG8_BAR; PG8_SCHED;
            PG8_STAGE(PG8_SB(0, 1), b2 + hstepB, voffB);
            PG8_WAIT_V(6); PG8_BAR; PG8_MMA(1, 1, At, B1); PG8_BAR;
            PG8_LDB(B0, 1, 0); PG8_SCHED; PG8_LDA(At, 1, 0); PG8_STAGE(PG8_SA(0, 1), a2 + hstepA, voffA);
            PG8_WAIT_L(8); PG8_BAR; PG8_WAIT_L(0); PG8_MMA(0, 0, At, B0); PG8_BAR; PG8_SCHED;
            PG8_LDB(B1, 1, 1); PG8_STAGE(PG8_SB(1, 0), b3, voffB);
            PG8_BAR; PG8_WAIT_L(0); PG8_MMA(0, 1, At, B1); PG8_BAR;
            PG8_LDA(At, 1, 1); PG8_STAGE(PG8_SA(1, 0), a3, voffA);
            PG8_BAR; PG8_WAIT_L(0); PG8_MMA(1, 0, At, B0); PG8_BAR; PG8_SCHED;
            PG8_STAGE(PG8_SB(1, 1), b3 + hstepB, voffB);
            PG8_WAIT_V(6); PG8_BAR; PG8_MMA(1, 1, At, B1); PG8_BAR;
            }
        }
        if constexpr (ALIGN_EPI) { if (wr == 0) PG8_BAR; }
        if constexpr (!Epi::AFTER_DRAIN) { E(acc, cur, wr, wc, fr, fq); if (EPI_REP > 1) { asm volatile("" ::: "memory"); E(acc, cur, wr, wc, fr, fq); } S.done(cur); }
        if (!has_next) break;
#pragma unroll
        for (int a = 0; a < 2; ++a)
#pragma unroll
            for (int b = 0; b < 2; ++b)
#pragma unroll
                for (int m = 0; m < 4; ++m)
#pragma unroll
                    for (int n = 0; n < 2; ++n) acc[a][b][m][n] = (f32x4){0.f, 0.f, 0.f, 0.f};
        cur = nxt; cA = nA; cB = nB; nt = cur.nt; ++ui;
        if constexpr (ALIGN_EPI) { if (wr == 1) PG8_BAR; }
    }
    PG8_WAIT_V(0);
    if constexpr (!ALIGN_EPI) { if (wr == 0) PG8_BAR; }
    PG8_BAR;
    if constexpr (Epi::AFTER_DRAIN) { E.fused(acc, cur, wr, wc, fr, fq, lds, wid, lane); S.done(cur); }
#undef PG8_SA
#undef PG8_SB
#undef PG8_STAGE
#undef PG8_LDA
#undef PG8_LDB
#undef PG8_MMA
#undef PG8_WAIT_V
#undef PG8_WAIT_L
#undef PG8_BAR
#undef PG8_SCHED
}
}

constexpr size_t MiB = 1u << 20;
constexpr size_t WS_CTL = 0, CTL_ZERO_BYTES = 512 * 1024;
constexpr size_t SZ_WGU = (size_t)2 * FF * D * 2, SZ_WDN = (size_t)D * FF * 2;
constexpr size_t SZ_WEVIN = (size_t)NEV * D * 2, SZ_WSQ = (size_t)D * D * 2, SZ_WODIN = (size_t)2 * D * D * 2;
constexpr size_t SZ_WLORA = (size_t)NLORA * KLORA * 2, SZ_WLRU = (size_t)4096 * 256 * 2;
constexpr size_t WS_WGU = 1 * MiB;
constexpr size_t WS_WDN = WS_WGU + 8 * SZ_WGU;
constexpr size_t WS_WEVIN = WS_WDN + 8 * SZ_WDN;
constexpr size_t WS_WEVOUT = WS_WEVIN + 2 * SZ_WEVIN;
constexpr size_t WS_WODIN = WS_WEVOUT + 2 * SZ_WSQ;
constexpr size_t WS_WODOUT = WS_WODIN + 2 * SZ_WODIN;
constexpr size_t WS_WLORA = WS_WODOUT + 2 * SZ_WSQ;
constexpr size_t WS_WLRU = WS_WLORA + 2 * SZ_WLORA;
constexpr size_t WS_X = WS_WLRU + 2 * SZ_WLRU;
constexpr size_t WS_XN = WS_X + (size_t)M * D * 4;
constexpr size_t WS_H = WS_XN + (size_t)M * D * 2;
constexpr size_t WS_YIN = WS_H + (size_t)M * FF * 2;
constexpr size_t WS_MIX = WS_YIN + (size_t)M * D * 2;
constexpr size_t WS_PROJ = WS_MIX;
constexpr size_t WS_WAG = WS_PROJ + (size_t)M * NEV * 4;
constexpr size_t WS_LA = WS_WAG + (size_t)M * NLORA * 4;
constexpr size_t WS_HU = WS_LA + (size_t)M * KLORA * 2;
constexpr size_t WS_HD = WS_HU + (size_t)1024 * 16384 * 4;
constexpr size_t WS_PST = WS_HD + (size_t)1024 * 128 * 4;
constexpr size_t WS_QST = WS_PST + (size_t)8192 * 4096 * 2;
constexpr size_t WS_OB2 = WS_QST + (size_t)8192 * 4096 * 4;
constexpr size_t WS_SSP = WS_OB2 + (size_t)MP * 1024 * 4;
constexpr size_t WS_RSTD = WS_SSP + (size_t)M * 32 * 4;
constexpr size_t WS_EVEN_END = WS_RSTD + (size_t)M * 4;
constexpr size_t WS_OI = WS_H, WS_QT = WS_H + (size_t)MP * 1024 * 4;
constexpr size_t WS_RQ = WS_QT + (size_t)MP * 1024 * 4;
constexpr size_t WS_OB = WS_XN;
static_assert(WS_RQ + (size_t)8192 * 1024 * 2 <= WS_YIN, "OI/QT/RQ overlay fits in H");
constexpr size_t WS_SLAB = WS_MIX;
constexpr size_t WS_OSLAB = WS_PST;
constexpr size_t WS_XB = WS_MIX;
constexpr size_t WS_GATE = WS_XB + (size_t)M * 2048 * 4;
constexpr size_t WS_XC = WS_GATE + (size_t)M * 2048 * 2;
constexpr size_t WS_XCB = WS_XC + (size_t)M * 2048 * 4;
constexpr size_t WS_LRA = WS_XCB + (size_t)M * 2048 * 2;
constexpr size_t WS_LRB = WS_LRA + (size_t)M * 2048 * 4;
constexpr size_t WS_CP = WS_LRB + (size_t)M * 2048 * 4;
constexpr size_t WS_CH = WS_CP + (size_t)4 * 32 * 2048 * 4;
constexpr size_t WS_ODD_END = WS_CH + (size_t)4 * 32 * 2048 * 4;
constexpr size_t WS_END = WS_EVEN_END > WS_ODD_END ? WS_EVEN_END : WS_ODD_END;
constexpr int CW_BAR = 4096;
constexpr int PAR_FFN1N = 0, PAR_MIXN = 8192, PAR_FFN2N = 16384, PAR_FINN = 24576, PAR_MU = 26624, PAR_W0 = 33664, PAR_A0 = 35712, PAR_KK = 37760, PAR_KA = 39808,
              PAR_RK = 41856, PAR_LNW = 43904, PAR_LNB = 45952, PAR_HGLB = 48000, PAR_HGN = 50048, PAR_CONVW = 52096, PAR_CONVB = 68480, PAR_BA = 72576, PAR_BX = 76672,
              PAR_LAM = 80768, PAR_END = 84864;
constexpr size_t WS_PAR = 512 * 1024;

constexpr size_t O_Y = 0, O_PSHIFT = (size_t)M * D, O_PRWKV = O_PSHIFT + (size_t)BP * 2 * PRW, O_PHGRN = O_PRWKV + (size_t)BP * 2 * 16 * 4096,
                 O_PCONV = O_PHGRN + (size_t)BP * 2 * 8 * 16384, O_PLRU = O_PCONV + (size_t)BP * 2 * 3 * 2048, O_SSHIFT = O_PLRU + (size_t)BP * 2 * 2048,
                 O_SRWKV = O_SSHIFT + (size_t)BS * 2 * PRW, O_SHGRN = O_SRWKV + (size_t)BS * 2 * 16 * 4096, O_SCONV = O_SHGRN + (size_t)BS * 2 * 8 * 16384,
                 O_SLRU = O_SCONV + (size_t)BS * 2 * 3 * 2048, O_END = O_SLRU + (size_t)BS * 2 * 2048;

constexpr int LDS_BYTES = 155648;
constexpr int MISC_OFF = 153600;

#define GAS __attribute__((address_space(1)))
#define LAS __attribute__((address_space(3)))
typedef unsigned short bf16;
typedef unsigned v4u __attribute__((ext_vector_type(4)));
typedef unsigned v2u __attribute__((ext_vector_type(2)));
typedef float f32x4 __attribute__((ext_vector_type(4)));
typedef float f32x2 __attribute__((ext_vector_type(2)));
using pg8::sigm; using pg8::silu_; using pg8::softplus_; using pg8::cvt_pk_bf16;
#define LDS_WAIT() asm volatile("s_waitcnt lgkmcnt(0)" ::: "memory")
#define VM_WAIT() asm volatile("s_waitcnt vmcnt(0)" ::: "memory")
__device__ __forceinline__ unsigned f2bf(float f) { unsigned u = __builtin_bit_cast(unsigned, f); return (u + 0x7fffu + ((u >> 16) & 1u)) >> 16; }
__device__ __forceinline__ unsigned pk2(float lo, float hi) { return f2bf(lo) | (f2bf(hi) << 16); }
__device__ __forceinline__ float bf2f(unsigned h) { return __builtin_bit_cast(float, h << 16); }
template <int CTRL> __device__ __forceinline__ float dppf(float v) { return __builtin_bit_cast(float, __builtin_amdgcn_update_dpp(0, __builtin_bit_cast(int, v), CTRL, 0xf, 0xf, true)); }
__device__ __forceinline__ float red8(float x) { x += dppf<0xB1>(x); x += dppf<0x4E>(x); x += dppf<0x141>(x); return x; }
__device__ __forceinline__ float red16(float x) { x = red8(x); x += dppf<0x140>(x); return x; }
__device__ __forceinline__ float wave_sum(float v) {
#pragma unroll
    for (int o = 1; o < 64; o <<= 1) v += __shfl_xor(v, o);
    return v;
}
#define XB_TMO      128
#define XB_XCNT(j)  (256  + 64 * (j))
#define XB_XSUB(j)  (1280 + 64 * (j))
#define XB_XGEN(j)  (2304 + 64 * (j))
#define XB_TOP      3328
#define XB_TOPGEN   3392
#define XCD_BAR_WORDS 3456
#define XB_SPIN_CAP (1u << 18)

__device__ __forceinline__ unsigned xb_ld(unsigned* p)              { return __hip_atomic_load(p, __ATOMIC_RELAXED, __HIP_MEMORY_SCOPE_AGENT); }
__device__ __forceinline__ unsigned xb_add(unsigned* p, unsigned v) { return __hip_atomic_fetch_add(p, v, __ATOMIC_RELAXED, __HIP_MEMORY_SCOPE_AGENT); }
__device__ __forceinline__ unsigned xb_xcc_id() { return (unsigned)__builtin_amdgcn_s_getreg((3 << 11) | 20) & 0xFu; }
#define XB_SPIN(cond, bar) do { unsigned _sp = 0; while (cond) { __builtin_amdgcn_s_sleep(1); \
    if ((++_sp & 255u) == 0u) { if (xb_ld(&(bar)[XB_TMO])) break; if (_sp > XB_SPIN_CAP) { atomicAdd(&(bar)[XB_TMO], 1u); break; } } } } while (0)

struct XcdBarrier {
    unsigned* bar; unsigned x;
    volatile LAS unsigned* st;
};

__device__ __forceinline__ XcdBarrier xcd_barrier_post(unsigned* bar, volatile LAS unsigned* st) {
    XcdBarrier b; b.bar = bar; b.x = xb_xcc_id(); b.st = st;
    if (threadIdx.x == 0) (void)xb_add(&bar[XB_XCNT(b.x)], 1u);
    return b;
}
__device__ __forceinline__ void xcd_barrier_complete(unsigned* bar, unsigned x, unsigned& nloc, unsigned& nx) {
    const unsigned G = gridDim.x * gridDim.y * gridDim.z;
    unsigned sum, cnt, mine, sp = 0u;
    for (;;) {
        sum = 0u; cnt = 0u; mine = 0u;
#pragma unroll
        for (unsigned j = 0; j < 16; ++j) { const unsigned c = xb_ld(&bar[XB_XCNT(j)]); sum += c; cnt += (c > 0u) ? 1u : 0u; mine = (j == x) ? c : mine; }
        if (sum == G) break;
        __builtin_amdgcn_s_sleep(1);
        if ((++sp & 255u) == 0u) { if (xb_ld(&bar[XB_TMO])) break; if (sp > XB_SPIN_CAP) { atomicAdd(&bar[XB_TMO], 1u); break; } }
    }
    nloc = mine > 0u ? mine : 1u; nx = cnt > 0u ? cnt : 1u;
}

__device__ __forceinline__ void xcd_barrier(const XcdBarrier& b) {
    asm volatile("s_waitcnt vmcnt(0)" ::: "memory");
    __syncthreads();
    if (threadIdx.x == 0) {
        unsigned* bar = b.bar;
        __builtin_amdgcn_s_waitcnt(0);
        unsigned nloc = b.st[0], nx = b.st[1];
        if (nloc == 0u) { xcd_barrier_complete(bar, b.x, nloc, nx); b.st[0] = nloc; b.st[1] = nx; }
        const unsigned old = xb_add(&bar[XB_XSUB(b.x)], 1u);
        const unsigned gen = old / nloc;
        if (old + 1u == (gen + 1u) * nloc) {
            __builtin_amdgcn_fence(__ATOMIC_RELEASE, "agent");
            asm volatile("s_waitcnt vmcnt(0)" ::: "memory");
            const unsigned og = xb_add(&bar[XB_TOP], 1u);
            const unsigned tg = og / nx;
            if (og + 1u == (tg + 1u) * nx) xb_add(&bar[XB_TOPGEN], 1u);
            else XB_SPIN(xb_ld(&bar[XB_TOPGEN]) == tg, bar);
            __builtin_amdgcn_fence(__ATOMIC_ACQUIRE, "agent");
            xb_add(&bar[XB_XGEN(b.x)], 1u);
            asm volatile("s_waitcnt vmcnt(0)" ::: "memory");
        } else {
            XB_SPIN(xb_ld(&bar[XB_XGEN(b.x)]) == gen, bar);
            __builtin_amdgcn_fence(__ATOMIC_ACQUIRE, "agent");
            asm volatile("s_waitcnt vmcnt(0)" ::: "memory");
        }
    }
    __syncthreads();
}


#define GAS __attribute__((address_space(1)))
struct Args { const float* in[39]; GAS float* out; GAS unsigned char* ws; int ph_lo, ph_hi, li, pad; };
#define AOUT ((float*)A.out)
struct Frame { LAS unsigned char* lds; int tid, lane, wave, G, blk; };
#define PARP(off) ((const float*)(A.ws + WS_PAR) + (off))
__device__ __forceinline__ f32x4 ld4(const float* p) { return *(const f32x4*)p; }
__device__ __forceinline__ f32x4 ldp4(const bf16* p) { const v2u w = *(const v2u*)p; return (f32x4){bf2f(w.x & 0xffffu), bf2f(w.x >> 16), bf2f(w.y & 0xffffu), bf2f(w.y >> 16)}; }
__device__ __forceinline__ f32x4 cvq(const v2u w) { return (f32x4){bf2f(w.x & 0xffffu), bf2f(w.x >> 16), bf2f(w.y & 0xffffu), bf2f(w.y >> 16)}; }
__device__ __forceinline__ void st4bf(bf16* p, f32x4 v) { v2u w; w.x = cvt_pk_bf16(v[0], v[1]); w.y = cvt_pk_bf16(v[2], v[3]); *(v2u*)p = w; }

__device__ __forceinline__ void tr_item(const float* src, int Nsrc, int srcc0, int k0, bf16* dst, int ldd, int n0, LAS float* scr, int lane) {
    const int r4 = lane >> 4, q = lane & 15;
    if (srcc0 >= 0) {
        f32x4 v[16];
#pragma unroll
        for (int i = 0; i < 16; ++i) v[i] = ld4(src + (size_t)(k0 + 4 * i + r4) * Nsrc + srcc0 + 4 * q);
#pragma unroll
        for (int i = 0; i < 16; ++i) { LAS float* s = scr + (4 * i + r4) * 65 + 4 * q; s[0] = v[i][0]; s[1] = v[i][1]; s[2] = v[i][2]; s[3] = v[i][3]; }
    } else {
#pragma unroll 4
        for (int i = 0; i < 16; ++i) { const int k = 4 * i + r4; LAS float* s = scr + k * 65 + 4 * q; s[0] = 0.f; s[1] = 0.f; s[2] = 0.f; s[3] = 0.f; }
    }
    LDS_WAIT(); asm volatile("" ::: "memory");
    const int c = lane & 7;
#pragma unroll
    for (int j = 0; j < 8; ++j) { const int n = (lane >> 3) + 8 * j; const LAS float* s = scr + (8 * c) * 65 + n;
        v4u o; o.x = pk2(s[0 * 65], s[1 * 65]); o.y = pk2(s[2 * 65], s[3 * 65]); o.z = pk2(s[4 * 65], s[5 * 65]); o.w = pk2(s[6 * 65], s[7 * 65]);
        *(v4u*)(dst + (size_t)(n0 + n) * ldd + k0 + 8 * c) = o; }
    LDS_WAIT(); asm volatile("" ::: "memory");
}
constexpr int IT_GU = 32 * 176, IT_DN = 88 * 32, IT_EVIN = 32 * 120, IT_SQ = 32 * 32, IT_ODIN = 32 * 64;
constexpr int IT_TOTAL = 8 * IT_GU + 8 * IT_DN + 2 * IT_EVIN + 2 * IT_SQ + 2 * IT_ODIN + 2 * IT_SQ;

__device__ __forceinline__ void norm_row(const float* xrow, const float* gain, bf16* xn, float* y, float* xcopy, int lane, int sf = 0, float scale = 0.f, const float* slab = nullptr, int m = 0, float* xrow_w = nullptr, float* rstd_out = nullptr) {
    f32x4 v[8]; float s = 0.f;
#pragma unroll
    for (int j = 0; j < 8; ++j) v[j] = ld4(xrow + 4 * lane + 256 * j);
    if (sf > 0 && m >= MP) {
        const int r = m & 255, j0 = ((m >> 8) - 32) * 8;
#pragma unroll
        for (int jj = 0; jj < 8; ++jj) { f32x4 add = {0.f, 0.f, 0.f, 0.f};
            for (int p = 0; p < sf; ++p) { const v2u w2 = *(const v2u*)((const bf16*)slab + (size_t)((j0 + jj) * sf + p) * 65536 + r * 256 + 4 * lane); add += (f32x4){bf2f(w2.x & 0xffffu), bf2f(w2.x >> 16), bf2f(w2.y & 0xffffu), bf2f(w2.y >> 16)}; }
            v[jj] += add * scale; *(f32x4*)(xrow_w + 4 * lane + 256 * jj) = v[jj]; }
    }
#pragma unroll
    for (int j = 0; j < 8; ++j) s += (v[j][0] * v[j][0] + v[j][1] * v[j][1]) + (v[j][2] * v[j][2] + v[j][3] * v[j][3]);
    const float rstd = 1.0f / sqrtf(wave_sum(s) * (1.0f / D) + 1e-6f);
#pragma unroll
    for (int j = 0; j < 8; ++j) {
        if (xcopy) *(f32x4*)(xcopy + 4 * lane + 256 * j) = v[j];
        const f32x4 gq = ld4(gain + 4 * lane + 256 * j), o = v[j] * rstd * gq;
        if (xn) st4bf(xn + 4 * lane + 256 * j, rstd_out ? v[j] * gq : o);
        if (y) *(f32x4*)(y + 4 * lane + 256 * j) = o;
    }
    if (rstd_out && lane == 0) *rstd_out = rstd;
}

#ifndef PRO_2X4
#define PRO_2X4 1
#endif
#if PRO_2X4
#define PRO_MAP(r, NB, kb, nb) do { const int g_ = (r) >> 3, w_ = (r) & 7; nb = (g_ % ((NB) / 4)) * 4 + (w_ & 3); kb = (g_ / ((NB) / 4)) * 2 + (w_ >> 2); } while (0)
#else
#define PRO_MAP(r, NB, kb, nb) do { kb = (r) / (NB); nb = (r) % (NB); } while (0)
#endif
__device__ __forceinline__ void p0_prologue(const Args& A, Frame& F) {
    LAS float* scr = (LAS float*)(F.lds + F.wave * 16640);
    const int gw = F.blk * NWAVES + F.wave, NGW = F.G * NWAVES;
    bf16* Wgu = (bf16*)(A.ws + WS_WGU); bf16* Wdn = (bf16*)(A.ws + WS_WDN); bf16* Wevin = (bf16*)(A.ws + WS_WEVIN); bf16* Wevout = (bf16*)(A.ws + WS_WEVOUT);
    bf16* Wodin = (bf16*)(A.ws + WS_WODIN); bf16* Wodout = (bf16*)(A.ws + WS_WODOUT);
    for (int it = gw; it < IT_TOTAL; it += NGW) {
        int r = it;
        if (r < 8 * IT_GU) { const int mat = r / IT_GU; r -= mat * IT_GU; int kb, nb; PRO_MAP(r, 176, kb, nb); const int n0 = nb * 64, pn = n0 >> 8, c = n0 & 255;
            const int srcc = c < 128 ? pn * 128 + c : FF + pn * 128 + (c - 128);
            tr_item(((mat & 1) ? A.in[12] : A.in[8]) + (size_t)(mat >> 1) * D * 2 * FF, 2 * FF, srcc, kb * 64, Wgu + (size_t)mat * (SZ_WGU / 2), D, n0, scr, F.lane); continue; }
        r -= 8 * IT_GU;
        if (r < 8 * IT_DN) { const int mat = r / IT_DN; r -= mat * IT_DN; int kb, nb; PRO_MAP(r, 32, kb, nb);
            tr_item(((mat & 1) ? A.in[13] : A.in[9]) + (size_t)(mat >> 1) * FF * D, D, nb * 64, kb * 64, Wdn + (size_t)mat * (SZ_WDN / 2), FF, nb * 64, scr, F.lane); continue; }
        r -= 8 * IT_DN;
        if (r < 2 * IT_EVIN) { const int mat = r / IT_EVIN; r -= mat * IT_EVIN; int kb, nb; PRO_MAP(r, 120, kb, nb);
            tr_item(A.in[14] + (size_t)mat * D * PEV, PEV, nb * 64 < PEV ? nb * 64 : -1, kb * 64, Wevin + (size_t)mat * (SZ_WEVIN / 2), D, nb * 64, scr, F.lane); continue; }
        r -= 2 * IT_EVIN;
        if (r < 2 * IT_SQ) { const int mat = r / IT_SQ; r -= mat * IT_SQ; int kb, nb; PRO_MAP(r, 32, kb, nb);
            tr_item(A.in[28] + (size_t)mat * D * D, D, nb * 64, kb * 64, Wevout + (size_t)mat * (SZ_WSQ / 2), D, nb * 64, scr, F.lane); continue; }
        r -= 2 * IT_SQ;
        if (r < 2 * IT_ODIN) { const int mat = r / IT_ODIN; r -= mat * IT_ODIN; int kb, nb; PRO_MAP(r, 64, kb, nb);
            tr_item(A.in[29] + (size_t)mat * D * 2 * D, 2 * D, nb * 64, kb * 64, Wodin + (size_t)mat * (SZ_WODIN / 2), D, nb * 64, scr, F.lane); continue; }
        r -= 2 * IT_ODIN;
        { const int mat = r / IT_SQ; r -= mat * IT_SQ; int kb, nb; PRO_MAP(r, 32, kb, nb);
            tr_item(A.in[37] + (size_t)mat * D * D, D, nb * 64, kb * 64, Wodout + (size_t)mat * (SZ_WSQ / 2), D, nb * 64, scr, F.lane); }
    }
    const int gt = F.blk * NTHR + F.tid, NGT = F.G * NTHR;
    for (int idx = gt; idx < 2 * NLORA * (KLORA / 8); idx += NGT) {
        const int e = idx / (NLORA * (KLORA / 8)); int r = idx - e * (NLORA * (KLORA / 8)); const int n = r % NLORA, k8 = r / NLORA;
        const int ty = n >> 10, nn = n & 1023; float v[8];
#pragma unroll
        for (int i = 0; i < 8; ++i) { const int k = 8 * k8 + i; float x = 0.f;
            if (ty == 0) { if (k < 96) x = A.in[17][((size_t)e * 96 + k) * 1024 + nn]; }
            else if (ty == 1) { if (k >= 96 && k < 192) x = A.in[19][((size_t)e * 96 + (k - 96)) * 1024 + nn]; }
            else { if (k >= 192 && k < 448) x = A.in[20][((size_t)e * 256 + (k - 192)) * 1024 + nn]; }
            v[i] = x; }
        v4u o; o.x = pk2(v[0], v[1]); o.y = pk2(v[2], v[3]); o.z = pk2(v[4], v[5]); o.w = pk2(v[6], v[7]);
        *(v4u*)((bf16*)(A.ws + WS_WLORA) + (size_t)e * NLORA * KLORA + (size_t)n * KLORA + 8 * k8) = o;
    }
    for (int idx = gt; idx < 2 * 4096 * 32; idx += NGT) {
        const int o_ = idx / (4096 * 32); int r = idx - o_ * (4096 * 32); const int rr = r % 4096, k8 = r / 4096;
        const int j = rr >> 8, c = rr & 255, n = j >> 1, cc = (j & 1) * 128 + (c & 127);
        const float* src = (c < 128 ? A.in[32] : A.in[34]) + ((size_t)(o_ * 8 + n) * 256) * 256 + cc; float v[8];
#pragma unroll
        for (int i = 0; i < 8; ++i) v[i] = src[(size_t)(8 * k8 + i) * 256];
        v4u o; o.x = pk2(v[0], v[1]); o.y = pk2(v[2], v[3]); o.z = pk2(v[4], v[5]); o.w = pk2(v[6], v[7]);
        *(v4u*)((bf16*)(A.ws + WS_WLRU) + (size_t)o_ * 4096 * 256 + (size_t)rr * 256 + 8 * k8) = o;
    }
    {
        float* P = (float*)(A.ws + WS_PAR);
#define CPPAR(off, src, n) for (int i_ = gt; i_ < (n); i_ += NGT) P[(off) + i_] = (src)[i_];
        CPPAR(PAR_FFN1N, A.in[7], 8192) CPPAR(PAR_MIXN, A.in[10], 8192) CPPAR(PAR_FFN2N, A.in[11], 8192) CPPAR(PAR_FINN, A.in[38], 2048)
        CPPAR(PAR_MU, A.in[15], 7040) CPPAR(PAR_W0, A.in[16], 2048) CPPAR(PAR_A0, A.in[18], 2048) CPPAR(PAR_KK, A.in[21], 2048) CPPAR(PAR_KA, A.in[22], 2048)
        CPPAR(PAR_RK, A.in[23], 2048) CPPAR(PAR_LNW, A.in[24], 2048) CPPAR(PAR_LNB, A.in[25], 2048) CPPAR(PAR_HGLB, A.in[26], 2048) CPPAR(PAR_HGN, A.in[27], 2048)
        CPPAR(PAR_CONVW, A.in[30], 16384) CPPAR(PAR_CONVB, A.in[31], 4096) CPPAR(PAR_BA, A.in[33], 4096) CPPAR(PAR_BX, A.in[35], 4096) CPPAR(PAR_LAM, A.in[36], 4096)
#undef CPPAR
    }
    float* X = (float*)(A.ws + WS_X); bf16* XN = (bf16*)(A.ws + WS_XN);
    for (int m = gw; m < M; m += NGW) {
        const float* src = m < MP ? A.in[0] + (size_t)m * D : A.in[1] + (size_t)(m - MP) * D;
        norm_row(src, A.in[7], XN + (size_t)m * D, nullptr, X + (size_t)m * D, F.lane, 0, 0.f, nullptr, 0, nullptr, (float*)(A.ws + WS_RSTD) + m);
    }
}

__device__ __forceinline__ void norm_phase(const Args& A, Frame& F, const float* gain, bool final_, int sf, float scale) {
    const int gw = F.blk * NWAVES + F.wave, NGW = F.G * NWAVES;
    float* X = (float*)(A.ws + WS_X); bf16* XN = (bf16*)(A.ws + WS_XN);
    for (int m = gw; m < M; m += NGW)
        norm_row(X + (size_t)m * D, gain, final_ ? nullptr : XN + (size_t)m * D, final_ ? AOUT + O_Y + (size_t)m * D : nullptr, nullptr, F.lane, sf, scale, (const float*)(A.ws + WS_SLAB), m, X + (size_t)m * D);
}

__device__ __forceinline__ void rstd_phase(const Args& A, Frame& F, const float* gain, int sf, float scale) {
    float* X = (float*)(A.ws + WS_X); bf16* XN = (bf16*)(A.ws + WS_XN); float* RSTD = (float*)(A.ws + WS_RSTD); const float* SSP = (const float*)(A.ws + WS_SSP);
    if (sf > 0) {
        LAS float* red = (LAS float*)F.lds; const bf16* slab = (const bf16*)(A.ws + WS_SLAB); const int jj = F.wave, lane = F.lane;
        for (int m0 = MP + F.blk; m0 < M; m0 += 2 * F.G) {
            f32x4 v[2], add[2]; const f32x4 gq = ld4(gain + 256 * jj + 4 * lane);
#pragma unroll
            for (int q = 0; q < 2; ++q) { const int m = m0 + q * F.G; add[q] = (f32x4){0.f, 0.f, 0.f, 0.f}; v[q] = add[q];
                if (m < M) { v[q] = ld4(X + (size_t)m * D + 256 * jj + 4 * lane);
                    const bf16* sp = slab + (size_t)(((m >> 8) - 32) * 8 + jj) * sf * 65536 + (m & 255) * 256 + 4 * lane;
                    if (sf == 16) {
#pragma unroll
                        for (int p = 0; p < 16; ++p) add[q] += ldp4(sp + (size_t)p * 65536);
                    } else { for (int p = 0; p < sf; ++p) add[q] += ldp4(sp + (size_t)p * 65536); } } }
#pragma unroll
            for (int q = 0; q < 2; ++q) { const int m = m0 + q * F.G;
                if (m < M) { v[q] += add[q] * scale; *(f32x4*)(X + (size_t)m * D + 256 * jj + 4 * lane) = v[q]; st4bf(XN + (size_t)m * D + 256 * jj + 4 * lane, v[q] * gq); }
                const float s = wave_sum((v[q][0] * v[q][0] + v[q][1] * v[q][1]) + (v[q][2] * v[q][2] + v[q][3] * v[q][3]));
                if (lane == 0) red[q * 8 + jj] = s; }
            __syncthreads();
            if (F.tid < 2) { const int m = m0 + F.tid * F.G; const LAS float* rr = red + F.tid * 8;
                if (m < M) RSTD[m] = 1.0f / sqrtf(((rr[0] + rr[1]) + (rr[2] + rr[3]) + (rr[4] + rr[5]) + (rr[6] + rr[7])) * (1.0f / D) + 1e-6f); }
            __syncthreads();
        }
    }
    const int r1 = sf > 0 ? MP : M;
    for (int m = F.blk * NTHR + F.tid; m < r1; m += F.G * NTHR) { float s = 0.f;
#pragma unroll
        for (int q = 0; q < 8; ++q) { const f32x4 t = ld4(SSP + (size_t)m * 32 + 4 * q); s += (t[0] + t[1]) + (t[2] + t[3]); }
        RSTD[m] = 1.0f / sqrtf(s * (1.0f / D) + 1e-6f); }
}

__device__ __forceinline__ void e2_prep(const Args& A, Frame& F, int e) {
    const bf16* PROJ = (const bf16*)(A.ws + WS_PROJ); bf16* LA = (bf16*)(A.ws + WS_LA);
    const int gt = F.blk * NTHR + F.tid, NGT = F.G * NTHR;
    for (int idx = gt; idx < (M / 8) * 128; idx += NGT) {
        const int c4 = (idx & 127) * 4, m0 = (idx >> 7) * 8;
        if (c4 >= 448) {
#pragma unroll
            for (int r = 0; r < 8; ++r) st4bf(LA + (size_t)(m0 + r) * KLORA + c4, (f32x4){0.f, 0.f, 0.f, 0.f});
            continue; }
        const int col = 3072 + c4; f32x4 x[9];
#pragma unroll
        for (int r = 0; r < 8; ++r) x[r + 1] = ldp4(PROJ + (size_t)(m0 + r) * NEV + col);
        const bool prompt = m0 < MP;
        if (prompt) x[0] = (m0 & (TP - 1)) ? ldp4(PROJ + (size_t)(m0 - 1) * NEV + col) : (f32x4){0.f, 0.f, 0.f, 0.f};
        else x[0] = ld4(A.in[2] + (size_t)(((m0 - MP) >> 2) * 2 + e) * PRW + col);
        f32x4 xs4 = {0.f, 0.f, 0.f, 0.f}; if (!prompt) xs4 = ld4(A.in[2] + (size_t)((((m0 - MP) >> 2) + 1) * 2 + e) * PRW + col);
        const f32x4 mu = ld4(PARP(PAR_MU) + (size_t)e * PRW + col);
#pragma unroll
        for (int r = 0; r < 8; ++r) {
            const f32x4 pv = (!prompt && r == 4) ? xs4 : x[r], p = x[r + 1], z = p + (pv - p) * mu; f32x4 o;
#pragma unroll
            for (int i = 0; i < 4; ++i) o[i] = c4 < 96 ? 2.0f * sigm(2.0f * z[i]) - 1.0f : (c4 < 192 ? z[i] : sigm(z[i]));
            st4bf(LA + (size_t)(m0 + r) * KLORA + c4, o);
        }
    }
    for (int idx = gt; idx < NSEQ * (PRW / 4); idx += NGT) {
        const int q = idx / (PRW / 4), c4 = (idx % (PRW / 4)) * 4;
        const int m = q < BP ? q * TP + TP - 1 : MP + (q - BP) * TS + TS - 1;
        float* o = AOUT + (q < BP ? O_PSHIFT + (size_t)(q * 2 + e) * PRW : O_SSHIFT + (size_t)((q - BP) * 2 + e) * PRW) + c4;
        *(f32x4*)o = ldp4(PROJ + (size_t)m * NEV + c4);
    }
}

struct RwRaw { f32x4 pr, pk, pv, qr, qk, qv, wd, wa; };
__device__ __forceinline__ void rwkv_unit(const Args& A, Frame& F, int e, int q, int h) {
    const int tid = F.tid, hi = tid >> 4, lo = tid & 15;
    const bool prompt = q < BP; const int T = prompt ? TP : TS, row0 = prompt ? q * TP : MP + (q - BP) * TS, bs = q - BP;
    const bf16* PROJ = (const bf16*)(A.ws + WS_PROJ); const float* WAG = (const float*)(A.ws + WS_WAG); bf16* YIN = (bf16*)(A.ws + WS_YIN);
    LAS float* cb = (LAS float*)F.lds; LAS float* ob = cb + 2 * 32 * 384;
    const int hc = h * 64 + 4 * lo;
    const float* mu = PARP(PAR_MU) + (size_t)e * PRW;
    const f32x4 mu_r = ld4(mu + hc), mu_k = ld4(mu + 1024 + hc), mu_v = ld4(mu + 2048 + hc);
    const f32x4 k_k = ld4(PARP(PAR_KK) + e * 1024 + hc), k_a = ld4(PARP(PAR_KA) + e * 1024 + hc);
    const int hs = (tid >> 3) & 31, ls = tid & 7; const bool stepper = tid < 256;
    f32x4 S[2][2];
#pragma unroll
    for (int i = 0; i < 2; ++i)
#pragma unroll
        for (int c = 0; c < 2; ++c) {
            S[i][c] = (f32x4){0.f, 0.f, 0.f, 0.f};
            if (!prompt && stepper) S[i][c] = ld4(A.in[3] + ((size_t)(bs * 2 + e) * 16 + h) * 4096 + (2 * hs + i) * 64 + 8 * ls + 4 * c);
        }
    const int nch = (T + 31) / 32;
    RwRaw raw = {};
#define RW_LOAD_RAW(ci_) do { const int t_ = (ci_) * 32 + hi; \
        if (t_ < T) { const size_t m_ = (size_t)(row0 + t_); \
            raw.pr = ldp4(PROJ + m_ * NEV + hc); raw.pk = ldp4(PROJ + m_ * NEV + 1024 + hc); raw.pv = ldp4(PROJ + m_ * NEV + 2048 + hc); \
            raw.wd = ld4(WAG + m_ * NLORA + hc); raw.wa = ld4(WAG + m_ * NLORA + 1024 + hc); \
            if (t_ > 0) { raw.qr = ldp4(PROJ + (m_ - 1) * NEV + hc); raw.qk = ldp4(PROJ + (m_ - 1) * NEV + 1024 + hc); raw.qv = ldp4(PROJ + (m_ - 1) * NEV + 2048 + hc); } \
            else if (!prompt) { const float* sh_ = A.in[2] + (size_t)(bs * 2 + e) * PRW; raw.qr = ld4(sh_ + hc); raw.qk = ld4(sh_ + 1024 + hc); raw.qv = ld4(sh_ + 2048 + hc); } \
            else { raw.qr = (f32x4){0.f, 0.f, 0.f, 0.f}; raw.qk = raw.qr; raw.qv = raw.qr; } } } while (0)
    RW_LOAD_RAW(0);
    for (int ci = 0; ci < nch; ++ci) {
        const int t0 = ci * 32, t = t0 + hi; const bool valid = t < T;
        LAS float* cbb = cb + (ci & 1) * (32 * 384); LAS float* obb = ob + (ci & 1) * (32 * 64);
        if (valid) {
            const f32x4 zr = raw.pr + (raw.qr - raw.pr) * mu_r, zk = raw.pk + (raw.qk - raw.pk) * mu_k, zv = raw.pv + (raw.qv - raw.pv) * mu_v;
            f32x4 kk = zk * k_k;
            const float ss = red16((kk[0] * kk[0] + kk[1] * kk[1]) + (kk[2] * kk[2] + kk[3] * kk[3]));
            kk = kk * (1.0f / fmaxf(sqrtf(ss), 1e-12f));
            const f32x4 kp = zk * (1.0f + (raw.wa - 1.0f) * k_a), bb = kk * raw.wa;
            LAS float* p = cbb + hi * 384 + 4 * lo;
            *(LAS f32x4*)(p) = zr; *(LAS f32x4*)(p + 64) = raw.wd; *(LAS f32x4*)(p + 128) = kp; *(LAS f32x4*)(p + 192) = kk; *(LAS f32x4*)(p + 256) = bb; *(LAS f32x4*)(p + 320) = zv;
        }
        __syncthreads();
        if (ci + 1 < nch) RW_LOAD_RAW(ci + 1);
        const int ns = (T - t0) < 32 ? (T - t0) : 32;
        if (stepper) {
            f32x4 r4[2], w4[2], kp4[2], kk4[2], bb4[2]; f32x2 v2;
#define RW_LD(s_) do { const LAS float* p_ = cbb + (s_) * 384 + 8 * ls; \
            r4[0] = *(const LAS f32x4*)(p_); r4[1] = *(const LAS f32x4*)(p_ + 4); w4[0] = *(const LAS f32x4*)(p_ + 64); w4[1] = *(const LAS f32x4*)(p_ + 68); \
            kp4[0] = *(const LAS f32x4*)(p_ + 128); kp4[1] = *(const LAS f32x4*)(p_ + 132); kk4[0] = *(const LAS f32x4*)(p_ + 192); kk4[1] = *(const LAS f32x4*)(p_ + 196); \
            bb4[0] = *(const LAS f32x4*)(p_ + 256); bb4[1] = *(const LAS f32x4*)(p_ + 260); v2 = *(const LAS f32x2*)(cbb + (s_) * 384 + 320 + 2 * hs); } while (0)
            RW_LD(0);
            for (int s = 0; s < ns; ++s) {
                const f32x4 cr0 = r4[0], cr1 = r4[1], cw0 = w4[0], cw1 = w4[1], ck0 = kp4[0], ck1 = kp4[1], cq0 = kk4[0], cq1 = kk4[1], cb0 = bb4[0], cb1 = bb4[1]; const f32x2 cv = v2;
                if (s + 1 < ns) RW_LD(s + 1);
                float sa[2], o[2];
#pragma unroll
                for (int i = 0; i < 2; ++i) { const f32x4 t = S[i][0] * cq0 + S[i][1] * cq1; sa[i] = -red8((t[0] + t[1]) + (t[2] + t[3])); }
#pragma unroll
                for (int i = 0; i < 2; ++i) { S[i][0] = S[i][0] * cw0 + cb0 * sa[i] + ck0 * cv[i]; S[i][1] = S[i][1] * cw1 + cb1 * sa[i] + ck1 * cv[i]; }
#pragma unroll
                for (int i = 0; i < 2; ++i) { const f32x4 t = S[i][0] * cr0 + S[i][1] * cr1; o[i] = red8((t[0] + t[1]) + (t[2] + t[3])); }
                if (ls == 0) *(LAS f32x2*)(obb + s * 64 + 2 * hs) = (f32x2){o[0], o[1]};
            }
#undef RW_LD
        }
        __syncthreads();
        if (valid) {
            const size_t m = (size_t)(row0 + t);
            const f32x4 o4 = *(const LAS f32x4*)(obb + hi * 64 + 4 * lo);
            const float mean = red16((o4[0] + o4[1]) + (o4[2] + o4[3])) * (1.0f / 64.0f);
            const f32x4 d = o4 - mean;
            const float var = red16((d[0] * d[0] + d[1] * d[1]) + (d[2] * d[2] + d[3] * d[3])) * (1.0f / 64.0f);
            const float rs = 1.0f / sqrtf(var + 64e-5f);
            const LAS float* p = cbb + hi * 384 + 4 * lo;
            const f32x4 r4 = *(const LAS f32x4*)(p), kp4 = *(const LAS f32x4*)(p + 128), v4 = *(const LAS f32x4*)(p + 320);
            const f32x4 rk = ld4(PARP(PAR_RK) + e * 1024 + hc);
            const float bonus = red16((r4[0] * kp4[0] * rk[0] + r4[1] * kp4[1] * rk[1]) + (r4[2] * kp4[2] * rk[2] + r4[3] * kp4[3] * rk[3]));
            const f32x4 on = d * rs * ld4(PARP(PAR_LNW) + e * 1024 + hc) + ld4(PARP(PAR_LNB) + e * 1024 + hc) + v4 * bonus;
            st4bf(YIN + m * D + hc, on * ld4(WAG + m * NLORA + 2048 + hc));
        }
    }
    float* so = AOUT + (prompt ? O_PRWKV + ((size_t)(q * 2 + e) * 16 + h) * 4096 : O_SRWKV + ((size_t)(bs * 2 + e) * 16 + h) * 4096);
    if (stepper) {
#pragma unroll
        for (int i = 0; i < 2; ++i)
#pragma unroll
            for (int c = 0; c < 2; ++c) *(f32x4*)(so + (2 * hs + i) * 64 + 8 * ls + 4 * c) = S[i][c];
    }
    __syncthreads();
}

__device__ __forceinline__ float hg_lb(const Args& A, int e, int ch) {
    if (e == 0) return 0.f;
    const float l0 = PARP(PAR_HGLB)[ch], l1 = PARP(PAR_HGLB)[1024 + ch]; return sigm(l1 - l0);
}
constexpr int HG_S = 130, HG_VS = 132;
typedef short hbf16x8 __attribute__((ext_vector_type(8)));
__device__ __forceinline__ hbf16x8 pack8_strided(const LAS float* p, int st) {
    v4u o; o.x = cvt_pk_bf16(p[0], p[st]); o.y = cvt_pk_bf16(p[2 * st], p[3 * st]); o.z = cvt_pk_bf16(p[4 * st], p[5 * st]); o.w = cvt_pk_bf16(p[6 * st], p[7 * st]); return __builtin_bit_cast(hbf16x8, o); }
__device__ __forceinline__ void hgrn_chunk_unit(const Args& A, Frame& F, int e, int b, int h, int c) {
    const int tid = F.tid, lane = F.lane, w = F.wave, g = lane >> 4, i = lane & 15;
    const bf16* PROJ = (const bf16*)(A.ws + WS_PROJ);
    float* OI = (float*)(A.ws + WS_OI); float* QT = (float*)(A.ws + WS_QT); float* HU = (float*)(A.ws + WS_HU); float* HD = (float*)(A.ws + WS_HD);
    LAS float* Qs = (LAS float*)F.lds; LAS float* Ks = Qs + 64 * HG_S; LAS float* Vs = Ks + 64 * HG_S; LAS float* Gs = Vs + 64 * HG_VS; LAS float* As = Gs;
    LAS float* GB = Gs + 64 * HG_S; LAS float* EJ = GB + 5 * 128;
    const int m0 = b * TP + c * 64, unit = (b * 8 + h) * 32 + c;
    f32x4 lbv;
#pragma unroll
    for (int j = 0; j < 4; ++j) lbv[j] = hg_lb(A, e, h * 128 + (tid & 31) * 4 + j);
    f32x4 qv4[4], fv4[4], iv4[4];
#pragma unroll
    for (int it = 0; it < 4; ++it) { const int idx = tid + 512 * it, row = idx >> 5, c4 = (idx & 31) * 4;
        const bf16* pr = PROJ + (size_t)(m0 + row) * NEV + PRW + h * 128 + c4; qv4[it] = ldp4(pr); fv4[it] = ldp4(pr + 1024); iv4[it] = ldp4(pr + 2048); }
#pragma unroll
    for (int it = 0; it < 4; ++it) {
        const int idx = tid + 512 * it, row = idx >> 5, c4 = (idx & 31) * 4;
        const f32x4 qv = qv4[it], fv = fv4[it], iv = iv4[it];
#pragma unroll
        for (int j = 0; j < 4; ++j) {
            const float lb = lbv[j], sg = fmaxf(sigm(fv[j]), 1e-37f);
            Qs[row * HG_S + c4 + j] = silu_(qv[j]);
            Gs[row * HG_S + c4 + j] = __logf(lb + (1.0f - lb) * sg);
            Ks[row * HG_S + c4 + j] = (1.0f - lb) * (1.0f - sg);
        }
        *(LAS f32x4*)(Vs + row * HG_VS + c4) = iv;
    }
    __syncthreads();
    LAS float* TQ = EJ + 512;
    { const int k = tid & 127, I = tid >> 7; float run = 0.f;
#pragma unroll
        for (int t = 0; t < 16; ++t) { run += Gs[(16 * I + t) * HG_S + k]; Gs[(16 * I + t) * HG_S + k] = run; }
        TQ[tid] = run; }
    __syncthreads();
    { const int J = tid >> 7, k = tid & 127; const float t0 = TQ[k], t1 = TQ[128 + k], t2 = TQ[256 + k], t3 = TQ[384 + k];
      const float gbJ = J == 0 ? 0.f : (J == 1 ? t0 : (J == 2 ? t0 + t1 : (t0 + t1) + t2)), gl = ((t0 + t1) + t2) + t3;
      GB[J * 128 + k] = gbJ; if (J == 3) GB[4 * 128 + k] = gl; EJ[tid] = __expf(gl - gbJ); if (J == 0) HD[unit * 128 + k] = __expf(gl); }
#pragma unroll
    for (int it = 0; it < 4; ++it) {
        const int idx = tid + 512 * it, row = idx >> 5, c4 = (idx & 31) * 4, I = row >> 4; f32x4 o;
#pragma unroll
        for (int j = 0; j < 4; ++j) { const int kc = c4 + j; const float q = Qs[row * HG_S + kc], G = Gs[row * HG_S + kc];
            const float gb = I == 0 ? 0.f : (I == 1 ? TQ[kc] : (I == 2 ? TQ[kc] + TQ[128 + kc] : (TQ[kc] + TQ[128 + kc]) + TQ[256 + kc]));
            o[j] = q * __expf(G + gb); Qs[row * HG_S + kc] = q * __expf(G); Ks[row * HG_S + kc] *= __expf(fminf(-G, 80.0f)); }
        *(f32x4*)(QT + (size_t)(m0 + row) * 1024 + h * 128 + c4) = o;
    }
    __syncthreads();
    for (int pi = w; pi < 10; pi += 8) {
        const int I = pi < 1 ? 0 : (pi < 3 ? 1 : (pi < 6 ? 2 : 3)), J = pi - (I * (I + 1)) / 2;
        f32x4 acc = {0.f, 0.f, 0.f, 0.f};
#pragma unroll 8
        for (int s = 0; s < 32; ++s) { const int k = 4 * s + g;
            float av = Qs[(16 * I + i) * HG_S + k]; if (I != J) av *= __expf(GB[I * 128 + k] - GB[J * 128 + k]);
            acc = __builtin_amdgcn_mfma_f32_16x16x4f32(av, Ks[(16 * J + i) * HG_S + k], acc, 0, 0, 0); }
#pragma unroll
        for (int r = 0; r < 4; ++r) As[(16 * I + 4 * g + r) * 66 + 16 * J + i] = (I != J || i <= 4 * g + r) ? acc[r] : 0.f;
    }
    __syncthreads();
    {
        hbf16x8 vB[2];
#pragma unroll
        for (int ks = 0; ks < 2; ++ks) vB[ks] = pack8_strided(Vs + (32 * ks + 8 * g) * HG_VS + 16 * w + i, HG_VS);
#pragma unroll
        for (int I = 0; I < 4; ++I) {
            f32x4 acc = {0.f, 0.f, 0.f, 0.f};
#pragma unroll
            for (int ks = 0; ks < 2; ++ks) if (32 * ks < 16 * (I + 1)) {
                hbf16x8 aA = pack8_strided(As + (16 * I + i) * 66 + 32 * ks + 8 * g, 1);
                if (32 * ks + 8 * g >= 16 * (I + 1)) aA = (hbf16x8){0, 0, 0, 0, 0, 0, 0, 0};
                acc = __builtin_amdgcn_mfma_f32_16x16x32_bf16(aA, vB[ks], acc, 0, 0, 0); }
#pragma unroll
            for (int r = 0; r < 4; ++r) OI[(size_t)(m0 + 16 * I + 4 * g + r) * 1024 + h * 128 + 16 * w + i] = acc[r];
        }
        hbf16x8 kA[2];
#pragma unroll
        for (int ks = 0; ks < 2; ++ks) { const LAS float* p = Ks + (32 * ks + 8 * g) * HG_S + 16 * w + i; const int J = (32 * ks + 8 * g) >> 4; const float ej = EJ[J * 128 + 16 * w + i];
            v4u o; o.x = cvt_pk_bf16(p[0] * ej, p[HG_S] * ej); o.y = cvt_pk_bf16(p[2 * HG_S] * ej, p[3 * HG_S] * ej); o.z = cvt_pk_bf16(p[4 * HG_S] * ej, p[5 * HG_S] * ej); o.w = cvt_pk_bf16(p[6 * HG_S] * ej, p[7 * HG_S] * ej);
            kA[ks] = __builtin_bit_cast(hbf16x8, o); }
#pragma unroll 2
        for (int vb = 0; vb < 8; ++vb) {
            f32x4 acc = {0.f, 0.f, 0.f, 0.f};
#pragma unroll
            for (int ks = 0; ks < 2; ++ks) acc = __builtin_amdgcn_mfma_f32_16x16x32_bf16(kA[ks], pack8_strided(Vs + (32 * ks + 8 * g) * HG_VS + 16 * vb + i, HG_VS), acc, 0, 0, 0);
#pragma unroll
            for (int r = 0; r < 4; ++r) HU[(size_t)unit * 16384 + (16 * w + 4 * g + r) * 128 + 16 * vb + i] = acc[r];
        }
    }
    __syncthreads();
}
constexpr int HC_S = 132, HC_T = 72;
#define HC_SW(rc_, t_) ((rc_) * HC_T + ((((t_) >> 3) ^ (((rc_) >> 2) & 7)) << 3) + ((t_) & 7))
__device__ __forceinline__ hbf16x8 pk8f(const f32x4& a, const f32x4& b) { v4u o; o.x = cvt_pk_bf16(a[0], a[1]); o.y = cvt_pk_bf16(a[2], a[3]); o.z = cvt_pk_bf16(b[0], b[1]); o.w = cvt_pk_bf16(b[2], b[3]); return __builtin_bit_cast(hbf16x8, o); }
__device__ __forceinline__ void hgrn_chunk_unit2(const Args& A, Frame& F, int e, int b, int h, int c) {
    const int tid = F.tid, lane = F.lane, w = F.wave, g = lane >> 4, i = lane & 15;
    const bf16* PROJ = (const bf16*)(A.ws + WS_PROJ);
    float* OI = (float*)(A.ws + WS_OI); float* QT = (float*)(A.ws + WS_QT); float* HU = (float*)(A.ws + WS_HU); float* HD = (float*)(A.ws + WS_HD);
    LAS float* Qs = (LAS float*)F.lds; LAS float* Ks = Qs + 64 * HC_S; LAS float* Gs = Ks + 64 * HC_S;
    LAS unsigned short* AsB = (LAS unsigned short*)Gs;
    LAS unsigned short* VT = (LAS unsigned short*)(Gs + 64 * HC_S);
    LAS unsigned short* KT = VT + 128 * HC_T;
    LAS float* GB = (LAS float*)(KT + 128 * HC_T); LAS float* TQ = GB + 5 * 128;
    const int m0 = b * TP + c * 64, unit = (b * 8 + h) * 32 + c;
    f32x4 lbv;
#pragma unroll
    for (int j = 0; j < 4; ++j) lbv[j] = hg_lb(A, e, h * 128 + (tid & 31) * 4 + j);
    v2u qr4[4], fr4[4], ir4[4];
#pragma unroll
    for (int it = 0; it < 4; ++it) { const int idx = tid + 512 * it, row = idx >> 5, c4 = (idx & 31) * 4;
        const bf16* pr = PROJ + (size_t)(m0 + row) * NEV + PRW + h * 128 + c4; qr4[it] = *(const v2u*)pr; fr4[it] = *(const v2u*)(pr + 1024); ir4[it] = *(const v2u*)(pr + 2048); }
#pragma unroll
    for (int it = 0; it < 4; ++it) {
        const int idx = tid + 512 * it, row = idx >> 5, c4 = (idx & 31) * 4;
        const f32x4 qv = {bf2f(qr4[it].x & 0xffffu), bf2f(qr4[it].x >> 16), bf2f(qr4[it].y & 0xffffu), bf2f(qr4[it].y >> 16)};
        const f32x4 fv = {bf2f(fr4[it].x & 0xffffu), bf2f(fr4[it].x >> 16), bf2f(fr4[it].y & 0xffffu), bf2f(fr4[it].y >> 16)};
        f32x4 Q4, G4, K4;
#pragma unroll
        for (int j = 0; j < 4; ++j) { const float lb = lbv[j], sg = fmaxf(sigm(fv[j]), 1e-37f);
            Q4[j] = silu_(qv[j]); G4[j] = __logf(lb + (1.0f - lb) * sg); K4[j] = (1.0f - lb) * (1.0f - sg); }
        *(LAS f32x4*)(Qs + row * HC_S + c4) = Q4; *(LAS f32x4*)(Gs + row * HC_S + c4) = G4; *(LAS f32x4*)(Ks + row * HC_S + c4) = K4;
        VT[HC_SW(c4 + 0, row)] = (unsigned short)(ir4[it].x & 0xffffu); VT[HC_SW(c4 + 1, row)] = (unsigned short)(ir4[it].x >> 16);
        VT[HC_SW(c4 + 2, row)] = (unsigned short)(ir4[it].y & 0xffffu); VT[HC_SW(c4 + 3, row)] = (unsigned short)(ir4[it].y >> 16);
    }
    __syncthreads();
    { const int k = tid & 127, I = tid >> 7; float run = 0.f;
#pragma unroll
        for (int t = 0; t < 16; ++t) { run += Gs[(16 * I + t) * HC_S + k]; Gs[(16 * I + t) * HC_S + k] = run; }
        TQ[tid] = run; }
    __syncthreads();
    { const int J = tid >> 7, k = tid & 127; const float t0 = TQ[k], t1 = TQ[128 + k], t2 = TQ[256 + k], t3 = TQ[384 + k];
      const float gbJ = J == 0 ? 0.f : (J == 1 ? t0 : (J == 2 ? t0 + t1 : (t0 + t1) + t2)), gl = ((t0 + t1) + t2) + t3;
      GB[J * 128 + k] = gbJ; if (J == 3) GB[4 * 128 + k] = gl; if (J == 0) HD[unit * 128 + k] = __expf(gl); }
#pragma unroll
    for (int it = 0; it < 4; ++it) {
        const int idx = tid + 512 * it, row = idx >> 5, c4 = (idx & 31) * 4, I = row >> 4;
        const f32x4 q4 = *(const LAS f32x4*)(Qs + row * HC_S + c4), G4 = *(const LAS f32x4*)(Gs + row * HC_S + c4), K4 = *(const LAS f32x4*)(Ks + row * HC_S + c4);
        const f32x4 t0 = *(const LAS f32x4*)(TQ + c4), t1 = *(const LAS f32x4*)(TQ + 128 + c4), t2 = *(const LAS f32x4*)(TQ + 256 + c4), t3 = *(const LAS f32x4*)(TQ + 384 + c4);
        const f32x4 z4 = {0.f, 0.f, 0.f, 0.f};
        const f32x4 gb = I == 0 ? z4 : (I == 1 ? t0 : (I == 2 ? t0 + t1 : (t0 + t1) + t2)), gl = ((t0 + t1) + t2) + t3;
        f32x4 o, Qn, Kn, ke;
#pragma unroll
        for (int j = 0; j < 4; ++j) { o[j] = q4[j] * __expf(G4[j] + gb[j]); Qn[j] = q4[j] * __expf(G4[j]); Kn[j] = K4[j] * __expf(fminf(-G4[j], 80.0f)); ke[j] = Kn[j] * __expf(gl[j] - gb[j]); }
        st4bf((bf16*)QT + (size_t)(m0 + row) * 1024 + h * 128 + c4, o);
        *(LAS f32x4*)(Qs + row * HC_S + c4) = Qn; *(LAS f32x4*)(Ks + row * HC_S + c4) = Kn;
        const unsigned k01 = cvt_pk_bf16(ke[0], ke[1]), k23 = cvt_pk_bf16(ke[2], ke[3]);
        KT[HC_SW(c4 + 0, row)] = (unsigned short)(k01 & 0xffffu); KT[HC_SW(c4 + 1, row)] = (unsigned short)(k01 >> 16);
        KT[HC_SW(c4 + 2, row)] = (unsigned short)(k23 & 0xffffu); KT[HC_SW(c4 + 3, row)] = (unsigned short)(k23 >> 16);
    }
    __syncthreads();
    for (int pi = w; pi < 10; pi += 8) {
        const int I = pi < 1 ? 0 : (pi < 3 ? 1 : (pi < 6 ? 2 : 3)), J = pi - (I * (I + 1)) / 2;
        f32x4 acc = {0.f, 0.f, 0.f, 0.f};
#pragma unroll
        for (int ks = 0; ks < 4; ++ks) { const int kb = 32 * ks + 8 * g;
            f32x4 a0 = *(const LAS f32x4*)(Qs + (16 * I + i) * HC_S + kb), a1 = *(const LAS f32x4*)(Qs + (16 * I + i) * HC_S + kb + 4);
            if (I != J) { const f32x4 d0 = *(const LAS f32x4*)(GB + I * 128 + kb) - *(const LAS f32x4*)(GB + J * 128 + kb), d1 = *(const LAS f32x4*)(GB + I * 128 + kb + 4) - *(const LAS f32x4*)(GB + J * 128 + kb + 4);
#pragma unroll
                for (int j = 0; j < 4; ++j) { a0[j] *= __expf(d0[j]); a1[j] *= __expf(d1[j]); } }
            const f32x4 b0 = *(const LAS f32x4*)(Ks + (16 * J + i) * HC_S + kb), b1 = *(const LAS f32x4*)(Ks + (16 * J + i) * HC_S + kb + 4);
            acc = __builtin_amdgcn_mfma_f32_16x16x32_bf16(pk8f(a0, a1), pk8f(b0, b1), acc, 0, 0, 0); }
#pragma unroll
        for (int r = 0; r < 4; ++r) { const int t = 4 * g + r; const float v = (I != J || i <= t) ? acc[r] : 0.f;
            AsB[(16 * I + t) * HC_T + 16 * J + i] = (unsigned short)(cvt_pk_bf16(v, 0.f) & 0xffffu); }
    }
    __syncthreads();
    {
        hbf16x8 vB[2];
#pragma unroll
        for (int ks = 0; ks < 2; ++ks) vB[ks] = *(const LAS hbf16x8*)(VT + HC_SW(16 * w + i, 32 * ks + 8 * g));
#pragma unroll
        for (int I = 0; I < 4; ++I) {
            f32x4 acc = {0.f, 0.f, 0.f, 0.f};
#pragma unroll
            for (int ks = 0; ks < 2; ++ks) if (32 * ks < 16 * (I + 1)) {
                hbf16x8 aA = *(const LAS hbf16x8*)(AsB + (16 * I + i) * HC_T + 32 * ks + 8 * g);
                if (32 * ks + 8 * g >= 16 * (I + 1)) aA = (hbf16x8){0, 0, 0, 0, 0, 0, 0, 0};
                acc = __builtin_amdgcn_mfma_f32_16x16x32_bf16(vB[ks], aA, acc, 0, 0, 0); }
            st4bf((bf16*)OI + (size_t)(m0 + 16 * I + i) * 1024 + h * 128 + 16 * w + 4 * g, acc);
        }
        hbf16x8 kA[2];
#pragma unroll
        for (int ks = 0; ks < 2; ++ks) kA[ks] = *(const LAS hbf16x8*)(KT + HC_SW(16 * w + i, 32 * ks + 8 * g));
#pragma unroll
        for (int vb = 0; vb < 8; ++vb) {
            f32x4 acc = {0.f, 0.f, 0.f, 0.f};
#pragma unroll
            for (int ks = 0; ks < 2; ++ks) acc = __builtin_amdgcn_mfma_f32_16x16x32_bf16(*(const LAS hbf16x8*)(VT + HC_SW(16 * vb + i, 32 * ks + 8 * g)), kA[ks], acc, 0, 0, 0);
            st4bf((bf16*)HU + (size_t)unit * 16384 + (16 * w + i) * 128 + 16 * vb + 4 * g, acc);
        }
    }
    __syncthreads();
}
__device__ __forceinline__ void hgrn_sample_unit(const Args& A, Frame& F, int e, int bs, int h) {
    const int tid = F.tid;
    const bf16* PROJ = (const bf16*)(A.ws + WS_PROJ); bf16* YIN = (bf16*)(A.ws + WS_YIN);
    LAS float* sq = (LAS float*)F.lds; LAS float* sf = sq + 512; LAS float* sk = sf + 512; LAS float* po = sk + 512; LAS float* pn = po + 2048;
    const int mrow = MP + bs * TS;
    { const int t = tid >> 7, k = tid & 127; const bf16* pr = PROJ + (size_t)(mrow + t) * NEV + PRW + h * 128 + k;
      const float qv = bf2f(pr[0]), fv = bf2f(pr[1024]), lb = hg_lb(A, e, h * 128 + k);
      sq[tid] = silu_(qv); sf[tid] = lb + (1.0f - lb) * sigm(fv); sk[tid] = (1.0f - lb) * sigm(-fv); }
    const int v = tid & 127, kq = tid >> 7;
    const size_t sbase = (((size_t)(bs * 2 + e) * 8 + h) * 128) * 128;
    float S[32];
#pragma unroll
    for (int j = 0; j < 32; ++j) S[j] = A.in[4][sbase + (size_t)(32 * kq + j) * 128 + v];
    float vt[4];
#pragma unroll
    for (int t = 0; t < 4; ++t) vt[t] = bf2f(PROJ[(size_t)(mrow + t) * NEV + PRW + 2048 + h * 128 + v]);
    __syncthreads();
#pragma unroll
    for (int t = 0; t < 4; ++t) { float o = 0.f;
#pragma unroll
        for (int j = 0; j < 32; ++j) { const int k = t * 128 + 32 * kq + j; S[j] = sf[k] * S[j] + sk[k] * vt[t]; o += S[j] * sq[k]; }
        po[(t * 4 + kq) * 128 + v] = o; }
    __syncthreads();
    { const int t = tid >> 7; const float o = (po[(t * 4 + 0) * 128 + v] + po[(t * 4 + 1) * 128 + v]) + (po[(t * 4 + 2) * 128 + v] + po[(t * 4 + 3) * 128 + v]);
      const float ss = wave_sum(o * o); if (F.lane == 0) pn[F.wave] = ss;
      __syncthreads();
      const float tot = pn[(F.wave & ~1)] + pn[(F.wave | 1)];
      const size_t m = (size_t)(mrow + t);
      const float og = bf2f(PROJ[m * NEV + PRW + 3072 + h * 128 + v]);
      const float y = o * (1.0f / sqrtf(tot * (1.0f / 128.0f) + 1e-5f)) * PARP(PAR_HGN)[e * 1024 + h * 128 + v] * silu_(og);
      YIN[m * D + 1024 + h * 128 + v] = (bf16)f2bf(y); }
    float* so = AOUT + O_SHGRN + sbase;
#pragma unroll
    for (int j = 0; j < 32; ++j) so[(size_t)(32 * kq + j) * 128 + v] = S[j];
    __syncthreads();
}
__device__ __forceinline__ void hgrn_state_scan(const Args& A, Frame& F, int e) {
    float* HU = (float*)(A.ws + WS_HU); const float* HD = (const float*)(A.ws + WS_HD);
    const int gt = F.blk * NTHR + F.tid, NGT = F.G * NTHR;
    for (int idx = gt; idx < BP * 8 * 128 * 32; idx += NGT) {
        const int v4 = (idx & 31) * 4, k = (idx >> 5) & 127, bh = idx >> 12;
        f32x4 S = {0.f, 0.f, 0.f, 0.f};
#pragma unroll 1
        for (int c0 = 0; c0 < 32; c0 += 8) {
            f32x4 u[8]; float dcy[8];
#pragma unroll
            for (int q = 0; q < 8; ++q) { const int unit = bh * 32 + c0 + q; u[q] = ldp4((const bf16*)HU + (size_t)unit * 16384 + k * 128 + v4); dcy[q] = HD[unit * 128 + k]; }
#pragma unroll
            for (int q = 0; q < 8; ++q) { const int unit = bh * 32 + c0 + q; st4bf((bf16*)HU + (size_t)unit * 16384 + k * 128 + v4, S); S = S * dcy[q] + u[q]; }
        }
        const int b = bh >> 3, h = bh & 7;
        *(f32x4*)(AOUT + O_PHGRN + (((size_t)(b * 2 + e) * 8 + h) * 128 + k) * 128 + v4) = S;
    }
}
struct HfRaw { v2u qt[4], hu[8]; };
__device__ __forceinline__ void hgrn_finish_load(const Args& A, Frame& F, int b, int h, int c, HfRaw& r) {
    const float* QT = (const float*)(A.ws + WS_QT); const float* HU = (const float*)(A.ws + WS_HU);
    const int tid = F.tid, m0 = b * TP + c * 64, unit = (b * 8 + h) * 32 + c;
#pragma unroll
    for (int it = 0; it < 4; ++it) { const int idx = tid + 512 * it, row = idx >> 5, c4 = (idx & 31) * 4; r.qt[it] = *(const v2u*)((const bf16*)QT + (size_t)(m0 + row) * 1024 + h * 128 + c4); }
#pragma unroll
    for (int it = 0; it < 8; ++it) { const int idx = tid + 512 * it, row = idx >> 5, c4 = (idx & 31) * 4; r.hu[it] = *(const v2u*)((const bf16*)HU + (size_t)unit * 16384 + row * 128 + c4); }
}
__device__ __forceinline__ void hgrn_finish_unit(const Args& A, Frame& F, int e, int b, int h, int c, const HfRaw& raw, bool has_next, int nb, int nh, int nc, HfRaw& nraw) {
    const int tid = F.tid, lane = F.lane, w = F.wave, g = lane >> 4, i = lane & 15;
    const bf16* PROJ = (const bf16*)(A.ws + WS_PROJ); const float* OI = (const float*)(A.ws + WS_OI); bf16* YIN = (bf16*)(A.ws + WS_YIN);
    LAS float* Qt = (LAS float*)F.lds; LAS float* Ss = Qt + 64 * HG_S; LAS float* Os = Ss + 128 * HG_VS;
    LAS unsigned short* QtB = (LAS unsigned short*)Qt;
    const int m0 = b * TP + c * 64;
#pragma unroll
    for (int it = 0; it < 4; ++it) { const int idx = tid + 512 * it, row = idx >> 5, c4 = (idx & 31) * 4; *(LAS v2u*)(QtB + row * 136 + c4) = raw.qt[it]; }
#pragma unroll
    for (int it = 0; it < 8; ++it) { const int idx = tid + 512 * it, row = idx >> 5, c4 = (idx & 31) * 4; *(LAS f32x4*)(Ss + row * HG_VS + c4) = cvq(raw.hu[it]); }
    __syncthreads();
    v2u oi[4];
#pragma unroll
    for (int tb = 0; tb < 4; ++tb) oi[tb] = *(const v2u*)((const bf16*)OI + (size_t)(m0 + 16 * tb + i) * 1024 + h * 128 + 16 * w + 4 * g);
    const int t = tid >> 3, vg = tid & 7; const size_t m = (size_t)(m0 + t);
    f32x4 og[4], gn[4];
#pragma unroll
    for (int jj = 0; jj < 4; ++jj) { const int ch = h * 128 + 4 * vg + 32 * jj; og[jj] = ldp4(PROJ + m * NEV + PRW + 3072 + ch); gn[jj] = ld4(PARP(PAR_HGN) + e * 1024 + ch); }
    if (has_next) hgrn_finish_load(A, F, nb, nh, nc, nraw);
    {
        hbf16x8 sB[4];
#pragma unroll
        for (int ks = 0; ks < 4; ++ks) sB[ks] = pack8_strided(Ss + (32 * ks + 8 * g) * HG_VS + 16 * w + i, HG_VS);
#pragma unroll
        for (int tb = 0; tb < 4; ++tb) {
            f32x4 acc = cvq(oi[tb]);
#pragma unroll
            for (int ks = 0; ks < 4; ++ks) acc = __builtin_amdgcn_mfma_f32_16x16x32_bf16(sB[ks], *(const LAS hbf16x8*)(QtB + (16 * tb + i) * 136 + 32 * ks + 8 * g), acc, 0, 0, 0);
            *(LAS f32x4*)(Os + (16 * tb + i) * HG_VS + 16 * w + 4 * g) = acc;
        }
    }
    __syncthreads();
    f32x4 acc[4]; float ss = 0.f;
#pragma unroll
    for (int jj = 0; jj < 4; ++jj) {
#pragma unroll
        for (int q = 0; q < 4; ++q) acc[jj][q] = Os[t * HG_VS + 4 * vg + 32 * jj + q];
        ss += (acc[jj][0] * acc[jj][0] + acc[jj][1] * acc[jj][1]) + (acc[jj][2] * acc[jj][2] + acc[jj][3] * acc[jj][3]); }
    const float rs = 1.0f / sqrtf(red8(ss) * (1.0f / 128.0f) + 1e-5f);
#pragma unroll
    for (int jj = 0; jj < 4; ++jj) { const int ch = h * 128 + 4 * vg + 32 * jj; f32x4 y;
#pragma unroll
        for (int q = 0; q < 4; ++q) y[q] = acc[jj][q] * rs * gn[jj][q] * silu_(og[jj][q]);
        st4bf(YIN + m * D + 1024 + ch, y); }
    __syncthreads();
}

__device__ __forceinline__ f32x4 oddin_sample4(const Args& A, int m, int col) {
    const bf16* sl = (const bf16*)(A.ws + WS_OSLAB) + (size_t)((((m - MP) >> 8) * 16 + (col >> 8)) * 8) * 65536 + ((m - MP) & 255) * 256 + (col & 255);
    f32x4 s = {0.f, 0.f, 0.f, 0.f};
#pragma unroll
    for (int p = 0; p < 8; ++p) s += ldp4(sl + (size_t)p * 65536);
    return s * ((const float*)(A.ws + WS_RSTD))[m];
}
__device__ __forceinline__ void o2_conv(const Args& A, Frame& F, int o_) {
    const bf16* XB = (const bf16*)(A.ws + WS_XB); bf16* XCB = (bf16*)(A.ws + WS_XCB); const bool split = F.G == 256;
    const int gt = F.blk * NTHR + F.tid, NGT = F.G * NTHR;
    if (split) for (int idx = gt; idx < (MP / 32) * 512; idx += NGT) {
        const int ch = (idx & 511) * 4, m0 = (idx >> 9) * 32, t0 = m0 & (TP - 1);
        const f32x4 cb = ld4(PARP(PAR_CONVB) + o_ * 2048 + ch); f32x4 cw[4];
#pragma unroll
        for (int j = 0; j < 4; ++j) cw[j] = ld4(PARP(PAR_CONVW) + (size_t)(o_ * 4 + j) * 2048 + ch);
        f32x4 w0 = {0.f, 0.f, 0.f, 0.f}, w1 = w0, w2 = w0;
        if (t0 > 0) { w0 = ldp4(XB + (size_t)(m0 - 3) * 2048 + ch); w1 = ldp4(XB + (size_t)(m0 - 2) * 2048 + ch); w2 = ldp4(XB + (size_t)(m0 - 1) * 2048 + ch); }
#pragma unroll
        for (int r0 = 0; r0 < 32; r0 += 16) {
            f32x4 x[16];
#pragma unroll
            for (int q = 0; q < 16; ++q) x[q] = ldp4(XB + (size_t)(m0 + r0 + q) * 2048 + ch);
#pragma unroll
            for (int q = 0; q < 16; ++q) { st4bf(XCB + (size_t)(m0 + r0 + q) * 2048 + ch, cb + w0 * cw[0] + w1 * cw[1] + w2 * cw[2] + x[q] * cw[3]); w0 = w1; w1 = w2; w2 = x[q]; }
        }
    }
    else for (int idx = gt; idx < M * 512; idx += NGT) {
        const int ch = (idx & 511) * 4, m = idx >> 9;
        int t, bs; if (m < MP) { t = m & (TP - 1); bs = -1; } else { t = (m - MP) & 3; bs = (m - MP) >> 2; }
        f32x4 acc = ld4(PARP(PAR_CONVB) + o_ * 2048 + ch);
#pragma unroll
        for (int j = 0; j < 4; ++j) { const int ti = t + j - 3; f32x4 x;
            if (ti >= 0) x = (split && m >= MP) ? oddin_sample4(A, m + j - 3, 2048 + ch) : ldp4(XB + (size_t)(m + j - 3) * 2048 + ch);
            else if (bs >= 0) x = ld4(A.in[5] + ((size_t)(bs * 2 + o_) * 3 + (ti + 3)) * 2048 + ch);
            else x = (f32x4){0.f, 0.f, 0.f, 0.f};
            acc += x * ld4(PARP(PAR_CONVW) + (size_t)(o_ * 4 + j) * 2048 + ch); }
        st4bf(XCB + (size_t)m * 2048 + ch, acc);
    }
    if (split) for (int idx = gt; idx < BS * 512; idx += NGT) {
        const int ch = (idx & 511) * 4, bs = idx >> 9, m0 = MP + bs * TS;
        f32x4 xr[7];
#pragma unroll
        for (int i = 0; i < 3; ++i) xr[i] = ld4(A.in[5] + ((size_t)(bs * 2 + o_) * 3 + i) * 2048 + ch);
#pragma unroll
        for (int t = 0; t < 4; ++t) xr[3 + t] = oddin_sample4(A, m0 + t, 2048 + ch);
        const f32x4 cb = ld4(PARP(PAR_CONVB) + o_ * 2048 + ch); f32x4 cw[4];
#pragma unroll
        for (int j = 0; j < 4; ++j) cw[j] = ld4(PARP(PAR_CONVW) + (size_t)(o_ * 4 + j) * 2048 + ch);
#pragma unroll
        for (int t = 0; t < 4; ++t) st4bf(XCB + (size_t)(m0 + t) * 2048 + ch, cb + xr[t] * cw[0] + xr[t + 1] * cw[1] + xr[t + 2] * cw[2] + xr[t + 3] * cw[3]);
#pragma unroll
        for (int i = 0; i < 3; ++i) *(f32x4*)(AOUT + O_SCONV + ((size_t)(bs * 2 + o_) * 3 + i) * 2048 + ch) = xr[4 + i];
    }
    for (int idx = gt; idx < (split ? BP : NSEQ) * 3 * 512; idx += NGT) {
        const int ch = (idx & 511) * 4, r = idx >> 9, i = r % 3, q = r / 3;
        const int T = q < BP ? TP : TS, row0 = q < BP ? q * TP : MP + (q - BP) * TS;
        float* o = AOUT + (q < BP ? O_PCONV + ((size_t)(q * 2 + o_) * 3 + i) * 2048 : O_SCONV + ((size_t)((q - BP) * 2 + o_) * 3 + i) * 2048) + ch;
        *(f32x4*)o = (split && q >= BP) ? oddin_sample4(A, row0 + T - 3 + i, 2048 + ch) : ldp4(XB + (size_t)(row0 + T - 3 + i) * 2048 + ch);
    }
}
__device__ __forceinline__ f32x2 lru_a(const float* LA_, size_t o) { const unsigned w = *(const unsigned*)((const bf16*)LA_ + o); return (f32x2){__expf(bf2f(w & 0xffffu)), __expf(bf2f(w >> 16))}; }
__device__ __forceinline__ f32x2 lru_b(const float* LB_, size_t o) { const unsigned w = *(const unsigned*)((const bf16*)LB_ + o); return (f32x2){bf2f(w & 0xffffu), bf2f(w >> 16)}; }
__device__ __forceinline__ void o4_tail(const Args& A, Frame& F) {
    const float* LA_ = (const float*)(A.ws + WS_LRA); const float* LB_ = (const float*)(A.ws + WS_LRB); float* CP = (float*)(A.ws + WS_CP); float* CHh = (float*)(A.ws + WS_CH);
    __syncthreads();
    const int half = F.tid & 1, cp = (F.tid >> 1) & 63, chunk = F.tid >> 7;
#pragma unroll 1
    for (int L = F.blk; L < 32 * 16; L += F.G) {
        const int pm = L >> 4, pn = L & 15; const int ch = pn * 128 + cp * 2; const int b = pm >> 3, c = (pm & 7) * 4 + chunk;
        f32x2 P = {1.f, 1.f}, H = {0.f, 0.f}; const size_t r0 = (size_t)(pm * 256 + chunk * 64 + half * 32) * 2048 + ch;
#pragma unroll 1
        for (int t0 = 0; t0 < 32; t0 += 8) {
            f32x2 a8[8], b8[8];
#pragma unroll
            for (int q = 0; q < 8; ++q) { a8[q] = lru_a(LA_, r0 + (size_t)(t0 + q) * 2048); b8[q] = lru_b(LB_, r0 + (size_t)(t0 + q) * 2048); }
#pragma unroll
            for (int q = 0; q < 8; ++q) { H = a8[q] * H + b8[q]; P = P * a8[q]; }
        }
        f32x2 Po, Ho; Po.x = __shfl_xor(P.x, 1); Po.y = __shfl_xor(P.y, 1); Ho.x = __shfl_xor(H.x, 1); Ho.y = __shfl_xor(H.y, 1);
        if (half == 0) { *(f32x2*)(CP + (size_t)(b * 32 + c) * 2048 + ch) = P * Po; *(f32x2*)(CHh + (size_t)(b * 32 + c) * 2048 + ch) = Po * H + Ho; }
    }
}
__device__ __forceinline__ void o4_lru_chunks(const Args& A, Frame& F) {
    const float* LA_ = (const float*)(A.ws + WS_LRA); const float* LB_ = (const float*)(A.ws + WS_LRB); float* CP = (float*)(A.ws + WS_CP); float* CHh = (float*)(A.ws + WS_CH);
    const int gt = F.blk * NTHR + F.tid, NGT = F.G * NTHR;
    for (int idx = gt; idx < BP * 32 * 1024; idx += NGT) {
        const int ch = (idx & 1023) * 2, c = (idx >> 10) & 31, b = idx >> 15;
        f32x2 P = {1.f, 1.f}, H = {0.f, 0.f}; const size_t r0 = (size_t)(b * TP + c * 64) * 2048 + ch;
#pragma unroll 1
        for (int t0 = 0; t0 < 64; t0 += 8) {
            f32x2 a8[8], b8[8];
#pragma unroll
            for (int q = 0; q < 8; ++q) { a8[q] = lru_a(LA_, r0 + (size_t)(t0 + q) * 2048); b8[q] = lru_b(LB_, r0 + (size_t)(t0 + q) * 2048); }
#pragma unroll
            for (int q = 0; q < 8; ++q) { H = a8[q] * H + b8[q]; P = P * a8[q]; }
        }
        *(f32x2*)(CP + (size_t)(b * 32 + c) * 2048 + ch) = P; *(f32x2*)(CHh + (size_t)(b * 32 + c) * 2048 + ch) = H;
    }
}
__device__ __forceinline__ void o5_lru_scan(const Args& A, Frame& F, int o_) {
    const float* LA_ = (const float*)(A.ws + WS_LRA); const float* LB_ = (const float*)(A.ws + WS_LRB); const float* CP = (const float*)(A.ws + WS_CP); const float* CHh = (const float*)(A.ws + WS_CH);
    const bf16* GATE = (const bf16*)(A.ws + WS_GATE); bf16* YIN = (bf16*)(A.ws + WS_YIN);
    const int gt = F.blk * NTHR + F.tid, NGT = F.G * NTHR;
    for (int idx = gt; idx < BP * 32 * 1024 + BS * 1024; idx += NGT) {
        int ch, nt_; size_t r0; f32x2 H; float* so = nullptr;
        if (idx < BP * 32 * 1024) {
            ch = (idx & 1023) * 2; const int c = (idx >> 10) & 31, b = idx >> 15; H = (f32x2){0.f, 0.f};
#pragma unroll 1
            for (int cb = 0; cb < c; cb += 8) {
                f32x2 p8[8], h8[8];
#pragma unroll
                for (int q = 0; q < 8; ++q) { const int cc = (cb + q < c) ? cb + q : c - 1; const size_t o = (size_t)(b * 32 + cc) * 2048 + ch; p8[q] = *(const f32x2*)(CP + o); h8[q] = *(const f32x2*)(CHh + o); }
#pragma unroll
                for (int q = 0; q < 8; ++q) if (cb + q < c) H = p8[q] * H + h8[q];
            }
            r0 = (size_t)(b * TP + c * 64) * 2048 + ch; nt_ = 64; if (c == 31) so = AOUT + O_PLRU + (size_t)(b * 2 + o_) * 2048 + ch;
        } else {
            const int r = idx - BP * 32 * 1024; ch = (r & 1023) * 2; const int bs = r >> 10;
            H = *(const f32x2*)(A.in[6] + (size_t)(bs * 2 + o_) * 2048 + ch); r0 = (size_t)(MP + bs * TS) * 2048 + ch; nt_ = TS; so = AOUT + O_SLRU + (size_t)(bs * 2 + o_) * 2048 + ch;
        }
#pragma unroll 1
        for (int t0 = 0; t0 < nt_; t0 += 4) {
            f32x2 a4[4], b4[4]; unsigned g4[4];
#pragma unroll
            for (int q = 0; q < 4; ++q) { const size_t o = r0 + (size_t)(t0 + q) * 2048; a4[q] = lru_a(LA_, o); b4[q] = lru_b(LB_, o);
                if (F.G == 256 && idx >= BP * 32 * 1024) {
                    const int m = (int)(o >> 11); const bf16* sl = (const bf16*)(A.ws + WS_OSLAB) + (size_t)((((m - MP) >> 8) * 16 + (ch >> 8)) * 8) * 65536 + ((m - MP) & 255) * 256 + (ch & 255);
                    unsigned w8[8];
#pragma unroll
                    for (int p = 0; p < 8; ++p) w8[p] = *(const unsigned*)(sl + (size_t)p * 65536);
                    float s0 = 0.f, s1 = 0.f;
#pragma unroll
                    for (int p = 0; p < 8; ++p) { s0 += bf2f(w8[p] & 0xffffu); s1 += bf2f(w8[p] >> 16); }
                    const float rs = ((const float*)(A.ws + WS_RSTD))[m];
                    g4[q] = cvt_pk_bf16(pg8::gelu_tanh(s0 * rs), pg8::gelu_tanh(s1 * rs));
                } else g4[q] = *(const unsigned*)(GATE + o); }
#pragma unroll
            for (int q = 0; q < 4; ++q) { const size_t o = r0 + (size_t)(t0 + q) * 2048; H = a4[q] * H + b4[q];
                *(unsigned*)(YIN + o) = cvt_pk_bf16(H[0] * bf2f(g4[q] & 0xffffu), H[1] * bf2f(g4[q] >> 16)); }
        }
        if (so) *(f32x2*)so = H;
    }
}
#ifndef R1W_SHFL_SCAN
#define R1W_SHFL_SCAN 0
#endif
#ifndef R1W_LDS_TINV
#define R1W_LDS_TINV 1
#endif
#ifndef R1W_MASK
#define R1W_MASK 31
#endif
#define R1O_MASK (31 & ~R1W_MASK)

__device__ __forceinline__ f32x4 mm16(const LAS float* a, int sai, int sak, const LAS float* b, int sbk, int sbj, int K, f32x4 acc, int lane) {
    const int i = lane & 15, g = lane >> 4;
#pragma unroll
    for (int s = 0; s < K / 4; ++s) acc = __builtin_amdgcn_mfma_f32_16x16x4f32(a[i * sai + (4 * s + g) * sak], b[(4 * s + g) * sbk + i * sbj], acc, 0, 0, 0);
    return acc;
}
constexpr int R1_RS = 68, R1_TS = 20, R1_HSZ = 16064;
constexpr int R1_RT = 0, R1_KAP = 1088, R1_BT = 2176, R1_KT = 3264,
              R1_KAPT = 4352, R1_BTT = 5632, R1_KTT = 6912, R1_VVT = 8192, R1_TKT = 9472, R1_W1T = 10752, R1_LKVT = 12032,
              R1_LB = 13312, R1_LK = 13632, R1_MRK = 13952, R1_MRB = 14272, R1_TM = 14592, R1_GAM = 14912, R1_GC = 16000;
__device__ __forceinline__ f32x4 mm4(const LAS float* a, const LAS float* b, f32x4 acc) {
    const f32x4 av = *(const LAS f32x4*)a, bv = *(const LAS f32x4*)b;
#pragma unroll
    for (int s = 0; s < 4; ++s) acc = __builtin_amdgcn_mfma_f32_16x16x4f32(av[s], bv[s], acc, 0, 0, 0);
    return acc;
}
__device__ __forceinline__ v4u pack8(const f32x4& a, const f32x4& b) { v4u o; o.x = cvt_pk_bf16(a[0], a[1]); o.y = cvt_pk_bf16(a[2], a[3]); o.z = cvt_pk_bf16(b[0], b[1]); o.w = cvt_pk_bf16(b[2], b[3]); return o; }

struct R1Raw { f32x4 pr, pk, pv, qr, qk, qv, wd, wa; };
__device__ __forceinline__ void rwkv_r1_load(const Args& A, Frame& F, int b, int h, int cp, R1Raw& r) {
    const bf16* PROJ = (const bf16*)(A.ws + WS_PROJ); const float* WAG = (const float*)(A.ws + WS_WAG);
    const int tt = F.tid >> 4, cg = F.tid & 15, hc = h * 64 + 4 * cg, tabs = cp * 32 + tt; const size_t m = (size_t)b * TP + tabs;
    r.pr = ldp4(PROJ + m * NEV + hc); r.pk = ldp4(PROJ + m * NEV + 1024 + hc); r.pv = ldp4(PROJ + m * NEV + 2048 + hc);
    r.qr = (f32x4){0.f, 0.f, 0.f, 0.f}; r.qk = r.qr; r.qv = r.qr;
    if (tabs > 0) { r.qr = ldp4(PROJ + (m - 1) * NEV + hc); r.qk = ldp4(PROJ + (m - 1) * NEV + 1024 + hc); r.qv = ldp4(PROJ + (m - 1) * NEV + 2048 + hc); }
    r.wd = ld4(WAG + m * NLORA + hc); r.wa = ld4(WAG + m * NLORA + 1024 + hc);
}
__device__ __forceinline__ void rwkv_r1_unit(const Args& A, Frame& F, int e, int b, int h, int cp, const R1Raw& raw) {
    const int tid = F.tid, tt = tid >> 4, cg = tid & 15, ts = tt & 15;
    const int hf = F.wave >> 2, wl = F.wave & 3, lane = F.lane, g = lane >> 4, i = lane & 15;
    LAS float* HS = (LAS float*)F.lds + (tt >> 4) * R1_HSZ;
    LAS float* HM = (LAS float*)F.lds + hf * R1_HSZ;
    const int hc = h * 64 + 4 * cg;
#ifndef R1_REP12
#define R1_REP12 1
#endif
    for (int rp12 = 0; rp12 < R1_REP12; ++rp12) {
    const float* mu = PARP(PAR_MU) + (size_t)e * PRW;
    const f32x4 zr = raw.pr + (raw.qr - raw.pr) * ld4(mu + hc), zk = raw.pk + (raw.qk - raw.pk) * ld4(mu + 1024 + hc), zv = raw.pv + (raw.qv - raw.pv) * ld4(mu + 2048 + hc);
    f32x4 kk = zk * ld4(PARP(PAR_KK) + e * 1024 + hc);
    const float ss = red16((kk[0] * kk[0] + kk[1] * kk[1]) + (kk[2] * kk[2] + kk[3] * kk[3]));
    kk = kk * (1.0f / fmaxf(sqrtf(ss), 1e-12f));
    const f32x4 kp = zk * (1.0f + (raw.wa - 1.0f) * ld4(PARP(PAR_KA) + e * 1024 + hc)), bb = kk * raw.wa;
    *(LAS f32x4*)(HS + R1_GAM + ts * 68 + 4 * cg) = raw.wd;
    {
        const f32x4 rk = ld4(PARP(PAR_RK) + e * 1024 + hc);
        const float bonus = red16((zr[0] * kp[0] * rk[0] + zr[1] * kp[1] * rk[1]) + (zr[2] * kp[2] * rk[2] + zr[3] * kp[3] * rk[3]));
        if (R1O_MASK & 16) *(f32x4*)((float*)(A.ws + WS_WAG) + ((size_t)b * TP + cp * 32 + tt) * NLORA + hc) = zv * bonus;
    }
    __syncthreads();
    {
        f32x4 gm = {1.f, 1.f, 1.f, 1.f}, gp = gm;
#pragma unroll
        for (int j = 0; j < 16; ++j) { const f32x4 wv = *(const LAS f32x4*)(HS + R1_GAM + j * 68 + 4 * cg); if (j <= ts) gm *= wv; if (j < ts) gp *= wv; }
        f32x4 inv;
#pragma unroll
        for (int j = 0; j < 4; ++j) inv[j] = 1.0f / gm[j];
        const f32x4 rt = zr * gm, kap = kk * gp, bt = bb * inv, kt = kp * inv;
        LAS float* pn = HS + ts * R1_RS + 4 * cg;
        *(LAS f32x4*)(pn + R1_RT) = rt; *(LAS f32x4*)(pn + R1_KAP) = kap; *(LAS f32x4*)(pn + R1_BT) = bt; *(LAS f32x4*)(pn + R1_KT) = kt;
        LAS float* pt = HS + (4 * cg) * R1_TS + ts;
#pragma unroll
        for (int j = 0; j < 4; ++j) { pt[R1_KAPT + j * R1_TS] = kap[j]; pt[R1_BTT + j * R1_TS] = bt[j]; pt[R1_KTT + j * R1_TS] = kt[j]; pt[R1_VVT + j * R1_TS] = zv[j]; }
        if (ts == 15) *(LAS f32x4*)(HS + R1_GC + 4 * cg) = gm;
    }
    __syncthreads();
    }
    const f32x4 z4 = {0.f, 0.f, 0.f, 0.f};
#define R1_ROWN(arr_, r_) (HM + (arr_) + (r_) * R1_RS + 16 * g)
#define R1_COLT(arr_, c_) (HM + (arr_) + (c_) * R1_TS + 4 * g)
#define R1_ROWM(arr_, r_) (HM + (arr_) + (r_) * R1_TS + 4 * g)
    {
        const LAS float* a = R1_ROWN((wl < 2) ? R1_KAP : R1_RT, i); const LAS float* bm = R1_ROWN((wl & 1) ? R1_KT : R1_BT, i);
        f32x4 d = z4;
#pragma unroll
        for (int q = 0; q < 4; ++q) d = mm4(a + 4 * q, bm + 4 * q, d);
        LAS float* o = HM + (wl == 0 ? R1_LB : (wl == 1 ? R1_LK : (wl == 2 ? R1_MRB : R1_MRK)));
#pragma unroll
        for (int r = 0; r < 4; ++r) { const int t = 4 * g + r; const bool keep = (wl < 2) ? (i < t) : (i <= t); o[t * R1_TS + i] = keep ? d[r] : 0.f; }
    }
    __syncthreads();
    {
        const f32x4 d = mm4(R1_ROWM(R1_LK, i), R1_COLT(R1_VVT, 16 * wl + i), z4);
        *(LAS f32x4*)(HM + R1_LKVT + (16 * wl + i) * R1_TS + 4 * g) = d;
        if (wl == 0) { float tr[16];
#pragma unroll
            for (int t = 0; t < 16; ++t) { float v = (t == i) ? 1.0f : 0.0f;
#pragma unroll
                for (int j = 0; j < t; ++j) v -= HM[R1_LB + t * R1_TS + j] * tr[j];
                tr[t] = v; HM[R1_TM + t * R1_TS + i] = v; } }
    }
    __syncthreads();
    {
        const f32x4 d1 = mm4(R1_ROWM(R1_TM, i), R1_COLT(R1_KAPT, 16 * wl + i), z4), d2 = mm4(R1_ROWM(R1_TM, i), R1_COLT(R1_LKVT, 16 * wl + i), z4);
        *(LAS f32x4*)(HM + R1_TKT + (16 * wl + i) * R1_TS + 4 * g) = d1; *(LAS f32x4*)(HM + R1_W1T + (16 * wl + i) * R1_TS + 4 * g) = d2;
    }
    __syncthreads();
    {
        const size_t cid = ((size_t)(b * 16 + h) * 128 + cp * 2 + hf);
        const size_t mrow = (size_t)b * TP + cp * 32 + hf * 16;
        {
            const f32x4 d1 = mm4(R1_COLT(R1_VVT, 16 * wl + i), R1_ROWM(R1_MRK, i), z4), d2 = mm4(R1_COLT(R1_W1T, 16 * wl + i), R1_ROWM(R1_MRB, i), z4);
            if (R1O_MASK & 1) *(f32x4*)((float*)(A.ws + WS_OB) + (mrow + i) * 1024 + h * 64 + 16 * wl + 4 * g) = d1 - d2;
        }
        if (wl < 2) {
            f32x4 q[2];
#pragma unroll
            for (int c2 = 0; c2 < 2; ++c2) { const int a = 2 * wl + c2; const f32x4 d = mm4(R1_COLT(R1_TKT, 16 * a + i), R1_ROWM(R1_MRB, i), z4);
                q[c2] = *(const LAS f32x4*)(HM + R1_RT + i * R1_RS + 16 * a + 4 * g) - d; }
            if (R1O_MASK & 2) *(v4u*)((bf16*)(A.ws + WS_RQ) + ((cid * 2 + wl) * 64 + lane) * 8) = pack8(q[0], q[1]);
        }
        const float gci = HM[R1_GC + 16 * wl + i];
#pragma unroll
        for (int kp2 = 0; kp2 < 2; ++kp2) {
            f32x4 q[2];
#pragma unroll
            for (int c2 = 0; c2 < 2; ++c2) { const int a = 2 * kp2 + c2; const f32x4 d = mm4(R1_COLT(R1_TKT, 16 * a + i), R1_COLT(R1_BTT, 16 * wl + i), z4);
#pragma unroll
                for (int r = 0; r < 4; ++r) q[c2][r] = (((a == wl && 4 * g + r == i) ? 1.0f : 0.0f) - d[r]) * gci; }
            if (R1O_MASK & 4) *(v4u*)((bf16*)(A.ws + WS_PST) + (((cid * 4 + wl) * 2 + kp2) * 64 + lane) * 8) = pack8(q[0], q[1]);
        }
        const f32x4 gcr = *(const LAS f32x4*)(HM + R1_GC + 16 * wl + 4 * g);
#pragma unroll
        for (int a = 0; a < 4; ++a) {
            const f32x4 d1 = mm4(R1_COLT(R1_KTT, 16 * wl + i), R1_COLT(R1_VVT, 16 * a + i), z4), d2 = mm4(R1_COLT(R1_BTT, 16 * wl + i), R1_COLT(R1_W1T, 16 * a + i), z4);
            if (R1O_MASK & 8) *(f32x4*)((float*)(A.ws + WS_QST) + (((cid * 4 + a) * 4 + wl) * 64 + lane) * 4) = (d1 - d2) * gcr;
        }
    }
#undef R1_ROWN
#undef R1_COLT
#undef R1_ROWM
    __syncthreads();
}

template <int CTRL> __device__ __forceinline__ float dpp1(float v) {
    return __builtin_bit_cast(float, __builtin_amdgcn_update_dpp(0x3f800000, __builtin_bit_cast(int, v), CTRL, 0xf, 0xf, false)); }
__device__ __forceinline__ f32x4 mmr(const f32x4& av, const f32x4& bv, f32x4 acc) {
#pragma unroll
    for (int s = 0; s < 4; ++s) acc = __builtin_amdgcn_mfma_f32_16x16x4f32(av[s], bv[s], acc, 0, 0, 0);
    return acc;
}
typedef short bf16x4_ __attribute__((ext_vector_type(4)));
__device__ __forceinline__ bf16x4_ tobf4(const f32x4& v) { v2u w; w.x = cvt_pk_bf16(v[0], v[1]); w.y = cvt_pk_bf16(v[2], v[3]); return __builtin_bit_cast(bf16x4_, w); }
constexpr int R1W_LDS = 19200;
constexpr int R1W_GC = 4352, R1W_PARS = 4416;
struct R1WRaw { v2u pr[4], pk[4], pv[4], qr[4], qk[4], qv[4], wd[4], wa[4]; };
__device__ __forceinline__ f32x4 cv4(const v2u w) { return (f32x4){bf2f(w.x & 0xffffu), bf2f(w.x >> 16), bf2f(w.y & 0xffffu), bf2f(w.y >> 16)}; }
__device__ __forceinline__ void rwkv_r1w_load(const Args& A, int lane, int b, int h, int c, R1WRaw& r) {
    const bf16* PROJ = (const bf16*)(A.ws + WS_PROJ); const float* WAG = (const float*)(A.ws + WS_WAG);
    const int g = lane >> 4, i = lane & 15, tabs = c * 16 + i, hc = h * 64 + 4 * g; const size_t m = (size_t)b * TP + tabs, mq = tabs > 0 ? m - 1 : m;
#pragma unroll
    for (int a = 0; a < 4; ++a) { r.pr[a] = *(const v2u*)(PROJ + m * NEV + hc + 16 * a); r.pk[a] = *(const v2u*)(PROJ + m * NEV + 1024 + hc + 16 * a); r.pv[a] = *(const v2u*)(PROJ + m * NEV + 2048 + hc + 16 * a);
        r.qr[a] = *(const v2u*)(PROJ + mq * NEV + hc + 16 * a); r.qk[a] = *(const v2u*)(PROJ + mq * NEV + 1024 + hc + 16 * a); r.qv[a] = *(const v2u*)(PROJ + mq * NEV + 2048 + hc + 16 * a);
        r.wd[a] = *(const v2u*)((const bf16*)WAG + m * NLORA + hc + 16 * a); r.wa[a] = *(const v2u*)((const bf16*)WAG + m * NLORA + 1024 + hc + 16 * a); }
}
__device__ __forceinline__ void rwkv_r1w_unit(const Args& A, Frame& F, int e, int b, int h, int c, const R1WRaw& raw, bool has_next, int nb, int nc, R1WRaw& nraw) {
    const int lane = F.lane, g = lane >> 4, i = lane & 15;
    LAS float* WL = (LAS float*)(F.lds + __builtin_amdgcn_readfirstlane(F.wave) * R1W_LDS);
    float* WAG = (float*)(A.ws + WS_WAG);
    const int tabs = c * 16 + i, hc = h * 64 + 4 * g; const size_t m = (size_t)b * TP + tabs;
    const f32x4 z4 = {0.f, 0.f, 0.f, 0.f};
    const LAS float* PS = WL + R1W_PARS + 4 * g;
    f32x4 zr[4], zk[4], zv[4], wd[4], wa[4];
#pragma unroll
    for (int a = 0; a < 4; ++a) {
        const f32x4 pr = cv4(raw.pr[a]), pk = cv4(raw.pk[a]), pv = cv4(raw.pv[a]);
        f32x4 qr = cv4(raw.qr[a]), qk = cv4(raw.qk[a]), qv = cv4(raw.qv[a]);
        if (tabs == 0) { qr = z4; qk = z4; qv = z4; }
        zr[a] = pr + (qr - pr) * *(const LAS f32x4*)(PS + 16 * a); zk[a] = pk + (qk - pk) * *(const LAS f32x4*)(PS + 64 + 16 * a); zv[a] = pv + (qv - pv) * *(const LAS f32x4*)(PS + 128 + 16 * a);
        { const f32x4 lw = cv4(raw.wd[a]); wd[a] = (f32x4){__expf(lw[0]), __expf(lw[1]), __expf(lw[2]), __expf(lw[3])}; } wa[a] = cv4(raw.wa[a]);
    }
    f32x4 rt[4], kap[4], bt[4], kt[4], gcr[4];
    {
        f32x4 kk[4], kp[4]; float ss = 0.f, bon = 0.f;
#pragma unroll
        for (int a = 0; a < 4; ++a) { kk[a] = zk[a] * *(const LAS f32x4*)(PS + 192 + 16 * a); ss += (kk[a][0] * kk[a][0] + kk[a][1] * kk[a][1]) + (kk[a][2] * kk[a][2] + kk[a][3] * kk[a][3]); }
        ss += __shfl_xor(ss, 16); ss += __shfl_xor(ss, 32);
        const float rn = 1.0f / fmaxf(sqrtf(ss), 1e-12f);
#pragma unroll
        for (int a = 0; a < 4; ++a) { kk[a] = kk[a] * rn; kp[a] = zk[a] * (1.0f + (wa[a] - 1.0f) * *(const LAS f32x4*)(PS + 256 + 16 * a));
            const f32x4 rk = *(const LAS f32x4*)(PS + 320 + 16 * a); const f32x4 t3 = zr[a] * kp[a] * rk; bon += (t3[0] + t3[1]) + (t3[2] + t3[3]); }
        bon += __shfl_xor(bon, 16); bon += __shfl_xor(bon, 32);
        if (R1W_MASK & 16)
#pragma unroll
        for (int a = 0; a < 4; ++a) st4bf((bf16*)WAG + m * NLORA + hc + 16 * a, zv[a] * bon);
#pragma unroll
        for (int a = 0; a < 4; ++a) {
            f32x4 gm, gp;
#if R1W_SHFL_SCAN
            gm = (f32x4){1.f, 1.f, 1.f, 1.f}; gp = gm;
            *(LAS f32x4*)(WL + i * 68 + 16 * a + 4 * g) = wd[a];
#pragma unroll
            for (int j = 0; j < 16; ++j) { const f32x4 wv = *(const LAS f32x4*)(WL + j * 68 + 16 * a + 4 * g); if (j <= i) gm *= wv; if (j < i) gp *= wv; }
#else
#pragma unroll
            for (int r = 0; r < 4; ++r) { float x = wd[a][r]; x *= dpp1<0x111>(x); x *= dpp1<0x112>(x); x *= dpp1<0x114>(x); x *= dpp1<0x118>(x); gm[r] = x; gp[r] = dpp1<0x111>(x); }
#endif
            f32x4 inv;
#pragma unroll
            for (int r = 0; r < 4; ++r) inv[r] = __builtin_amdgcn_rcpf(gm[r]);
            rt[a] = zr[a] * gm; kap[a] = kk[a] * gp; bt[a] = kk[a] * wa[a] * inv; kt[a] = kp[a] * inv;
            if (i == 15) *(LAS f32x4*)(WL + R1W_GC + 16 * a + 4 * g) = gm;
        }
    }
#pragma unroll
    for (int a = 0; a < 4; ++a) { LAS float* pw = WL + i * 68 + 16 * a + 4 * g;
        *(LAS f32x4*)(pw) = zv[a]; *(LAS f32x4*)(pw + 1088) = kap[a]; *(LAS f32x4*)(pw + 2176) = bt[a]; *(LAS f32x4*)(pw + 3264) = kt[a]; }
    f32x4 Lb = z4, Lk = z4, Mrb = z4, Mrk = z4, LbD = z4;
#pragma unroll
    for (int a = 0; a < 4; ++a) { LbD = mmr(kap[a], bt[a], LbD); Lb = mmr(bt[a], kap[a], Lb); Lk = mmr(kt[a], kap[a], Lk); Mrb = mmr(bt[a], rt[a], Mrb); Mrk = mmr(kt[a], rt[a], Mrk); }
#pragma unroll
    for (int r = 0; r < 4; ++r) { const int sc = 4 * g + r; if (!(sc < i)) { Lb[r] = 0.f; Lk[r] = 0.f; } if (!(sc <= i)) { Mrb[r] = 0.f; Mrk[r] = 0.f; } if (!(i < sc)) LbD[r] = 0.f; }
    f32x4 VT[4], KAPT[4], BTT[4], KTT[4]; float gci[4];
#pragma unroll
    for (int a = 0; a < 4; ++a) {
#pragma unroll
        for (int s = 0; s < 4; ++s) { const LAS float* pr_ = WL + (4 * g + s) * 68 + 16 * a + i; VT[a][s] = pr_[0]; KAPT[a][s] = pr_[1088]; BTT[a][s] = pr_[2176]; KTT[a][s] = pr_[3264]; }
        gci[a] = WL[R1W_GC + 16 * a + i]; gcr[a] = *(const LAS f32x4*)(WL + R1W_GC + 16 * a + 4 * g);
    }
    f32x4 LKVT[4];
#pragma unroll
    for (int a = 0; a < 4; ++a) LKVT[a] = mmr(Lk, VT[a], z4);
    f32x4 Trow;
    {
        f32x4 idm;
#pragma unroll
        for (int r = 0; r < 4; ++r) idm[r] = (4 * g + r == i) ? 1.0f : 0.0f;
        const f32x4 L2D = mmr(Lb, LbD, z4), L2r = mmr(LbD, Lb, z4);
        const f32x4 L4D = mmr(L2r, L2D, z4), L4r = mmr(L2D, L2r, z4);
        const f32x4 L8D = mmr(L4r, L4D, z4);
        const f32x4 X1 = mmr(L2D + idm, idm - Lb, z4), X2 = mmr(L4D + idm, X1, z4);
        Trow = mmr(L8D + idm, X2, z4);
    }
    f32x4 TKT[4], W1T[4];
#pragma unroll
    for (int a = 0; a < 4; ++a) { TKT[a] = mmr(Trow, KAPT[a], z4); W1T[a] = mmr(Trow, LKVT[a], z4); }
    __builtin_amdgcn_sched_barrier(0);
    if (has_next) rwkv_r1w_load(A, lane, nb, h, nc, nraw);
    __builtin_amdgcn_sched_barrier(0);
    const size_t cid = (size_t)(b * 16 + h) * 128 + c; const size_t mrow = (size_t)b * TP + c * 16;
#pragma unroll
    for (int wl = 0; wl < 4; ++wl) {
        const f32x4 d1 = mmr(VT[wl], Mrk, z4), d2 = mmr(W1T[wl], Mrb, z4);
        if (R1W_MASK & 1) st4bf((bf16*)(A.ws + WS_OB) + (mrow + i) * 1024 + h * 64 + 16 * wl + 4 * g, d1 - d2);
    }
#pragma unroll
    for (int w2 = 0; w2 < 2; ++w2) {
        const f32x4 q0 = rt[2 * w2] - mmr(TKT[2 * w2], Mrb, z4), q1 = rt[2 * w2 + 1] - mmr(TKT[2 * w2 + 1], Mrb, z4);
        if (R1W_MASK & 2) *(v4u*)((bf16*)(A.ws + WS_RQ) + ((cid * 2 + w2) * 64 + lane) * 8) = pack8(q0, q1);
    }
    bf16x4_ TKb[4], BTb[4], nBTb[4], KTb[4], VTb[4], W1b[4];
#pragma unroll
    for (int a = 0; a < 4; ++a) { TKb[a] = tobf4(TKT[a]); BTb[a] = tobf4(BTT[a]); nBTb[a] = tobf4(z4 - BTT[a]); KTb[a] = tobf4(KTT[a]); VTb[a] = tobf4(VT[a]); W1b[a] = tobf4(W1T[a]); }
#pragma unroll
    for (int wl = 0; wl < 4; ++wl) {
#pragma unroll
        for (int kp2 = 0; kp2 < 2; ++kp2) {
            f32x4 q[2];
#pragma unroll
            for (int c2 = 0; c2 < 2; ++c2) { const int a = 2 * kp2 + c2; const f32x4 d = __builtin_amdgcn_mfma_f32_16x16x16bf16_1k(TKb[a], BTb[wl], z4, 0, 0, 0);
#pragma unroll
                for (int r = 0; r < 4; ++r) q[c2][r] = (((a == wl && 4 * g + r == i) ? 1.0f : 0.0f) - d[r]) * gci[wl]; }
            if (R1W_MASK & 4) *(v4u*)((bf16*)(A.ws + WS_PST) + (((cid * 4 + wl) * 2 + kp2) * 64 + lane) * 8) = pack8(q[0], q[1]);
        }
#pragma unroll
        for (int a = 0; a < 4; ++a) {
            f32x4 d = __builtin_amdgcn_mfma_f32_16x16x16bf16_1k(KTb[wl], VTb[a], z4, 0, 0, 0);
            d = __builtin_amdgcn_mfma_f32_16x16x16bf16_1k(nBTb[wl], W1b[a], d, 0, 0, 0);
            if (R1W_MASK & 8) { const f32x4 qv_ = d * gcr[wl]; v2u qp_; qp_.x = cvt_pk_bf16(qv_[0], qv_[1]); qp_.y = cvt_pk_bf16(qv_[2], qv_[3]);
                *(v2u*)((bf16*)(A.ws + WS_QST) + (((cid * 4 + a) * 4 + wl) * 64 + lane) * 4) = qp_; }
        }
    }
}
__device__ __forceinline__ void rwkv_r1w_phase(const Args& A, Frame& F, int e) {
    const int NGW = F.G * NWAVES, gw = F.blk * NWAVES + F.wave, NU = BP * 16 * 128;
    if (gw >= NU) return;
    const int h = (gw >> 7) & 15;
    {
        LAS float* WL = (LAS float*)(F.lds + __builtin_amdgcn_readfirstlane(F.wave) * R1W_LDS);
        const float* mu = PARP(PAR_MU) + (size_t)e * PRW; const int hl = h * 64 + F.lane;
        const float p0 = mu[hl], p1 = mu[1024 + hl], p2 = mu[2048 + hl], p3 = PARP(PAR_KK)[e * 1024 + hl], p4 = PARP(PAR_KA)[e * 1024 + hl], p5 = PARP(PAR_RK)[e * 1024 + hl];
        __builtin_amdgcn_sched_barrier(0);
        WL[R1W_PARS + F.lane] = p0; WL[R1W_PARS + 64 + F.lane] = p1; WL[R1W_PARS + 128 + F.lane] = p2; WL[R1W_PARS + 192 + F.lane] = p3; WL[R1W_PARS + 256 + F.lane] = p4; WL[R1W_PARS + 320 + F.lane] = p5;
    }
    R1WRaw raw = {}, nraw = {};
    rwkv_r1w_load(A, F.lane, gw >> 11, h, gw & 127, raw);
#pragma unroll 1
    for (int u = gw; u < NU; u += NGW) { asm volatile("" : "+v"(F.lane)); const int un = u + NGW;
        rwkv_r1w_unit(A, F, e, u >> 11, h, u & 127, raw, un < NU, un >> 11, un & 127, nraw); raw = nraw; }
}

#ifndef R2_PF
#define R2_PF 0
#define R2_PF_AHEAD 6
#endif
#if R2_PF
#define R2_PROG(c_) do { if (F.tid == 0) prog[0] = (c_); } while (0)
#else
#define R2_PROG(c_) do { } while (0)
#endif
__device__ __forceinline__ void rwkv_r2_head(const Args& A, Frame& F, int e, int b, int h) {
    typedef short bf16x8 __attribute__((ext_vector_type(8)));
    const int w = F.wave, lane = F.lane, g = lane >> 4, i = lane & 15;
    const size_t cid0 = (size_t)(b * 16 + h) * 128;
    const bf16* PST = (const bf16*)(A.ws + WS_PST); const float* QST = (const float*)(A.ws + WS_QST); const bf16* RQS = (const bf16*)(A.ws + WS_RQ); float* OB = (float*)(A.ws + WS_OB);
#if R2_PF
    LAS volatile int* prog = (LAS volatile int*)(F.lds + 4096);
    if (F.tid == 0) prog[0] = 0;
    __syncthreads();
    if (F.wave >= 4) {
        const int pl = (F.wave - 4) * 64 + lane; unsigned sink = 0;
        const char* base; size_t stride;
        if (pl < 64) { base = (const char*)PST + cid0 * 8192 + pl * 128; stride = 8192; }
        else if (pl < 80) { base = (const char*)RQS + cid0 * 2048 + (pl - 64) * 128; stride = 2048; }
        else if (pl < 208) { base = (const char*)QST + cid0 * 16384 + (pl - 80) * 128; stride = 16384; }
        else { const int r = ((pl - 208) >> 1) & 15, hf = (pl - 208) & 1; base = (const char*)OB + (((size_t)b * TP + r) * 1024 + h * 64) * 4 + hf * 128; stride = 65536; }
#pragma unroll 1
        for (int c0 = 0; c0 < 128; c0 += 8) {
            while (prog[0] + R2_PF_AHEAD < c0) __builtin_amdgcn_s_sleep(8);
            if (pl < 240) { unsigned v[8];
#pragma unroll
                for (int q = 0; q < 8; ++q) v[q] = *(const unsigned*)(base + (size_t)(c0 + q) * stride);
#pragma unroll
                for (int q = 0; q < 8; ++q) sink += v[q]; }
        }
        if (sink == 0x9e3779b9u) prog[1] = (int)sink;
        return;
    }
#else
    if (F.wave >= 4) return;
#endif
    f32x4 S[4];
#pragma unroll
    for (int k = 0; k < 4; ++k) S[k] = (f32x4){0.f, 0.f, 0.f, 0.f};
    struct R2Set { v4u P[4][2], RQ[2]; v2u Q[4], O; };
    R2Set s0 = {}, s1 = {}, s2 = {};
    float* OB2 = (float*)(A.ws + WS_OB2);
#define R2_LOAD(S_, c_) do { const size_t cid_ = cid0 + (c_); \
        _Pragma("unroll") for (int kb_ = 0; kb_ < 4; ++kb_) { _Pragma("unroll") for (int kp_ = 0; kp_ < 2; ++kp_) S_.P[kb_][kp_] = *(const v4u*)(PST + (((cid_ * 4 + kb_) * 2 + kp_) * 64 + lane) * 8); \
            S_.Q[kb_] = *(const v2u*)((const bf16*)QST + (((cid_ * 4 + w) * 4 + kb_) * 64 + lane) * 4); } \
        _Pragma("unroll") for (int kp_ = 0; kp_ < 2; ++kp_) S_.RQ[kp_] = *(const v4u*)(RQS + ((cid_ * 2 + kp_) * 64 + lane) * 8); \
        S_.O = *(const v2u*)((const bf16*)OB + ((size_t)b * TP + (c_) * 16 + i) * 1024 + h * 64 + 16 * w + 4 * g); } while (0)
#define R2_BODY(c_, CUR, NX2) do { R2_PROG(c_); if ((c_) + 2 < 128) R2_LOAD(NX2, (c_) + 2); \
        const v4u s0_ = pack8(S[0], S[1]), s1_ = pack8(S[2], S[3]); \
        const bf16x8 sp0 = __builtin_bit_cast(bf16x8, s0_), sp1 = __builtin_bit_cast(bf16x8, s1_); \
        f32x4 Oc = __builtin_amdgcn_mfma_f32_16x16x32_bf16(sp0, __builtin_bit_cast(bf16x8, CUR.RQ[0]), cv4(CUR.O), 0, 0, 0); \
        Oc = __builtin_amdgcn_mfma_f32_16x16x32_bf16(sp1, __builtin_bit_cast(bf16x8, CUR.RQ[1]), Oc, 0, 0, 0); \
        st4bf((bf16*)OB2 + ((size_t)b * TP + (c_) * 16 + i) * 1024 + h * 64 + 16 * w + 4 * g, Oc); \
        _Pragma("unroll") for (int kb = 0; kb < 4; ++kb) { f32x4 n = cv4(CUR.Q[kb]); \
            n = __builtin_amdgcn_mfma_f32_16x16x32_bf16(__builtin_bit_cast(bf16x8, CUR.P[kb][0]), sp0, n, 0, 0, 0); \
            n = __builtin_amdgcn_mfma_f32_16x16x32_bf16(__builtin_bit_cast(bf16x8, CUR.P[kb][1]), sp1, n, 0, 0, 0); S[kb] = n; } } while (0)
    R2_LOAD(s0, 0); R2_LOAD(s1, 1);
#pragma unroll 1
    for (int c = 0; c < 126; c += 3) { R2_BODY(c, s0, s2); R2_BODY(c + 1, s1, s0); R2_BODY(c + 2, s2, s1); }
    R2_BODY(126, s0, s2); R2_BODY(127, s1, s0);
#undef R2_BODY
#undef R2_LOAD
    float* so = AOUT + O_PRWKV + ((size_t)(b * 2 + e) * 16 + h) * 4096;
#pragma unroll
    for (int kb = 0; kb < 4; ++kb) *(f32x4*)(so + (16 * w + i) * 64 + 16 * kb + 4 * g) = S[kb];
}

struct R3Raw { v2u o4, bv, g4; };
__device__ __forceinline__ void rwkv_r3_load(const Args& A, Frame& F, int b, int h, int cp, R3Raw& r) {
    const float* WAG = (const float*)(A.ws + WS_WAG);
    const int tt = F.tid >> 4, cg = F.tid & 15, hc = h * 64 + 4 * cg; const size_t m = (size_t)b * TP + cp * 32 + tt;
    r.o4 = *(const v2u*)((const bf16*)(A.ws + WS_OB2) + m * 1024 + hc); r.bv = *(const v2u*)((const bf16*)WAG + m * NLORA + hc); r.g4 = *(const v2u*)((const bf16*)WAG + m * NLORA + 2048 + hc);
}
__device__ __forceinline__ void rwkv_r3_finish(const Args& A, Frame& F, int e, int b, int h, int cp, const R3Raw& r) {
    bf16* YIN = (bf16*)(A.ws + WS_YIN);
    const int tt = F.tid >> 4, cg = F.tid & 15, hc = h * 64 + 4 * cg; const size_t m = (size_t)b * TP + cp * 32 + tt;
    const f32x4 o4 = cv4(r.o4);
    const float mean = red16((o4[0] + o4[1]) + (o4[2] + o4[3])) * (1.0f / 64.0f);
    const f32x4 d = o4 - mean;
    const float var = red16((d[0] * d[0] + d[1] * d[1]) + (d[2] * d[2] + d[3] * d[3])) * (1.0f / 64.0f);
    const float rs = 1.0f / sqrtf(var + 64e-5f);
    const f32x4 on = d * rs * ld4(PARP(PAR_LNW) + e * 1024 + hc) + ld4(PARP(PAR_LNB) + e * 1024 + hc) + cv4(r.bv);
    st4bf(YIN + m * D + hc, on * cv4(r.g4));
}

__device__ __forceinline__ void rwkv_sample8(const Args& A, Frame& F, int e, int u8) {
    const int tid = F.tid, hi = tid >> 4, lo = tid & 15, lane = F.lane, wv = F.wave;
    const bf16* PROJ = (const bf16*)(A.ws + WS_PROJ); const float* WAG = (const float*)(A.ws + WS_WAG); bf16* YIN = (bf16*)(A.ws + WS_YIN);
    LAS float* cb = (LAS float*)F.lds; LAS float* ob = cb + 32 * 384;
    const int bs = u8 >> 1, hbase = (u8 & 1) * 8;
    const int hw = hbase + wv; const size_t sidx = ((size_t)(bs * 2 + e) * 16 + hw) * 4096 + lane * 64;
    f32x4 S[16];
#pragma unroll
    for (int q = 0; q < 16; ++q) S[q] = ld4(A.in[3] + sidx + 4 * q);
    {
        const int j = hi >> 2, t = hi & 3, h = hbase + j, hc = h * 64 + 4 * lo; const size_t m = (size_t)(MP + bs * TS + t);
        const float* mu = PARP(PAR_MU) + (size_t)e * PRW;
        const f32x4 pr = ldp4(PROJ + m * NEV + hc), pk = ldp4(PROJ + m * NEV + 1024 + hc), pv = ldp4(PROJ + m * NEV + 2048 + hc);
        f32x4 qr, qk, qv;
        if (t > 0) { qr = ldp4(PROJ + (m - 1) * NEV + hc); qk = ldp4(PROJ + (m - 1) * NEV + 1024 + hc); qv = ldp4(PROJ + (m - 1) * NEV + 2048 + hc); }
        else { const float* sh = A.in[2] + (size_t)(bs * 2 + e) * PRW; qr = ld4(sh + hc); qk = ld4(sh + 1024 + hc); qv = ld4(sh + 2048 + hc); }
        const f32x4 lw_ = ldp4((const bf16*)WAG + m * NLORA + hc), wd = {__expf(lw_[0]), __expf(lw_[1]), __expf(lw_[2]), __expf(lw_[3])}, wa = ldp4((const bf16*)WAG + m * NLORA + 1024 + hc);
        const f32x4 zr = pr + (qr - pr) * ld4(mu + hc), zk = pk + (qk - pk) * ld4(mu + 1024 + hc), zv = pv + (qv - pv) * ld4(mu + 2048 + hc);
        f32x4 kk = zk * ld4(PARP(PAR_KK) + e * 1024 + hc);
        const float ss = red16((kk[0] * kk[0] + kk[1] * kk[1]) + (kk[2] * kk[2] + kk[3] * kk[3]));
        kk = kk * (1.0f / fmaxf(sqrtf(ss), 1e-12f));
        const f32x4 kp = zk * (1.0f + (wa - 1.0f) * ld4(PARP(PAR_KA) + e * 1024 + hc)), bb = kk * wa;
        LAS float* p = cb + hi * 384 + 4 * lo;
        *(LAS f32x4*)(p) = zr; *(LAS f32x4*)(p + 64) = wd; *(LAS f32x4*)(p + 128) = kp; *(LAS f32x4*)(p + 192) = kk; *(LAS f32x4*)(p + 256) = bb; *(LAS f32x4*)(p + 320) = zv;
    }
    __syncthreads();
#pragma unroll 1
    for (int t = 0; t < 4; ++t) {
        const LAS float* p = cb + (wv * 4 + t) * 384; const float vv = p[320 + lane];
        f32x4 a4 = {0.f, 0.f, 0.f, 0.f};
#pragma unroll
        for (int q = 0; q < 16; ++q) a4 += S[q] * *(const LAS f32x4*)(p + 192 + 4 * q);
        const float sa = -((a4[0] + a4[1]) + (a4[2] + a4[3]));
        f32x4 o4 = {0.f, 0.f, 0.f, 0.f};
#pragma unroll
        for (int q = 0; q < 16; ++q) { S[q] = S[q] * *(const LAS f32x4*)(p + 64 + 4 * q) + *(const LAS f32x4*)(p + 256 + 4 * q) * sa + *(const LAS f32x4*)(p + 128 + 4 * q) * vv; o4 += S[q] * *(const LAS f32x4*)(p + 4 * q); }
        ob[(wv * 4 + t) * 64 + lane] = (o4[0] + o4[1]) + (o4[2] + o4[3]);
    }
    {
        float* so = AOUT + O_SRWKV + sidx;
#pragma unroll
        for (int q = 0; q < 16; ++q) *(f32x4*)(so + 4 * q) = S[q];
    }
    __syncthreads();
    {
        const int j = hi >> 2, t = hi & 3, h = hbase + j, hc = h * 64 + 4 * lo; const size_t m = (size_t)(MP + bs * TS + t);
        const f32x4 o4 = *(const LAS f32x4*)(ob + hi * 64 + 4 * lo);
        const float mean = red16((o4[0] + o4[1]) + (o4[2] + o4[3])) * (1.0f / 64.0f);
        const f32x4 d = o4 - mean;
        const float var = red16((d[0] * d[0] + d[1] * d[1]) + (d[2] * d[2] + d[3] * d[3])) * (1.0f / 64.0f);
        const float rs = 1.0f / sqrtf(var + 64e-5f);
        const LAS float* p = cb + hi * 384 + 4 * lo;
        const f32x4 r4 = *(const LAS f32x4*)(p), kp4 = *(const LAS f32x4*)(p + 128), v4 = *(const LAS f32x4*)(p + 320);
        const f32x4 rk = ld4(PARP(PAR_RK) + e * 1024 + hc);
        const float bonus = red16((r4[0] * kp4[0] * rk[0] + r4[1] * kp4[1] * rk[1]) + (r4[2] * kp4[2] * rk[2] + r4[3] * kp4[3] * rk[3]));
        const f32x4 on = d * rs * ld4(PARP(PAR_LNW) + e * 1024 + hc) + ld4(PARP(PAR_LNB) + e * 1024 + hc) + v4 * bonus;
        st4bf(YIN + m * D + hc, on * ldp4((const bf16*)WAG + m * NLORA + 2048 + hc));
    }
    __syncthreads();
}

constexpr int NPH = 61;
#ifndef MK_FUSED
#define MK_FUSED 1
#endif

__global__ void __launch_bounds__(NTHR, 2) mega(Args A) {
    extern __shared__ __attribute__((aligned(16))) unsigned char lds_raw[];
    Frame F; F.lds = (LAS unsigned char*)lds_raw; F.tid = threadIdx.x; F.lane = F.tid & 63; F.wave = __builtin_amdgcn_readfirstlane(F.tid >> 6); F.G = gridDim.x; F.blk = blockIdx.x;
    volatile LAS unsigned* MISC = (volatile LAS unsigned*)(F.lds + MISC_OFF);
    if (F.tid < 32) MISC[F.tid] = 0u;
    __syncthreads();
    const int lo = A.ph_lo, hi = A.ph_hi;
    XcdBarrier bar; bar.bar = (unsigned*)(A.ws + WS_CTL) + CW_BAR + A.li * XCD_BAR_WORDS; bar.x = 0; bar.st = nullptr;
    if (hi - lo > 1) bar = xcd_barrier_post(bar.bar, MISC + 8);
#ifndef SEL_MASK
#define SEL_MASK 0xFFFFFFFFu
#endif
#ifndef REP_MASK
#define REP_MASK 0u
#endif
#ifndef REP_N
#define REP_N 2
#endif
#ifndef FOLD_O4
#define FOLD_O4 1
#endif
#define SITE(n) ((SEL_MASK >> (n)) & 1u)
#define NREP(n) (((REP_MASK >> (n)) & 1u) ? REP_N : 1)
#define PH_BEGIN(n) if (ph >= lo && ph < hi) { asm volatile("" : "+v"(F.tid), "+v"(F.lane), "+s"(F.wave), "+s"(F.blk), "+s"(F.G), "+s"(A.ws), "+s"(A.out)); \
    if (SITE(n)) for (int rep_ = 0; rep_ < NREP(n); ++rep_) { if (rep_) xcd_barrier(bar);
#ifndef BAR_REP
#define BAR_REP 1
#endif
#define PH_END } if (ph + 1 < hi) for (int br_ = 0; br_ < BAR_REP; ++br_) xcd_barrier(bar); } ++ph;
    int ph = 0;
    PH_BEGIN(1) p0_prologue(A, F); PH_END
#pragma nounroll
    for (int l = 0; l < 4; ++l) {
        const int e = l >> 1; const bool even = !(l & 1);
#pragma nounroll
        for (int s = 0; s < 3; ++s) {
            if (s != 1) {
                const int mat = l * 2 + (s >> 1);
                PH_BEGIN(2) {
                    pg8::Gemm g{(const bf16*)(A.ws + WS_XN), (const bf16*)(A.ws + WS_WGU) + (size_t)mat * (SZ_WGU / 2), D, D}; pg8::StaticOrder S; S.init(M, 2 * FF, D, F.G, F.blk);
                    pg8::EpiSwiGLU E{(bf16*)(A.ws + WS_H), FF, (const float*)(A.ws + WS_RSTD)};
                    pg8::gemm_phase<pg8::EpiSwiGLU, pg8::StaticOrder, true, true>(F.lds, g, S, E);
                } PH_END
            } else if (even) {
                PH_BEGIN(3) {
                    pg8::Gemm g{(const bf16*)(A.ws + WS_XN), (const bf16*)(A.ws + WS_WEVIN) + (size_t)e * (SZ_WEVIN / 2), D, D}; pg8::StaticOrder S; S.init(M, NEV, D, F.G, F.blk);
                    pg8::EpiStoreBf16 E{(bf16*)(A.ws + WS_PROJ), NEV, (const float*)(A.ws + WS_RSTD)};
                    pg8::gemm_phase<pg8::EpiStoreBf16, pg8::StaticOrder, true, true>(F.lds, g, S, E);
                } PH_END
                PH_BEGIN(4) e2_prep(A, F, e); PH_END
                PH_BEGIN(5) {
                    pg8::Gemm g{(const bf16*)(A.ws + WS_LA), (const bf16*)(A.ws + WS_WLORA) + (size_t)e * NLORA * KLORA, KLORA, KLORA}; pg8::StaticOrder S; S.init(M, NLORA, KLORA, F.G, F.blk);
                    pg8::EpiLora E{(bf16*)(A.ws + WS_WAG), PARP(PAR_W0) + e * 1024, PARP(PAR_A0) + e * 1024};
                    pg8::gemm_phase<pg8::EpiLora, pg8::StaticOrder, true, true>(F.lds, g, S, E);
                } PH_END
#ifndef R1W
#define R1W 1
#endif
#if R1W
                PH_BEGIN(16) {
#if !R1O_MASK
                    rwkv_r1w_phase(A, F, e);
#endif
#if R1O_MASK
                    { R1Raw raw = {}, nraw = {}; if (F.blk < 4096) rwkv_r1_load(A, F, F.blk >> 10, (F.blk >> 6) & 15, F.blk & 63, raw);
                    for (int u = F.blk; u < 4096; u += F.G) { asm volatile("" : "+v"(F.tid), "+v"(F.lane), "+s"(F.wave), "+s"(A.ws)); const int un = u + F.G; if (un < 4096) rwkv_r1_load(A, F, un >> 10, (un >> 6) & 15, un & 63, nraw);
                        rwkv_r1_unit(A, F, e, u >> 10, (u >> 6) & 15, u & 63, raw); raw = nraw; } }
                    xcd_barrier(bar);
                    rwkv_r1w_phase(A, F, e);
#endif
                } PH_END
#else
                PH_BEGIN(16) { R1Raw raw = {}, nraw = {}; if (F.blk < 4096) rwkv_r1_load(A, F, F.blk >> 10, (F.blk >> 6) & 15, F.blk & 63, raw);
                    for (int u = F.blk; u < 4096; u += F.G) { asm volatile("" : "+v"(F.tid), "+v"(F.lane), "+s"(F.wave), "+s"(A.ws)); const int un = u + F.G; if (un < 4096) rwkv_r1_load(A, F, un >> 10, (un >> 6) & 15, un & 63, nraw);
                        rwkv_r1_unit(A, F, e, u >> 10, (u >> 6) & 15, u & 63, raw); raw = nraw; } } PH_END
#endif
                PH_BEGIN(6) {
#ifndef REP_E4A
#define REP_E4A 1
#define REP_E4B 1
#define REP_E4C 1
#define REP_E4D 1
#endif
#ifndef R2_TWICE
#define R2_TWICE 0
#endif
#ifndef R2_ONLY_FIRST_REP
#define R2_ONLY_FIRST_REP 0
#endif
                    if (F.blk < 64 && !(R2_ONLY_FIRST_REP && rep_ > 0)) { rwkv_r2_head(A, F, e, F.blk >> 4, F.blk & 15);
#if R2_TWICE
                        asm volatile("" : "+v"(F.tid), "+v"(F.lane), "+s"(F.wave)); rwkv_r2_head(A, F, e, F.blk >> 4, F.blk & 15);
#endif
                    }
                    {
                        unsigned* ctr = (unsigned*)(A.ws + WS_CTL) + 2048 + 64 * e + 16 * rep_;
                        unsigned nxt = 0;
                        if (F.tid == 0) nxt = __hip_atomic_fetch_add(ctr, 1u, __ATOMIC_RELAXED, __HIP_MEMORY_SCOPE_AGENT);
                        for (;;) {
                            asm volatile("" : "+v"(F.tid), "+v"(F.lane), "+s"(F.wave), "+s"(A.ws));
                            if (F.tid == 0) MISC[16] = nxt;
                            __syncthreads(); const int w = (int)MISC[16]; __syncthreads();
                            if (w >= 2304) break;
                            if (F.tid == 0) nxt = __hip_atomic_fetch_add(ctr, 1u, __ATOMIC_RELAXED, __HIP_MEMORY_SCOPE_AGENT);
                            if (w < 1024) { for (int rq = 0; rq < REP_E4B; ++rq) hgrn_chunk_unit2(A, F, e, w >> 8, (w >> 5) & 7, w & 31); }
                            else if (w < 2048) { for (int rq = 0; rq < REP_E4C; ++rq) hgrn_sample_unit(A, F, e, (w - 1024) >> 3, w & 7); }
                            else rwkv_sample8(A, F, e, w - 2048);
                        }
                    }
                } PH_END
                PH_BEGIN(7) hgrn_state_scan(A, F, e); PH_END
                PH_BEGIN(8) { { HfRaw hr = {}, hn = {}; if (F.blk < 1024) hgrn_finish_load(A, F, F.blk >> 8, (F.blk >> 5) & 7, F.blk & 31, hr);
                    for (int w = F.blk; w < 1024; w += F.G) { asm volatile("" : "+v"(F.tid), "+v"(F.lane), "+s"(F.wave), "+s"(A.ws)); const int wn = w + F.G;
                        hgrn_finish_unit(A, F, e, w >> 8, (w >> 5) & 7, w & 31, hr, wn < 1024, wn >> 8, (wn >> 5) & 7, wn & 31, hn); hr = hn; } }
                    for (int u = F.blk; u < 4096; u += 4 * F.G) {
                        R3Raw r3[4] = {};
#pragma unroll
                        for (int q = 0; q < 4; ++q) { const int uq = u + q * F.G; if (uq < 4096) rwkv_r3_load(A, F, uq >> 10, (uq >> 6) & 15, uq & 63, r3[q]); }
#pragma unroll
                        for (int q = 0; q < 4; ++q) { const int uq = u + q * F.G; if (uq < 4096) rwkv_r3_finish(A, F, e, uq >> 10, (uq >> 6) & 15, uq & 63, r3[q]); }
                    } } PH_END
            } else {
                PH_BEGIN(9) {
                    pg8::Gemm g{(const bf16*)(A.ws + WS_XN), (const bf16*)(A.ws + WS_WODIN) + (size_t)e * (SZ_WODIN / 2), D, D}; pg8::OddInOrder S; S.init(F.G, F.blk);
                    pg8::EpiOddIn E{(bf16*)(A.ws + WS_GATE), (bf16*)(A.ws + WS_XB), (const float*)(A.ws + WS_RSTD), (bf16*)(A.ws + WS_OSLAB)};
                    pg8::gemm_phase<pg8::EpiOddIn, pg8::OddInOrder, true, true>(F.lds, g, S, E);
                } PH_END
                PH_BEGIN(10) o2_conv(A, F, e); PH_END
                PH_BEGIN(11) {
                    pg8::Gemm g{(const bf16*)(A.ws + WS_XCB), (const bf16*)(A.ws + WS_WLRU) + (size_t)e * 4096 * 256, 2048, 256}; int nt4 = 4; asm volatile("" : "+s"(nt4)); pg8::LruOrder S{F.G, F.blk, nt4};
                    pg8::EpiLru E{(const bf16*)(A.ws + WS_XCB), (bf16*)(A.ws + WS_LRA), (bf16*)(A.ws + WS_LRB), PARP(PAR_BA) + e * 2048, PARP(PAR_BX) + e * 2048, PARP(PAR_LAM) + e * 2048};
                    pg8::gemm_phase<pg8::EpiLru, pg8::LruOrder, true, true>(F.lds, g, S, E);
#if FOLD_O4
                    o4_tail(A, F);
#endif
                } PH_END
#if FOLD_O4
                PH_BEGIN(13) o5_lru_scan(A, F, e); PH_END
                ph += 3;
#else
                PH_BEGIN(12) o4_lru_chunks(A, F); PH_END
                PH_BEGIN(13) o5_lru_scan(A, F, e); PH_END
                ph += 2;
#endif
            }
            PH_BEGIN(14) {
                const bf16* Ap; const bf16* Bp; int K; float scale;
                if (s != 1) { Ap = (const bf16*)(A.ws + WS_H); K = FF; scale = 0.5f; Bp = (const bf16*)(A.ws + WS_WDN) + (size_t)(l * 2 + (s >> 1)) * (SZ_WDN / 2); }
                else { Ap = (const bf16*)(A.ws + WS_YIN); K = D; scale = 1.0f; Bp = (const bf16*)(A.ws + (even ? WS_WEVOUT : WS_WODOUT)) + (size_t)e * (SZ_WSQ / 2); }
                pg8::Gemm g{Ap, Bp, K, K}; pg8::ResidOrder S; S.init(K, F.G, F.blk);
                const bool fin = (s == 2 && l == 3);
                const float* gnext = s == 0 ? PARP(PAR_MIXN) + l * D : (s == 1 ? PARP(PAR_FFN2N) + l * D : PARP(PAR_FFN1N) + ((l + 1) & 3) * D);
                pg8::EpiResid E{(float*)(A.ws + WS_X), D, scale / (float)(NREP(14) * EPI_REP), (float*)(A.ws + WS_SLAB), (bf16*)(A.ws + WS_XN), fin ? nullptr : gnext, (float*)(A.ws + WS_SSP)};
                pg8::gemm_phase<pg8::EpiResid, pg8::ResidOrder, true, true>(F.lds, g, S, E);
            } PH_END
            PH_BEGIN(15) {
                const float* gain = s == 0 ? PARP(PAR_MIXN) + l * D : (s == 1 ? PARP(PAR_FFN2N) + l * D : (l < 3 ? PARP(PAR_FFN1N) + (l + 1) * D : PARP(PAR_FINN)));
                const int K = s != 1 ? FF : D, PU = K / 128; const int sf = F.G == 256 ? ((PU / 2) < 16 ? (PU / 2) : 16) : 0;
                if (s == 2 && l == 3) norm_phase(A, F, gain, true, sf, (s != 1 ? 0.5f : 1.0f) / (float)NREP(15)); else rstd_phase(A, F, gain, sf, (s != 1 ? 0.5f : 1.0f) / (float)NREP(15));
            } PH_END
        }
    }
}

extern "C" void kernel_launch(void* const* d_in, const int* in_sizes, int n_in, void* d_out, int out_size, void* d_ws, size_t ws_size, hipStream_t stream) {
    static int grid = 0;
    if (grid == 0) {
        if (n_in != 39 || (size_t)out_size != O_END || ws_size < WS_END) { fprintf(stderr, "kernel_launch: unexpected shapes (n_in %d out %d ws %zu need %zu)\n", n_in, out_size, ws_size, (size_t)WS_END); grid = -1; return; }
        int dev = 0, cus = 0;
        if (hipGetDevice(&dev) != hipSuccess || hipDeviceGetAttribute(&cus, hipDeviceAttributeMultiprocessorCount, dev) != hipSuccess) { grid = -1; return; }
        if (hipFuncSetAttribute((const void*)mega, hipFuncAttributeMaxDynamicSharedMemorySize, LDS_BYTES) != hipSuccess) { fprintf(stderr, "kernel_launch: hipFuncSetAttribute failed\n"); grid = -1; return; }
        int per_cu = 0;
        if (hipOccupancyMaxActiveBlocksPerMultiprocessor(&per_cu, (const void*)mega, NTHR, LDS_BYTES) != hipSuccess || per_cu < 1) fprintf(stderr, "kernel_launch: occupancy query reports %d blocks per CU\n", per_cu);
        (void)hipGetLastError();
        grid = cus;
    }
    if (grid < 0) return;
    (void)hipMemsetAsync((char*)d_ws + WS_CTL, 0, CTL_ZERO_BYTES, stream);
    Args a{};
    for (int i = 0; i < 39; ++i) a.in[i] = (const float*)d_in[i];
    a.out = (GAS float*)d_out; a.ws = (GAS unsigned char*)d_ws; a.li = 0; a.pad = 0;
#if MK_FUSED
    a.ph_lo = 0; a.ph_hi = NPH;
    hipLaunchKernelGGL(mega, dim3(grid), dim3(NTHR), LDS_BYTES, stream, a);
#else
    for (int p = 0; p < NPH; ++p) {
        if (p >= 1 && (((p - 1) % 15) == 8 || ((p - 1) % 15) == 9) && (((p - 1) / 15) & 1)) continue;
        a.ph_lo = p; a.ph_hi = p + 1;
        hipLaunchKernelGGL(mega, dim3(grid), dim3(NTHR), LDS_BYTES, stream, a);
    }
#endif
}
```

```cpp
#include <hip/hip_runtime.h>
#include <cstdio>
#include <cstdint>

#ifndef EPI_REP
#define EPI_REP 1
#endif
constexpr int D = 2048, MP = 8192, MS = 512, M = MP + MS, FF = 5632;
constexpr int TP = 2048, BP = 4, TS = 4, BS = 128, NSEQ = BP + BS;
constexpr int RW = 1024, RH = 16, PRW = 3520, PEV = 7616, NEV = 7680;
constexpr int HGH = 8;
constexpr int NLORA = 3072, KLORA = 512;
constexpr int NWAVES = 8, NTHR = 512;

namespace pg8 {
#define PG8_LAS __attribute__((address_space(3)))
typedef unsigned short bf16_t;
typedef short bf16x8 __attribute__((ext_vector_type(8)));
typedef float f32x4 __attribute__((ext_vector_type(4)));
typedef float f32x2 __attribute__((ext_vector_type(2)));
typedef unsigned u32x4 __attribute__((ext_vector_type(4)));
typedef unsigned u32x2 __attribute__((ext_vector_type(2)));
constexpr int BM = 256, BK = 64, HALF = 128, HTB = HALF * BK * 2  , STAGE_BYTES = 8 * HTB, NXCD = 8, WGM = 8;

__host__ __device__ __forceinline__ int lds_byte(int r, int c) { const int st = (r >> 4) * 2 + (c >> 5), rr = r & 15, cc = c & 31, ob = rr * 64 + cc * 2; return st * 1024 + (ob ^ (((ob >> 9) & 1) << 5)); }
__host__ __device__ __forceinline__ void stage_rc(int b, int& R, int& C) { const int st = b / 1024, sb = b % 1024, swz = sb ^ (((sb >> 9) & 1) << 5); R = (st >> 1) * 16 + swz / 64; C = (st & 1) * 32 + (swz % 64) / 2; }
__host__ __device__ __forceinline__ int perm32(int rho) { const int n = rho >> 4, i = rho & 15; return 8 * (i >> 2) + 4 * n + (i & 3); }

struct Unit { int pm, pn, ka, kb, nt, slab; };
struct Gemm { const bf16_t* A; const bf16_t* Bt; int lda, ldb; };

struct StaticOrder {
    int nM, nN, nwg, G, c, nt;
    __device__ void init(int Mr, int N, int K, int G_, int c_) { nM = Mr / BM; nN = N / BM; nwg = nM * nN; G = G_; c = c_; nt = K / BK; }
    __device__ bool next(int i, Unit& u) const {
        const long L = (long)i * G + c; if (L >= nwg) return false;
        int wgid = (int)L; { const int q = nwg / NXCD, r = nwg % NXCD, xcd = wgid % NXCD, off = wgid / NXCD; wgid = (xcd < r ? xcd * (q + 1) : r * (q + 1) + (xcd - r) * q) + off; }
        const int nig = WGM * nN, gid = wgid / nig, fm = gid * WGM, gsz = (nM - fm) < WGM ? (nM - fm) : WGM;
        u.pm = fm + ((wgid % nig) % gsz); u.pn = (wgid % nig) / gsz; u.ka = 0; u.kb = 0; u.nt = nt; u.slab = -1; return true;
    }
    __device__ __forceinline__ void a_ready(const Unit&) const {}
    __device__ __forceinline__ void done(const Unit&) const {}
};
struct LoraOrder {
    StaticOrder so; int nt;
    __device__ bool next(int i, Unit& u) const { if (!so.next(i, u)) return false; const int off = ((u.pn >> 2) == 2) ? 192 : 0; u.ka = off; u.kb = off; u.nt = nt; return true; }
    __device__ __forceinline__ void a_ready(const Unit&) const {}
    __device__ __forceinline__ void done(const Unit&) const {}
};
__device__ __forceinline__ void resid_tile(int L, int& pm, int& pn) {
    if (L >= 256) { pm = 32 + ((L - 256) >> 3); pn = (L - 256) & 7; return; }
    const int wgid = (L % NXCD) * 32 + L / NXCD; pm = 8 * (wgid / 64) + ((wgid % 64) % 8); pn = (wgid % 64) / 8;
}
struct ResidOrder {
    StaticOrder so; int SF, PU; bool split;
    __device__ void init(int K, int G_, int c_) { so.init(M, 2048, K, G_, c_); PU = K / 128; SF = (PU / 2) < 16 ? (PU / 2) : 16; split = (G_ == 256); }
    __device__ bool next(int i, Unit& u) const {
        if (!split) return so.next(i, u);
        const int j = so.c / SF, p = so.c % SF; const bool piece = j < 16;
        if ((i == 0 && !piece) || (i == 1 && piece)) { resid_tile(so.c, u.pm, u.pn); u.ka = 0; u.kb = 0; u.nt = so.nt; u.slab = -1; return true; }
        if (i == 0) { resid_tile(256 + j, u.pm, u.pn); const int p0 = (p * PU) / SF, p1 = ((p + 1) * PU) / SF; u.ka = p0 * 128; u.kb = p0 * 128; u.nt = (p1 - p0) * 2; u.slab = j * SF + p; return true; }
        return false;
    }
    __device__ __forceinline__ void a_ready(const Unit&) const {}
    __device__ __forceinline__ void done(const Unit&) const {}
};
struct OddInOrder {
    StaticOrder so; bool split;
    __device__ void init(int G_, int c_) { so.init(M, 4096, 2048, G_, c_); split = (G_ == 256); }
    __device__ bool next(int i, Unit& u) const {
        if (!split) return so.next(i, u);
        if (i == 0) { const int j = so.c >> 3, p = so.c & 7; u.pm = 32 + (j >> 4); u.pn = j & 15; u.ka = p * 256; u.kb = p * 256; u.nt = 4; u.slab = so.c; return true; }
        if (i > 2) return false;
        const int L = (i - 1) * 256 + so.c, wgid = (L % NXCD) * 64 + L / NXCD;
        u.pm = 8 * (wgid / 128) + ((wgid % 128) % 8); u.pn = (wgid % 128) / 8; u.ka = 0; u.kb = 0; u.nt = so.nt; u.slab = -1; return true;
    }
    __device__ __forceinline__ void a_ready(const Unit&) const {}
    __device__ __forceinline__ void done(const Unit&) const {}
};
struct LruOrder {
    int G, c, nt;
    __device__ bool next(int i, Unit& u) const {
        const int L = i * G + c; if (L >= (M / BM) * 16) return false;
        u.pm = L >> 4; u.pn = L & 15; u.ka = 256 * (u.pn >> 1); u.kb = 0; u.nt = nt; u.slab = -1; return true;
    }
    __device__ __forceinline__ void a_ready(const Unit&) const {}
    __device__ __forceinline__ void done(const Unit&) const {}
};

__device__ __forceinline__ unsigned cvt_pk_bf16(float lo, float hi) {
    typedef float f2_ __attribute__((ext_vector_type(2))); typedef __bf16 b2_ __attribute__((ext_vector_type(2)));
    return __builtin_bit_cast(unsigned, __builtin_convertvector((f2_){lo, hi}, b2_));
}
__device__ __forceinline__ float sigm(float x) { return __builtin_amdgcn_rcpf(1.0f + __expf(-x)); }
__device__ __forceinline__ float log1p_pos(float t) { return t < 0.01f ? t * (1.0f - t * (0.5f - t * 0.33333333f)) : __logf(1.0f + t); }
__device__ __forceinline__ float softplus_(float y) { return fmaxf(y, 0.0f) + log1p_pos(__expf(-fabsf(y))); }
__device__ __forceinline__ float silu_(float x) { return x * sigm(x); }
__device__ __forceinline__ float gelu_tanh(float x) { return x * sigm(1.5957691216057308f * (x + 0.044715f * x * x * x)); }
__device__ __forceinline__ float neg_expm1(float x) {
    if (x > -0.25f) { return -x * (1.0f + x * (0.5f + x * (0.16666667f + x * (0.041666668f + x * (0.0083333338f + x * 0.0013888889f))))); }
    return 1.0f - __expf(x);
}

struct EpiSwiGLU {
    static constexpr bool PERM = true, AFTER_DRAIN = false;
    bf16_t* H; int ldh; const float* rstd;
    __device__ __forceinline__ void operator()(const f32x4 (&acc)[2][2][4][2], const Unit& u, int wr, int wc, int fr, int fq) const {
        const int row0 = u.pm * BM + wr * 64 + fr, col0 = u.pn * HALF + wc * 32 + 8 * fq;
        float rsv[2][4];
#pragma unroll
        for (int ai = 0; ai < 2; ++ai)
#pragma unroll
            for (int m = 0; m < 4; ++m) rsv[ai][m] = rstd[row0 + ai * HALF + m * 16];
#pragma unroll
        for (int ai = 0; ai < 2; ++ai)
#pragma unroll
            for (int m = 0; m < 4; ++m) {
                bf16_t* rowp = H + (size_t)(row0 + ai * HALF + m * 16) * ldh + col0;
                const float rs = rsv[ai][m];
                const f32x4 g0 = acc[ai][0][m][0] * rs, g1 = acc[ai][0][m][1] * rs, u0 = acc[ai][1][m][0] * rs, u1 = acc[ai][1][m][1] * rs;
                u32x4 w;
                w.x = cvt_pk_bf16(silu_(g0[0]) * u0[0], silu_(g0[1]) * u0[1]); w.y = cvt_pk_bf16(silu_(g0[2]) * u0[2], silu_(g0[3]) * u0[3]);
                w.z = cvt_pk_bf16(silu_(g1[0]) * u1[0], silu_(g1[1]) * u1[1]); w.w = cvt_pk_bf16(silu_(g1[2]) * u1[2], silu_(g1[3]) * u1[3]);
                *(u32x4*)rowp = w;
            }
    }
};
struct EpiResid {
    static constexpr bool PERM = true, AFTER_DRAIN = false;
    float* X; int ldx; float scale; float* SLAB; bf16_t* XR; const float* gain; float* SSP;
    __device__ __forceinline__ void operator()(const f32x4 (&acc)[2][2][4][2], const Unit& u, int wr, int wc, int fr, int fq) const {
        if (u.slab >= 0) {
            bf16_t* base = (bf16_t*)SLAB + (size_t)u.slab * 65536 + (wr * 64 + fr) * 256 + wc * 32 + 8 * fq;
#pragma unroll
            for (int ai = 0; ai < 2; ++ai)
#pragma unroll
                for (int m = 0; m < 4; ++m)
#pragma unroll
                    for (int bj = 0; bj < 2; ++bj)
#pragma unroll
                        for (int n = 0; n < 2; ++n) { const f32x4 v = acc[ai][bj][m][n]; u32x2 w2; w2.x = cvt_pk_bf16(v[0], v[1]); w2.y = cvt_pk_bf16(v[2], v[3]); *(u32x2*)(base + (ai * HALF + m * 16) * 256 + bj * HALF + n * 4) = w2; }
            return;
        }
        const int row0 = u.pm * BM + wr * 64 + fr, col0 = u.pn * BM + wc * 32 + 8 * fq;
        f32x4 gv[2][2];
#pragma unroll
        for (int bj = 0; bj < 2; ++bj)
#pragma unroll
            for (int n = 0; n < 2; ++n) gv[bj][n] = gain ? *(const f32x4*)(gain + col0 + bj * HALF + n * 4) : (f32x4){0.f, 0.f, 0.f, 0.f};
#pragma unroll
        for (int aim = 0; aim < 4; ++aim) { const int ai = aim >> 1, mb = (aim & 1) * 2;
            f32x4 xv[4][2][2];
#pragma unroll
            for (int m = mb; m < mb + 2; ++m)
#pragma unroll
                for (int bj = 0; bj < 2; ++bj)
#pragma unroll
                    for (int n = 0; n < 2; ++n) xv[m][bj][n] = *(const f32x4*)(X + (size_t)(row0 + ai * HALF + m * 16) * ldx + col0 + bj * HALF + n * 4);
#pragma unroll
            for (int m = mb; m < mb + 2; ++m) {
                const int row = row0 + ai * HALF + m * 16;
                float* rowp = X + (size_t)row * ldx + col0; float ssq = 0.f;
#pragma unroll
                for (int bj = 0; bj < 2; ++bj)
#pragma unroll
                    for (int n = 0; n < 2; ++n) { f32x4* p = (f32x4*)(rowp + bj * HALF + n * 4); const f32x4 o = xv[m][bj][n] + acc[ai][bj][m][n] * scale; *p = o;
                        if (gain) { ssq += (o[0] * o[0] + o[1] * o[1]) + (o[2] * o[2] + o[3] * o[3]); const f32x4 y = o * gv[bj][n];
                            u32x2 w2; w2.x = cvt_pk_bf16(y[0], y[1]); w2.y = cvt_pk_bf16(y[2], y[3]); *(u32x2*)(XR + (size_t)row * ldx + col0 + bj * HALF + n * 4) = w2; } }
                if (gain) { ssq += __shfl_xor(ssq, 16); ssq += __shfl_xor(ssq, 32); if (fq == 0) SSP[(size_t)row * 32 + u.pn * 4 + wc] = ssq; }
            }
        }
    }
};
struct EpiStoreBf16 {
    static constexpr bool PERM = true, AFTER_DRAIN = false;
    bf16_t* O; int ldo; const float* rstd;
    __device__ __forceinline__ void operator()(const f32x4 (&acc)[2][2][4][2], const Unit& u, int wr, int wc, int fr, int fq) const {
        const int row0 = u.pm * BM + wr * 64 + fr, col0 = u.pn * BM + wc * 32 + 8 * fq;
        float rsv[2][4];
#pragma unroll
        for (int ai = 0; ai < 2; ++ai)
#pragma unroll
            for (int m = 0; m < 4; ++m) rsv[ai][m] = rstd[row0 + ai * HALF + m * 16];
#pragma unroll
        for (int ai = 0; ai < 2; ++ai)
#pragma unroll
            for (int m = 0; m < 4; ++m) {
                bf16_t* rowp = O + (size_t)(row0 + ai * HALF + m * 16) * ldo + col0; const float rs = rsv[ai][m];
#pragma unroll
                for (int bj = 0; bj < 2; ++bj) { const f32x4 v0 = acc[ai][bj][m][0] * rs, v1 = acc[ai][bj][m][1] * rs;
                    u32x4 w; w.x = cvt_pk_bf16(v0[0], v0[1]); w.y = cvt_pk_bf16(v0[2], v0[3]); w.z = cvt_pk_bf16(v1[0], v1[1]); w.w = cvt_pk_bf16(v1[2], v1[3]);
                    *(u32x4*)(rowp + bj * HALF) = w; }
            }
    }
};
struct EpiLora {
    static constexpr bool PERM = true, AFTER_DRAIN = false;
    bf16_t* O; const float* w0; const float* a0;
    __device__ __forceinline__ void operator()(const f32x4 (&acc)[2][2][4][2], const Unit& u, int wr, int wc, int fr, int fq) const {
        const int row0 = u.pm * BM + wr * 64 + fr, col0 = u.pn * BM + wc * 32 + 8 * fq, ty = u.pn >> 2;
        f32x4 bv[2][2];
#pragma unroll
        for (int bj = 0; bj < 2; ++bj)
#pragma unroll
            for (int n = 0; n < 2; ++n) { const int c = (col0 + bj * HALF + n * 4) & 1023; bv[bj][n] = ty == 0 ? *(const f32x4*)(w0 + c) : (ty == 1 ? *(const f32x4*)(a0 + c) : (f32x4){0.f, 0.f, 0.f, 0.f}); }
#pragma unroll
        for (int ai = 0; ai < 2; ++ai)
#pragma unroll
            for (int m = 0; m < 4; ++m) {
                bf16_t* rowp = O + (size_t)(row0 + ai * HALF + m * 16) * NLORA + col0;
#pragma unroll
                for (int bj = 0; bj < 2; ++bj)
#pragma unroll
                    for (int n = 0; n < 2; ++n) {
                        f32x4 v = acc[ai][bj][m][n] + bv[bj][n];
                        if (ty == 0) {
#pragma unroll
                            for (int i = 0; i < 4; ++i) v[i] = -0.60653065971f * sigm(v[i]);
                        } else if (ty == 1) {
#pragma unroll
                            for (int i = 0; i < 4; ++i) v[i] = sigm(v[i]);
                        }
                        u32x2 w2_; w2_.x = cvt_pk_bf16(v[0], v[1]); w2_.y = cvt_pk_bf16(v[2], v[3]); *(u32x2*)(rowp + bj * HALF + n * 4) = w2_;
                    }
            }
    }
};
struct EpiOddIn {
    static constexpr bool PERM = true, AFTER_DRAIN = false;
    bf16_t* GATE; bf16_t* XB; const float* rstd; bf16_t* SLAB;
    __device__ __forceinline__ void operator()(const f32x4 (&acc)[2][2][4][2], const Unit& u, int wr, int wc, int fr, int fq) const {
        if (u.slab >= 0) {
            bf16_t* base = SLAB + (size_t)u.slab * 65536 + (wr * 64 + fr) * 256 + wc * 32 + 8 * fq;
#pragma unroll
            for (int ai = 0; ai < 2; ++ai)
#pragma unroll
                for (int m = 0; m < 4; ++m)
#pragma unroll
                    for (int bj = 0; bj < 2; ++bj) { const f32x4 v0 = acc[ai][bj][m][0], v1 = acc[ai][bj][m][1];
                        u32x4 w; w.x = cvt_pk_bf16(v0[0], v0[1]); w.y = cvt_pk_bf16(v0[2], v0[3]); w.z = cvt_pk_bf16(v1[0], v1[1]); w.w = cvt_pk_bf16(v1[2], v1[3]);
                        *(u32x4*)(base + (ai * HALF + m * 16) * 256 + bj * HALF) = w; }
            return;
        }
        const int row0 = u.pm * BM + wr * 64 + fr, col0 = (u.pn & 7) * BM + wc * 32 + 8 * fq; const bool isg = u.pn < 8;
        bf16_t* dst = isg ? GATE : XB;
        float rsv[2][4];
#pragma unroll
        for (int ai = 0; ai < 2; ++ai)
#pragma unroll
            for (int m = 0; m < 4; ++m) rsv[ai][m] = rstd[row0 + ai * HALF + m * 16];
#pragma unroll
        for (int ai = 0; ai < 2; ++ai)
#pragma unroll
            for (int m = 0; m < 4; ++m) {
                const size_t ro = (size_t)(row0 + ai * HALF + m * 16) * 2048 + col0; const float rs = rsv[ai][m];
#pragma unroll
                for (int bj = 0; bj < 2; ++bj) {
                    f32x4 v0 = acc[ai][bj][m][0] * rs, v1 = acc[ai][bj][m][1] * rs;
                    if (isg) {
#pragma unroll
                        for (int q = 0; q < 4; ++q) { v0[q] = gelu_tanh(v0[q]); v1[q] = gelu_tanh(v1[q]); } }
                    u32x4 w; w.x = cvt_pk_bf16(v0[0], v0[1]); w.y = cvt_pk_bf16(v0[2], v0[3]); w.z = cvt_pk_bf16(v1[0], v1[1]); w.w = cvt_pk_bf16(v1[2], v1[3]);
                    *(u32x4*)(dst + ro + bj * HALF) = w;
                }
            }
    }
};
struct EpiLru {
    static constexpr bool PERM = true, AFTER_DRAIN = false;
    const bf16_t* XC; bf16_t* OA; bf16_t* OB; const float* ba; const float* bx; const float* lam;
    __device__ __forceinline__ void operator()(const f32x4 (&acc)[2][2][4][2], const Unit& u, int wr, int wc, int fr, int fq) const {
        const int row0 = u.pm * BM + wr * 64 + fr, ch0 = u.pn * HALF + wc * 32 + 8 * fq;
#pragma unroll
        for (int n = 0; n < 2; ++n) {
            const f32x4 vba = *(const f32x4*)(ba + ch0 + n * 4), vbx = *(const f32x4*)(bx + ch0 + n * 4), l = *(const f32x4*)(lam + ch0 + n * 4); f32x4 vsl;
#pragma unroll
            for (int i = 0; i < 4; ++i) vsl[i] = -8.0f * softplus_(-l[i]);
            u32x2 xw[2][4];
#pragma unroll
            for (int ai = 0; ai < 2; ++ai)
#pragma unroll
                for (int m = 0; m < 4; ++m) xw[ai][m] = *(const u32x2*)(XC + (size_t)(row0 + ai * HALF + m * 16) * 2048 + ch0 + n * 4);
#pragma unroll
            for (int ai = 0; ai < 2; ++ai)
#pragma unroll
                for (int m = 0; m < 4; ++m) {
                    const size_t ro = (size_t)(row0 + ai * HALF + m * 16) * 2048 + ch0 + n * 4;
                    const f32x4 ga = acc[ai][0][m][n] + vba, gx = acc[ai][1][m][n] + vbx; const u32x2 w2 = xw[ai][m];
                    const f32x4 xc = {__builtin_bit_cast(float, w2.x << 16), __builtin_bit_cast(float, w2.x & 0xffff0000u), __builtin_bit_cast(float, w2.y << 16), __builtin_bit_cast(float, w2.y & 0xffff0000u)};
                    f32x4 la, b;
#pragma unroll
                    for (int i = 0; i < 4; ++i) { la[i] = vsl[i] * sigm(ga[i]); b[i] = sqrtf(neg_expm1(2.0f * la[i])) * sigm(gx[i]) * xc[i]; }
                    u32x2 wa_, wb_; wa_.x = cvt_pk_bf16(la[0], la[1]); wa_.y = cvt_pk_bf16(la[2], la[3]); wb_.x = cvt_pk_bf16(b[0], b[1]); wb_.y = cvt_pk_bf16(b[2], b[3]);
                    *(u32x2*)(OA + ro) = wa_; *(u32x2*)(OB + ro) = wb_;
                }
        }
    }
};

template <class Epi, class Sched, bool ALIGN_EPI = false, bool SP2 = false>
__device__ __forceinline__ void gemm_phase(PG8_LAS unsigned char* lds, const Gemm g, const Sched& S, const Epi& E) {
    int tid_ = threadIdx.x; asm volatile("" : "+v"(tid_));
    const int tid = tid_, wid = __builtin_amdgcn_readfirstlane(tid >> 6), lane = tid & 63, wr = wid >> 2, wc = wid & 3, fr = lane & 15, fq = lane >> 4;
    const int lda = g.lda, ldb = g.ldb;
    unsigned voffA[2], voffB[2];
#pragma unroll
    for (int i = 0; i < 2; ++i) { int R, C; stage_rc(tid * 16 + i * 8192, R, C); const int Rb = Epi::PERM ? ((R & ~31) + perm32(R & 31)) : R;
        voffA[i] = (unsigned)(R * lda + C) * 2u; voffB[i] = (unsigned)(Rb * ldb + C) * 2u; }
    const size_t kstep = (size_t)(BK * 2);
    const size_t hstepA = (size_t)HALF * lda * 2, hstepB = (size_t)HALF * ldb * 2;
    const size_t tstepA = 2 * hstepA, tstepB = 2 * hstepB;
    const unsigned ldsw = (unsigned)wid * 1024u;
    const int aoff = lds_byte(wr * 64 + fr, fq * 8), boff = lds_byte(wc * 32 + fr, fq * 8);
#define PG8_SA(b, h) (((b) * 2 + (h)) * HTB)
#define PG8_SB(b, h) ((4 + (b) * 2 + (h)) * HTB)
#define PG8_STAGE(bufoff, gbase, voff) do { _Pragma("unroll") for (int _i = 0; _i < 2; ++_i) \
        __builtin_amdgcn_global_load_lds((const unsigned*)((const char*)(gbase) + (voff)[_i]), (PG8_LAS unsigned*)(lds + (bufoff) + ldsw + _i * 8192), 16, 0, 0); } while (0)
#define PG8_LDA(dst, b, h) do { _Pragma("unroll") for (int m = 0; m < 4; ++m) _Pragma("unroll") for (int k = 0; k < 2; ++k) dst[m][k] = *(const PG8_LAS bf16x8*)(lds + PG8_SA(b, h) + aoff + m * 2048 + k * 1024); } while (0)
#define PG8_LDB(dst, b, h) do { _Pragma("unroll") for (int n = 0; n < 2; ++n) _Pragma("unroll") for (int k = 0; k < 2; ++k) dst[n][k] = *(const PG8_LAS bf16x8*)(lds + PG8_SB(b, h) + boff + n * 2048 + k * 1024); } while (0)
#define PG8_MMA(ai, bj, At, Bt) do { __builtin_amdgcn_s_setprio(1); _Pragma("unroll") for (int m = 0; m < 4; ++m) _Pragma("unroll") for (int n = 0; n < 2; ++n) _Pragma("unroll") for (int k = 0; k < 2; ++k) \
        acc[ai][bj][m][n] = __builtin_amdgcn_mfma_f32_16x16x32_bf16(Bt[n][k], At[m][k], acc[ai][bj][m][n], 0, 0, 0); __builtin_amdgcn_s_setprio(0); } while (0)
#define PG8_WAIT_V(n) asm volatile("s_waitcnt vmcnt(" #n ")" ::: "memory")
#define PG8_WAIT_L(n) asm volatile("s_waitcnt lgkmcnt(" #n ")" ::: "memory")
#define PG8_BAR __builtin_amdgcn_s_barrier()
#define PG8_SCHED __builtin_amdgcn_sched_barrier(0)
    Unit cur, nxt; int ui = 0;
    if (!S.next(0, cur)) return;
    f32x4 acc[2][2][4][2];
#pragma unroll
    for (int a = 0; a < 2; ++a)
#pragma unroll
        for (int b = 0; b < 2; ++b)
#pragma unroll
            for (int m = 0; m < 4; ++m)
#pragma unroll
                for (int n = 0; n < 2; ++n) acc[a][b][m][n] = (f32x4){0.f, 0.f, 0.f, 0.f};
    bf16x8 At[4][2], B0[2][2], B1[2][2];
    const char* cA = (const char*)g.A + (size_t)cur.pm * tstepA + (size_t)cur.ka * 2; const char* cB = (const char*)g.Bt + (size_t)cur.pn * tstepB + (size_t)cur.kb * 2; int nt = cur.nt;
    S.a_ready(cur);
    if constexpr (SP2) {
        PG8_STAGE(PG8_SB(0, 0), cB, voffB); PG8_STAGE(PG8_SB(0, 1), cB + hstepB, voffB); PG8_STAGE(PG8_SA(0, 0), cA, voffA); PG8_STAGE(PG8_SA(0, 1), cA + hstepA, voffA);
        if (wr == 1) PG8_BAR;
        PG8_WAIT_V(2); PG8_BAR;
        PG8_STAGE(PG8_SB(1, 0), cB + kstep, voffB); PG8_STAGE(PG8_SA(1, 0), cA + kstep, voffA); PG8_STAGE(PG8_SB(1, 1), cB + hstepB + kstep, voffB);
        PG8_WAIT_V(6); PG8_BAR;
    } else {
        PG8_STAGE(PG8_SB(0, 0), cB, voffB); PG8_STAGE(PG8_SA(0, 0), cA, voffA); PG8_STAGE(PG8_SB(0, 1), cB + hstepB, voffB); PG8_STAGE(PG8_SA(0, 1), cA + hstepA, voffA);
        if (wr == 1) PG8_BAR;
        PG8_WAIT_V(4); PG8_BAR;
        PG8_STAGE(PG8_SB(1, 0), cB + kstep, voffB); PG8_STAGE(PG8_SA(1, 0), cA + kstep, voffA); PG8_STAGE(PG8_SB(1, 1), cB + hstepB + kstep, voffB);
        PG8_WAIT_V(6); PG8_BAR;
    }
    for (;;) {
        const bool has_next = S.next(ui + 1, nxt);
        const char* nA = has_next ? (const char*)g.A + (size_t)nxt.pm * tstepA + (size_t)nxt.ka * 2 : cA; const char* nB = has_next ? (const char*)g.Bt + (size_t)nxt.pn * tstepB + (size_t)nxt.kb * 2 : cB;
        for (int t = 0; t < nt; t += 2) {
            const bool last = (t == nt - 2);
            const char* a1 = cA + (size_t)(t + 1) * kstep;
            const char* a2 = last ? nA : cA + (size_t)(t + 2) * kstep; const char* b2 = last ? nB : cB + (size_t)(t + 2) * kstep;
            const char* a3 = a2 + kstep; const char* b3 = b2 + kstep;
            if (last && has_next) S.a_ready(nxt);
            if constexpr (SP2) {
            PG8_LDB(B0, 0, 0); PG8_LDB(B1, 0, 1); PG8_SCHED; PG8_LDA(At, 0, 0); PG8_STAGE(PG8_SA(1, 1), a1 + hstepA, voffA);
            PG8_WAIT_V(8); PG8_WAIT_L(0); PG8_BAR; PG8_MMA(0, 0, At, B0); PG8_MMA(0, 1, At, B1); PG8_BAR; PG8_SCHED;
            PG8_LDA(At, 0, 1); PG8_STAGE(PG8_SB(0, 0), b2, voffB); PG8_STAGE(PG8_SB(0, 1), b2 + hstepB, voffB); PG8_STAGE(PG8_SA(0, 0), a2, voffA);
            PG8_WAIT_V(8); PG8_WAIT_L(0); PG8_BAR; PG8_MMA(1, 0, At, B0); PG8_MMA(1, 1, At, B1); PG8_BAR; PG8_SCHED;
            PG8_LDB(B0, 1, 0); PG8_LDB(B1, 1, 1); PG8_SCHED; PG8_LDA(At, 1, 0); PG8_STAGE(PG8_SA(0, 1), a2 + hstepA, voffA);
            PG8_WAIT_V(8); PG8_WAIT_L(0); PG8_BAR; PG8_MMA(0, 0, At, B0); PG8_MMA(0, 1, At, B1); PG8_BAR; PG8_SCHED;
            PG8_LDA(At, 1, 1); PG8_STAGE(PG8_SB(1, 0), b3, voffB); PG8_STAGE(PG8_SB(1, 1), b3 + hstepB, voffB); PG8_STAGE(PG8_SA(1, 0), a3, voffA);
            PG8_WAIT_V(8); PG8_WAIT_L(0); PG8_BAR; PG8_MMA(1, 0, At, B0); PG8_MMA(1, 1, At, B1); PG8_BAR; PG8_SCHED;
            } else {
            PG8_LDB(B0, 0, 0); PG8_SCHED; PG8_LDA(At, 0, 0); PG8_STAGE(PG8_SA(1, 1), a1 + hstepA, voffA);
            PG8_WAIT_L(8); PG8_BAR; PG8_WAIT_L(0); PG8_MMA(0, 0, At, B0); PG8_BAR; PG8_SCHED;
            PG8_LDB(B1, 0, 1); PG8_STAGE(PG8_SB(0, 0), b2, voffB);
            PG8_BAR; PG8_WAIT_L(0); PG8_MMA(0, 1, At, B1); PG8_BAR;
            PG8_LDA(At, 0, 1); PG8_STAGE(PG8_SA(0, 0), a2, voffA);
            PG8_BAR; PG8_WAIT_L(0); PG8_MMA(1, 0, At, B0); PG8_BAR; PG8_SCHED;
            PG8_STAGE(PG8_SB(0, 1), b2 + hstepB, voffB);
            PG8_WAIT_V(6); PG8_BAR; PG8_MMA(1, 1, At, B1); PG8_BAR;
            PG8_LDB(B0, 1, 0); PG8_SCHED; PG8_LDA(At, 1, 0); PG8_STAGE(PG8_SA(0, 1), a2 + hstepA, voffA);
            PG8_WAIT_L(8); PG8_BAR; PG8_WAIT_L(0); PG8_MMA(0, 0, At, B0); PG8_BAR; PG8_SCHED;
            PG8_LDB(B1, 1, 1); PG8_STAGE(PG8_SB(1, 0), b3, voffB);
            PG8_BAR; PG8_WAIT_L(0); PG8_MMA(0, 1, At, B1); PG8_BAR;
            PG8_LDA(At, 1, 1); PG8_STAGE(PG8_SA(1, 0), a3, voffA);
            PG8_BAR; PG8_WAIT_L(0); PG8_MMA(1, 0, At, B0); PG8_BAR; PG8_SCHED;
            PG8_STAGE(PG8_SB(1, 1), b3 + hstepB, voffB);
            PG8_WAIT_V(6); PG8_BAR; PG8_MMA(1, 1, At, B1); PG8_BAR;
            }
        }
        if constexpr (ALIGN_EPI) { if (wr == 0) PG8_BAR; }
        if constexpr (!Epi::AFTER_DRAIN) { E(acc, cur, wr, wc, fr, fq); if (EPI_REP > 1) { asm volatile("" ::: "memory"); E(acc, cur, wr, wc, fr, fq); } S.done(cur); }
        if (!has_next) break;
#pragma unroll
        for (int a = 0; a < 2; ++a)
#pragma unroll
            for (int b = 0; b < 2; ++b)
#pragma unroll
                for (int m = 0; m < 4; ++m)
#pragma unroll
                    for (int n = 0; n < 2; ++n) acc[a][b][m][n] = (f32x4){0.f, 0.f, 0.f, 0.f};
        cur = nxt; cA = nA; cB = nB; nt = cur.nt; ++ui;
        if constexpr (ALIGN_EPI) { if (wr == 1) PG8_BAR; }
    }
    PG8_WAIT_V(0);
    if constexpr (!ALIGN_EPI) { if (wr == 0) PG8_BAR; }
    PG8_BAR;
    if constexpr (Epi::AFTER_DRAIN) { E.fused(acc, cur, wr, wc, fr, fq, lds, wid, lane); S.done(cur); }
#undef PG8_SA
#undef PG8_SB
#undef PG8_STAGE
#undef PG8_LDA
#undef PG8_LDB
#undef PG8_MMA
#undef PG8_WAIT_V
#undef PG8_WAIT_L
#undef PG8_BAR
#undef PG8_SCHED
}
}

constexpr size_t MiB = 1u << 20;
constexpr size_t WS_CTL = 0, CTL_ZERO_BYTES = 512 * 1024;
constexpr size_t SZ_WGU = (size_t)2 * FF * D * 2, SZ_WDN = (size_t)D * FF * 2;
constexpr size_t SZ_WEVIN = (size_t)NEV * D * 2, SZ_WSQ = (size_t)D * D * 2, SZ_WODIN = (size_t)2 * D * D * 2;
constexpr size_t SZ_WLORA = (size_t)NLORA * KLORA * 2, SZ_WLRU = (size_t)4096 * 256 * 2;
constexpr size_t WS_WGU = 1 * MiB;
constexpr size_t WS_WDN = WS_WGU + 8 * SZ_WGU;
constexpr size_t WS_WEVIN = WS_WDN + 8 * SZ_WDN;
constexpr size_t WS_WEVOUT = WS_WEVIN + 2 * SZ_WEVIN;
constexpr size_t WS_WODIN = WS_WEVOUT + 2 * SZ_WSQ;
constexpr size_t WS_WODOUT = WS_WODIN + 2 * SZ_WODIN;
constexpr size_t WS_WLORA = WS_WODOUT + 2 * SZ_WSQ;
constexpr size_t WS_WLRU = WS_WLORA + 2 * SZ_WLORA;
constexpr size_t WS_X = WS_WLRU + 2 * SZ_WLRU;
constexpr size_t WS_XN = WS_X + (size_t)M * D * 4;
constexpr size_t WS_H = WS_XN + (size_t)M * D * 2;
constexpr size_t WS_YIN = WS_H + (size_t)M * FF * 2;
constexpr size_t WS_MIX = WS_YIN + (size_t)M * D * 2;
constexpr size_t WS_PROJ = WS_MIX;
constexpr size_t WS_WAG = WS_PROJ + (size_t)M * NEV * 4;
constexpr size_t WS_LA = WS_WAG + (size_t)M * NLORA * 4;
constexpr size_t WS_HU = WS_LA + (size_t)M * KLORA * 2;
constexpr size_t WS_HD = WS_HU + (size_t)1024 * 16384 * 4;
constexpr size_t WS_PST = WS_HD + (size_t)1024 * 128 * 4;
constexpr size_t WS_QST = WS_PST + (size_t)8192 * 4096 * 2;
constexpr size_t WS_OB2 = WS_QST + (size_t)8192 * 4096 * 4;
constexpr size_t WS_SSP = WS_OB2 + (size_t)MP * 1024 * 4;
constexpr size_t WS_RSTD = WS_SSP + (size_t)M * 32 * 4;
constexpr size_t WS_EVEN_END = WS_RSTD + (size_t)M * 4;
constexpr size_t WS_OI = WS_H, WS_QT = WS_H + (size_t)MP * 1024 * 4;
constexpr size_t WS_RQ = WS_QT + (size_t)MP * 1024 * 4;
constexpr size_t WS_OB = WS_XN;
static_assert(WS_RQ + (size_t)8192 * 1024 * 2 <= WS_YIN, "OI/QT/RQ overlay fits in H");
constexpr size_t WS_SLAB = WS_MIX;
constexpr size_t WS_OSLAB = WS_PST;
constexpr size_t WS_XB = WS_MIX;
constexpr size_t WS_GATE = WS_XB + (size_t)M * 2048 * 4;
constexpr size_t WS_XC = WS_GATE + (size_t)M * 2048 * 2;
constexpr size_t WS_XCB = WS_XC + (size_t)M * 2048 * 4;
constexpr size_t WS_LRA = WS_XCB + (size_t)M * 2048 * 2;
constexpr size_t WS_LRB = WS_LRA + (size_t)M * 2048 * 4;
constexpr size_t WS_CP = WS_LRB + (size_t)M * 2048 * 4;
constexpr size_t WS_CH = WS_CP + (size_t)4 * 32 * 2048 * 4;
constexpr size_t WS_ODD_END = WS_CH + (size_t)4 * 32 * 2048 * 4;
constexpr size_t WS_END = WS_EVEN_END > WS_ODD_END ? WS_EVEN_END : WS_ODD_END;
constexpr int CW_BAR = 4096;
constexpr int PAR_FFN1N = 0, PAR_MIXN = 8192, PAR_FFN2N = 16384, PAR_FINN = 24576, PAR_MU = 26624, PAR_W0 = 33664, PAR_A0 = 35712, PAR_KK = 37760, PAR_KA = 39808,
              PAR_RK = 41856, PAR_LNW = 43904, PAR_LNB = 45952, PAR_HGLB = 48000, PAR_HGN = 50048, PAR_CONVW = 52096, PAR_CONVB = 68480, PAR_BA = 72576, PAR_BX = 76672,
              PAR_LAM = 80768, PAR_END = 84864;
constexpr size_t WS_PAR = 512 * 1024;

constexpr size_t O_Y = 0, O_PSHIFT = (size_t)M * D, O_PRWKV = O_PSHIFT + (size_t)BP * 2 * PRW, O_PHGRN = O_PRWKV + (size_t)BP * 2 * 16 * 4096,
                 O_PCONV = O_PHGRN + (size_t)BP * 2 * 8 * 16384, O_PLRU = O_PCONV + (size_t)BP * 2 * 3 * 2048, O_SSHIFT = O_PLRU + (size_t)BP * 2 * 2048,
                 O_SRWKV = O_SSHIFT + (size_t)BS * 2 * PRW, O_SHGRN = O_SRWKV + (size_t)BS * 2 * 16 * 4096, O_SCONV = O_SHGRN + (size_t)BS * 2 * 8 * 16384,
                 O_SLRU = O_SCONV + (size_t)BS * 2 * 3 * 2048, O_END = O_SLRU + (size_t)BS * 2 * 2048;

constexpr int LDS_BYTES = 155648;
constexpr int MISC_OFF = 153600;

#define GAS __attribute__((address_space(1)))
#define LAS __attribute__((address_space(3)))
typedef unsigned short bf16;
typedef unsigned v4u __attribute__((ext_vector_type(4)));
typedef unsigned v2u __attribute__((ext_vector_type(2)));
typedef float f32x4 __attribute__((ext_vector_type(4)));
typedef float f32x2 __attribute__((ext_vector_type(2)));
using pg8::sigm; using pg8::silu_; using pg8::softplus_; using pg8::cvt_pk_bf16;
#define LDS_WAIT() asm volatile("s_waitcnt lgkmcnt(0)" ::: "memory")
#define VM_WAIT() asm volatile("s_waitcnt vmcnt(0)" ::: "memory")
__device__ __forceinline__ unsigned f2bf(float f) { unsigned u = __builtin_bit_cast(unsigned, f); return (u + 0x7fffu + ((u >> 16) & 1u)) >> 16; }
__device__ __forceinline__ unsigned pk2(float lo, float hi) { return f2bf(lo) | (f2bf(hi) << 16); }
__device__ __forceinline__ float bf2f(unsigned h) { return __builtin_bit_cast(float, h << 16); }
template <int CTRL> __device__ __forceinline__ float dppf(float v) { return __builtin_bit_cast(float, __builtin_amdgcn_update_dpp(0, __builtin_bit_cast(int, v), CTRL, 0xf, 0xf, true)); }
__device__ __forceinline__ float red8(float x) { x += dppf<0xB1>(x); x += dppf<0x4E>(x); x += dppf<0x141>(x); return x; }
__device__ __forceinline__ float red16(float x) { x = red8(x); x += dppf<0x140>(x); return x; }
__device__ __forceinline__ float wave_sum(float v) {
#pragma unroll
    for (int o = 1; o < 64; o <<= 1) v += __shfl_xor(v, o);
    return v;
}
#define XB_TMO      128
#define XB_XCNT(j)  (256  + 64 * (j))
#define XB_XSUB(j)  (1280 + 64 * (j))
#define XB_XGEN(j)  (2304 + 64 * (j))
#define XB_TOP      3328
#define XB_TOPGEN   3392
#define XCD_BAR_WORDS 3456
#define XB_SPIN_CAP (1u << 18)

__device__ __forceinline__ unsigned xb_ld(unsigned* p)              { return __hip_atomic_load(p, __ATOMIC_RELAXED, __HIP_MEMORY_SCOPE_AGENT); }
__device__ __forceinline__ unsigned xb_add(unsigned* p, unsigned v) { return __hip_atomic_fetch_add(p, v, __ATOMIC_RELAXED, __HIP_MEMORY_SCOPE_AGENT); }
__device__ __forceinline__ unsigned xb_xcc_id() { return (unsigned)__builtin_amdgcn_s_getreg((3 << 11) | 20) & 0xFu; }
#define XB_SPIN(cond, bar) do { unsigned _sp = 0; while (cond) { __builtin_amdgcn_s_sleep(1); \
    if ((++_sp & 255u) == 0u) { if (xb_ld(&(bar)[XB_TMO])) break; if (_sp > XB_SPIN_CAP) { atomicAdd(&(bar)[XB_TMO], 1u); break; } } } } while (0)

struct XcdBarrier {
    unsigned* bar; unsigned x;
    volatile LAS unsigned* st;
};

__device__ __forceinline__ XcdBarrier xcd_barrier_post(unsigned* bar, volatile LAS unsigned* st) {
    XcdBarrier b; b.bar = bar; b.x = xb_xcc_id(); b.st = st;
    if (threadIdx.x == 0) (void)xb_add(&bar[XB_XCNT(b.x)], 1u);
    return b;
}
__device__ __forceinline__ void xcd_barrier_complete(unsigned* bar, unsigned x, unsigned& nloc, unsigned& nx) {
    const unsigned G = gridDim.x * gridDim.y * gridDim.z;
    unsigned sum, cnt, mine, sp = 0u;
    for (;;) {
        sum = 0u; cnt = 0u; mine = 0u;
#pragma unroll
        for (unsigned j = 0; j < 16; ++j) { const unsigned c = xb_ld(&bar[XB_XCNT(j)]); sum += c; cnt += (c > 0u) ? 1u : 0u; mine = (j == x) ? c : mine; }
        if (sum == G) break;
        __builtin_amdgcn_s_sleep(1);
        if ((++sp & 255u) == 0u) { if (xb_ld(&bar[XB_TMO])) break; if (sp > XB_SPIN_CAP) { atomicAdd(&bar[XB_TMO], 1u); break; } }
    }
    nloc = mine > 0u ? mine : 1u; nx = cnt > 0u ? cnt : 1u;
}

__device__ __forceinline__ void xcd_barrier(const XcdBarrier& b) {
    asm volatile("s_waitcnt vmcnt(0)" ::: "memory");
    __syncthreads();
    if (threadIdx.x == 0) {
        unsigned* bar = b.bar;
        __builtin_amdgcn_s_waitcnt(0);
        unsigned nloc = b.st[0], nx = b.st[1];
        if (nloc == 0u) { xcd_barrier_complete(bar, b.x, nloc, nx); b.st[0] = nloc; b.st[1] = nx; }
        const unsigned old = xb_add(&bar[XB_XSUB(b.x)], 1u);
        const unsigned gen = old / nloc;
        if (old + 1u == (gen + 1u) * nloc) {
            __builtin_amdgcn_fence(__ATOMIC_RELEASE, "agent");
            asm volatile("s_waitcnt vmcnt(0)" ::: "memory");
            const unsigned og = xb_add(&bar[XB_TOP], 1u);
            const unsigned tg = og / nx;
            if (og + 1u == (tg + 1u) * nx) xb_add(&bar[XB_TOPGEN], 1u);
            else XB_SPIN(xb_ld(&bar[XB_TOPGEN]) == tg, bar);
            __builtin_amdgcn_fence(__ATOMIC_ACQUIRE, "agent");
            xb_add(&bar[XB_XGEN(b.x)], 1u);
            asm volatile("s_waitcnt vmcnt(0)" ::: "memory");
        } else {
            XB_SPIN(xb_ld(&bar[XB_XGEN(b.x)]) == gen, bar);
            __builtin_amdgcn_fence(__ATOMIC_ACQUIRE, "agent");
            asm volatile("s_waitcnt vmcnt(0)" ::: "memory");
        }
    }
    __syncthreads();
}


#define GAS __attribute__((address_space(1)))
struct Args { const float* in[39]; GAS float* out; GAS unsigned char* ws; int ph_lo, ph_hi, li, pad; };
#define AOUT ((float*)A.out)
struct Frame { LAS unsigned char* lds; int tid, lane, wave, G, blk; };
#define PARP(off) ((const float*)(A.ws + WS_PAR) + (off))
__device__ __forceinline__ f32x4 ld4(const float* p) { return *(const f32x4*)p; }
__device__ __forceinline__ f32x4 ldp4(const bf16* p) { const v2u w = *(const v2u*)p; return (f32x4){bf2f(w.x & 0xffffu), bf2f(w.x >> 16), bf2f(w.y & 0xffffu), bf2f(w.y >> 16)}; }
__device__ __forceinline__ f32x4 cvq(const v2u w) { return (f32x4){bf2f(w.x & 0xffffu), bf2f(w.x >> 16), bf2f(w.y & 0xffffu), bf2f(w.y >> 16)}; }
__device__ __forceinline__ void st4bf(bf16* p, f32x4 v) { v2u w; w.x = cvt_pk_bf16(v[0], v[1]); w.y = cvt_pk_bf16(v[2], v[3]); *(v2u*)p = w; }

__device__ __forceinline__ void tr_item(const float* src, int Nsrc, int srcc0, int k0, bf16* dst, int ldd, int n0, LAS float* scr, int lane) {
    const int r4 = lane >> 4, q = lane & 15;
    if (srcc0 >= 0) {
        f32x4 v[16];
#pragma unroll
        for (int i = 0; i < 16; ++i) v[i] = ld4(src + (size_t)(k0 + 4 * i + r4) * Nsrc + srcc0 + 4 * q);
#pragma unroll
        for (int i = 0; i < 16; ++i) { LAS float* s = scr + (4 * i + r4) * 65 + 4 * q; s[0] = v[i][0]; s[1] = v[i][1]; s[2] = v[i][2]; s[3] = v[i][3]; }
    } else {
#pragma unroll 4
        for (int i = 0; i < 16; ++i) { const int k = 4 * i + r4; LAS float* s = scr + k * 65 + 4 * q; s[0] = 0.f; s[1] = 0.f; s[2] = 0.f; s[3] = 0.f; }
    }
    LDS_WAIT(); asm volatile("" ::: "memory");
    const int c = lane & 7;
#pragma unroll
    for (int j = 0; j < 8; ++j) { const int n = (lane >> 3) + 8 * j; const LAS float* s = scr + (8 * c) * 65 + n;
        v4u o; o.x = pk2(s[0 * 65], s[1 * 65]); o.y = pk2(s[2 * 65], s[3 * 65]); o.z = pk2(s[4 * 65], s[5 * 65]); o.w = pk2(s[6 * 65], s[7 * 65]);
        *(v4u*)(dst + (size_t)(n0 + n) * ldd + k0 + 8 * c) = o; }
    LDS_WAIT(); asm volatile("" ::: "memory");
}
constexpr int IT_GU = 32 * 176, IT_DN = 88 * 32, IT_EVIN = 32 * 120, IT_SQ = 32 * 32, IT_ODIN = 32 * 64;
constexpr int IT_TOTAL = 8 * IT_GU + 8 * IT_DN + 2 * IT_EVIN + 2 * IT_SQ + 2 * IT_ODIN + 2 * IT_SQ;

__device__ __forceinline__ void norm_row(const float* xrow, const float* gain, bf16* xn, float* y, float* xcopy, int lane, int sf = 0, float scale = 0.f, const float* slab = nullptr, int m = 0, float* xrow_w = nullptr, float* rstd_out = nullptr) {
    f32x4 v[8]; float s = 0.f;
#pragma unroll
    for (int j = 0; j < 8; ++j) v[j] = ld4(xrow + 4 * lane + 256 * j);
    if (sf > 0 && m >= MP) {
        const int r = m & 255, j0 = ((m >> 8) - 32) * 8;
#pragma unroll
        for (int jj = 0; jj < 8; ++jj) { f32x4 add = {0.f, 0.f, 0.f, 0.f};
            for (int p = 0; p < sf; ++p) { const v2u w2 = *(const v2u*)((const bf16*)slab + (size_t)((j0 + jj) * sf + p) * 65536 + r * 256 + 4 * lane); add += (f32x4){bf2f(w2.x & 0xffffu), bf2f(w2.x >> 16), bf2f(w2.y & 0xffffu), bf2f(w2.y >> 16)}; }
            v[jj] += add * scale; *(f32x4*)(xrow_w + 4 * lane + 256 * jj) = v[jj]; }
    }
#pragma unroll
    for (int j = 0; j < 8; ++j) s += (v[j][0] * v[j][0] + v[j][1] * v[j][1]) + (v[j][2] * v[j][2] + v[j][3] * v[j][3]);
    const float rstd = 1.0f / sqrtf(wave_sum(s) * (1.0f / D) + 1e-6f);
#pragma unroll
    for (int j = 0; j < 8; ++j) {
        if (xcopy) *(f32x4*)(xcopy + 4 * lane + 256 * j) = v[j];
        const f32x4 gq = ld4(gain + 4 * lane + 256 * j), o = v[j] * rstd * gq;
        if (xn) st4bf(xn + 4 * lane + 256 * j, rstd_out ? v[j] * gq : o);
        if (y) *(f32x4*)(y + 4 * lane + 256 * j) = o;
    }
    if (rstd_out && lane == 0) *rstd_out = rstd;
}

#ifndef PRO_2X4
#define PRO_2X4 1
#endif
#if PRO_2X4
#define PRO_MAP(r, NB, kb, nb) do { const int g_ = (r) >> 3, w_ = (r) & 7; nb = (g_ % ((NB) / 4)) * 4 + (w_ & 3); kb = (g_ / ((NB) / 4)) * 2 + (w_ >> 2); } while (0)
#else
#define PRO_MAP(r, NB, kb, nb) do { kb = (r) / (NB); nb = (r) % (NB); } while (0)
#endif
__device__ __forceinline__ void p0_prologue(const Args& A, Frame& F) {
    LAS float* scr = (LAS float*)(F.lds + F.wave * 16640);
    const int gw = F.blk * NWAVES + F.wave, NGW = F.G * NWAVES;
    bf16* Wgu = (bf16*)(A.ws + WS_WGU); bf16* Wdn = (bf16*)(A.ws + WS_WDN); bf16* Wevin = (bf16*)(A.ws + WS_WEVIN); bf16* Wevout = (bf16*)(A.ws + WS_WEVOUT);
    bf16* Wodin = (bf16*)(A.ws + WS_WODIN); bf16* Wodout = (bf16*)(A.ws + WS_WODOUT);
    for (int it = gw; it < IT_TOTAL; it += NGW) {
        int r = it;
        if (r < 8 * IT_GU) { const int mat = r / IT_GU; r -= mat * IT_GU; int kb, nb; PRO_MAP(r, 176, kb, nb); const int n0 = nb * 64, pn = n0 >> 8, c = n0 & 255;
            const int srcc = c < 128 ? pn * 128 + c : FF + pn * 128 + (c - 128);
            tr_item(((mat & 1) ? A.in[12] : A.in[8]) + (size_t)(mat >> 1) * D * 2 * FF, 2 * FF, srcc, kb * 64, Wgu + (size_t)mat * (SZ_WGU / 2), D, n0, scr, F.lane); continue; }
        r -= 8 * IT_GU;
        if (r < 8 * IT_DN) { const int mat = r / IT_DN; r -= mat * IT_DN; int kb, nb; PRO_MAP(r, 32, kb, nb);
            tr_item(((mat & 1) ? A.in[13] : A.in[9]) + (size_t)(mat >> 1) * FF * D, D, nb * 64, kb * 64, Wdn + (size_t)mat * (SZ_WDN / 2), FF, nb * 64, scr, F.lane); continue; }
        r -= 8 * IT_DN;
        if (r < 2 * IT_EVIN) { const int mat = r / IT_EVIN; r -= mat * IT_EVIN; int kb, nb; PRO_MAP(r, 120, kb, nb);
            tr_item(A.in[14] + (size_t)mat * D * PEV, PEV, nb * 64 < PEV ? nb * 64 : -1, kb * 64, Wevin + (size_t)mat * (SZ_WEVIN / 2), D, nb * 64, scr, F.lane); continue; }
        r -= 2 * IT_EVIN;
        if (r < 2 * IT_SQ) { const int mat = r / IT_SQ; r -= mat * IT_SQ; int kb, nb; PRO_MAP(r, 32, kb, nb);
            tr_item(A.in[28] + (size_t)mat * D * D, D, nb * 64, kb * 64, Wevout + (size_t)mat * (SZ_WSQ / 2), D, nb * 64, scr, F.lane); continue; }
        r -= 2 * IT_SQ;
        if (r < 2 * IT_ODIN) { const int mat = r / IT_ODIN; r -= mat * IT_ODIN; int kb, nb; PRO_MAP(r, 64, kb, nb);
            tr_item(A.in[29] + (size_t)mat * D * 2 * D, 2 * D, nb * 64, kb * 64, Wodin + (size_t)mat * (SZ_WODIN / 2), D, nb * 64, scr, F.lane); continue; }
        r -= 2 * IT_ODIN;
        { const int mat = r / IT_SQ; r -= mat * IT_SQ; int kb, nb; PRO_MAP(r, 32, kb, nb);
            tr_item(A.in[37] + (size_t)mat * D * D, D, nb * 64, kb * 64, Wodout + (size_t)mat * (SZ_WSQ / 2), D, nb * 64, scr, F.lane); }
    }
    const int gt = F.blk * NTHR + F.tid, NGT = F.G * NTHR;
    for (int idx = gt; idx < 2 * NLORA * (KLORA / 8); idx += NGT) {
        const int e = idx / (NLORA * (KLORA / 8)); int r = idx - e * (NLORA * (KLORA / 8)); const int n = r % NLORA, k8 = r / NLORA;
        const int ty = n >> 10, nn = n & 1023; float v[8];
#pragma unroll
        for (int i = 0; i < 8; ++i) { const int k = 8 * k8 + i; float x = 0.f;
            if (ty == 0) { if (k < 96) x = A.in[17][((size_t)e * 96 + k) * 1024 + nn]; }
            else if (ty == 1) { if (k >= 96 && k < 192) x = A.in[19][((size_t)e * 96 + (k - 96)) * 1024 + nn]; }
            else { if (k >= 192 && k < 448) x = A.in[20][((size_t)e * 256 + (k - 192)) * 1024 + nn]; }
            v[i] = x; }
        v4u o; o.x = pk2(v[0], v[1]); o.y = pk2(v[2], v[3]); o.z = pk2(v[4], v[5]); o.w = pk2(v[6], v[7]);
        *(v4u*)((bf16*)(A.ws + WS_WLORA) + (size_t)e * NLORA * KLORA + (size_t)n * KLORA + 8 * k8) = o;
    }
    for (int idx = gt; idx < 2 * 4096 * 32; idx += NGT) {
        const int o_ = idx / (4096 * 32); int r = idx - o_ * (4096 * 32); const int rr = r % 4096, k8 = r / 4096;
        const int j = rr >> 8, c = rr & 255, n = j >> 1, cc = (j & 1) * 128 + (c & 127);
        const float* src = (c < 128 ? A.in[32] : A.in[34]) + ((size_t)(o_ * 8 + n) * 256) * 256 + cc; float v[8];
#pragma unroll
        for (int i = 0; i < 8; ++i) v[i] = src[(size_t)(8 * k8 + i) * 256];
        v4u o; o.x = pk2(v[0], v[1]); o.y = pk2(v[2], v[3]); o.z = pk2(v[4], v[5]); o.w = pk2(v[6], v[7]);
        *(v4u*)((bf16*)(A.ws + WS_WLRU) + (size_t)o_ * 4096 * 256 + (size_t)rr * 256 + 8 * k8) = o;
    }
    {
        float* P = (float*)(A.ws + WS_PAR);
#define CPPAR(off, src, n) for (int i_ = gt; i_ < (n); i_ += NGT) P[(off) + i_] = (src)[i_];
        CPPAR(PAR_FFN1N, A.in[7], 8192) CPPAR(PAR_MIXN, A.in[10], 8192) CPPAR(PAR_FFN2N, A.in[11], 8192) CPPAR(PAR_FINN, A.in[38], 2048)
        CPPAR(PAR_MU, A.in[15], 7040) CPPAR(PAR_W0, A.in[16], 2048) CPPAR(PAR_A0, A.in[18], 2048) CPPAR(PAR_KK, A.in[21], 2048) CPPAR(PAR_KA, A.in[22], 2048)
        CPPAR(PAR_RK, A.in[23], 2048) CPPAR(PAR_LNW, A.in[24], 2048) CPPAR(PAR_LNB, A.in[25], 2048) CPPAR(PAR_HGLB, A.in[26], 2048) CPPAR(PAR_HGN, A.in[27], 2048)
        CPPAR(PAR_CONVW, A.in[30], 16384) CPPAR(PAR_CONVB, A.in[31], 4096) CPPAR(PAR_BA, A.in[33], 4096) CPPAR(PAR_BX, A.in[35], 4096) CPPAR(PAR_LAM, A.in[36], 4096)
#undef CPPAR
    }
    float* X = (float*)(A.ws + WS_X); bf16* XN = (bf16*)(A.ws + WS_XN);
    for (int m = gw; m < M; m += NGW) {
        const float* src = m < MP ? A.in[0] + (size_t)m * D : A.in[1] + (size_t)(m - MP) * D;
        norm_row(src, A.in[7], XN + (size_t)m * D, nullptr, X + (size_t)m * D, F.lane, 0, 0.f, nullptr, 0, nullptr, (float*)(A.ws + WS_RSTD) + m);
    }
}

__device__ __forceinline__ void norm_phase(const Args& A, Frame& F, const float* gain, bool final_, int sf, float scale) {
    const int gw = F.blk * NWAVES + F.wave, NGW = F.G * NWAVES;
    float* X = (float*)(A.ws + WS_X); bf16* XN = (bf16*)(A.ws + WS_XN);
    for (int m = gw; m < M; m += NGW)
        norm_row(X + (size_t)m * D, gain, final_ ? nullptr : XN + (size_t)m * D, final_ ? AOUT + O_Y + (size_t)m * D : nullptr, nullptr, F.lane, sf, scale, (const float*)(A.ws + WS_SLAB), m, X + (size_t)m * D);
}

__device__ __forceinline__ void rstd_phase(const Args& A, Frame& F, const float* gain, int sf, float scale) {
    float* X = (float*)(A.ws + WS_X); bf16* XN = (bf16*)(A.ws + WS_XN); float* RSTD = (float*)(A.ws + WS_RSTD); const float* SSP = (const float*)(A.ws + WS_SSP);
    if (sf > 0) {
        LAS float* red = (LAS float*)F.lds; const bf16* slab = (const bf16*)(A.ws + WS_SLAB); const int jj = F.wave, lane = F.lane;
        for (int m0 = MP + F.blk; m0 < M; m0 += 2 * F.G) {
            f32x4 v[2], add[2]; const f32x4 gq = ld4(gain + 256 * jj + 4 * lane);
#pragma unroll
            for (int q = 0; q < 2; ++q) { const int m = m0 + q * F.G; add[q] = (f32x4){0.f, 0.f, 0.f, 0.f}; v[q] = add[q];
                if (m < M) { v[q] = ld4(X + (size_t)m * D + 256 * jj + 4 * lane);
                    const bf16* sp = slab + (size_t)(((m >> 8) - 32) * 8 + jj) * sf * 65536 + (m & 255) * 256 + 4 * lane;
                    if (sf == 16) {
#pragma unroll
                        for (int p = 0; p < 16; ++p) add[q] += ldp4(sp + (size_t)p * 65536);
                    } else { for (int p = 0; p < sf; ++p) add[q] += ldp4(sp + (size_t)p * 65536); } } }
#pragma unroll
            for (int q = 0; q < 2; ++q) { const int m = m0 + q * F.G;
                if (m < M) { v[q] += add[q] * scale; *(f32x4*)(X + (size_t)m * D + 256 * jj + 4 * lane) = v[q]; st4bf(XN + (size_t)m * D + 256 * jj + 4 * lane, v[q] * gq); }
                const float s = wave_sum((v[q][0] * v[q][0] + v[q][1] * v[q][1]) + (v[q][2] * v[q][2] + v[q][3] * v[q][3]));
                if (lane == 0) red[q * 8 + jj] = s; }
            __syncthreads();
            if (F.tid < 2) { const int m = m0 + F.tid * F.G; const LAS float* rr = red + F.tid * 8;
                if (m < M) RSTD[m] = 1.0f / sqrtf(((rr[0] + rr[1]) + (rr[2] + rr[3]) + (rr[4] + rr[5]) + (rr[6] + rr[7])) * (1.0f / D) + 1e-6f); }
            __syncthreads();
        }
    }
    const int r1 = sf > 0 ? MP : M;
    for (int m = F.blk * NTHR + F.tid; m < r1; m += F.G * NTHR) { float s = 0.f;
#pragma unroll
        for (int q = 0; q < 8; ++q) { const f32x4 t = ld4(SSP + (size_t)m * 32 + 4 * q); s += (t[0] + t[1]) + (t[2] + t[3]); }
        RSTD[m] = 1.0f / sqrtf(s * (1.0f / D) + 1e-6f); }
}

__device__ __forceinline__ void e2_prep(const Args& A, Frame& F, int e) {
    const bf16* PROJ = (const bf16*)(A.ws + WS_PROJ); bf16* LA = (bf16*)(A.ws + WS_LA);
    const int gt = F.blk * NTHR + F.tid, NGT = F.G * NTHR;
    for (int idx = gt; idx < (M / 8) * 128; idx += NGT) {
        const int c4 = (idx & 127) * 4, m0 = (idx >> 7) * 8;
        if (c4 >= 448) {
#pragma unroll
            for (int r = 0; r < 8; ++r) st4bf(LA + (size_t)(m0 + r) * KLORA + c4, (f32x4){0.f, 0.f, 0.f, 0.f});
            continue; }
        const int col = 3072 + c4; f32x4 x[9];
#pragma unroll
        for (int r = 0; r < 8; ++r) x[r + 1] = ldp4(PROJ + (size_t)(m0 + r) * NEV + col);
        const bool prompt = m0 < MP;
        if (prompt) x[0] = (m0 & (TP - 1)) ? ldp4(PROJ + (size_t)(m0 - 1) * NEV + col) : (f32x4){0.f, 0.f, 0.f, 0.f};
        else x[0] = ld4(A.in[2] + (size_t)(((m0 - MP) >> 2) * 2 + e) * PRW + col);
        f32x4 xs4 = {0.f, 0.f, 0.f, 0.f}; if (!prompt) xs4 = ld4(A.in[2] + (size_t)((((m0 - MP) >> 2) + 1) * 2 + e) * PRW + col);
        const f32x4 mu = ld4(PARP(PAR_MU) + (size_t)e * PRW + col);
#pragma unroll
        for (int r = 0; r < 8; ++r) {
            const f32x4 pv = (!prompt && r == 4) ? xs4 : x[r], p = x[r + 1], z = p + (pv - p) * mu; f32x4 o;
#pragma unroll
            for (int i = 0; i < 4; ++i) o[i] = c4 < 96 ? 2.0f * sigm(2.0f * z[i]) - 1.0f : (c4 < 192 ? z[i] : sigm(z[i]));
            st4bf(LA + (size_t)(m0 + r) * KLORA + c4, o);
        }
    }
    for (int idx = gt; idx < NSEQ * (PRW / 4); idx += NGT) {
        const int q = idx / (PRW / 4), c4 = (idx % (PRW / 4)) * 4;
        const int m = q < BP ? q * TP + TP - 1 : MP + (q - BP) * TS + TS - 1;
        float* o = AOUT + (q < BP ? O_PSHIFT + (size_t)(q * 2 + e) * PRW : O_SSHIFT + (size_t)((q - BP) * 2 + e) * PRW) + c4;
        *(f32x4*)o = ldp4(PROJ + (size_t)m * NEV + c4);
    }
}

struct RwRaw { f32x4 pr, pk, pv, qr, qk, qv, wd, wa; };
__device__ __forceinline__ void rwkv_unit(const Args& A, Frame& F, int e, int q, int h) {
    const int tid = F.tid, hi = tid >> 4, lo = tid & 15;
    const bool prompt = q < BP; const int T = prompt ? TP : TS, row0 = prompt ? q * TP : MP + (q - BP) * TS, bs = q - BP;
    const bf16* PROJ = (const bf16*)(A.ws + WS_PROJ); const float* WAG = (const float*)(A.ws + WS_WAG); bf16* YIN = (bf16*)(A.ws + WS_YIN);
    LAS float* cb = (LAS float*)F.lds; LAS float* ob = cb + 2 * 32 * 384;
    const int hc = h * 64 + 4 * lo;
    const float* mu = PARP(PAR_MU) + (size_t)e * PRW;
    const f32x4 mu_r = ld4(mu + hc), mu_k = ld4(mu + 1024 + hc), mu_v = ld4(mu + 2048 + hc);
    const f32x4 k_k = ld4(PARP(PAR_KK) + e * 1024 + hc), k_a = ld4(PARP(PAR_KA) + e * 1024 + hc);
    const int hs = (tid >> 3) & 31, ls = tid & 7; const bool stepper = tid < 256;
    f32x4 S[2][2];
#pragma unroll
    for (int i = 0; i < 2; ++i)
#pragma unroll
        for (int c = 0; c < 2; ++c) {
            S[i][c] = (f32x4){0.f, 0.f, 0.f, 0.f};
            if (!prompt && stepper) S[i][c] = ld4(A.in[3] + ((size_t)(bs * 2 + e) * 16 + h) * 4096 + (2 * hs + i) * 64 + 8 * ls + 4 * c);
        }
    const int nch = (T + 31) / 32;
    RwRaw raw = {};
#define RW_LOAD_RAW(ci_) do { const int t_ = (ci_) * 32 + hi; \
        if (t_ < T) { const size_t m_ = (size_t)(row0 + t_); \
            raw.pr = ldp4(PROJ + m_ * NEV + hc); raw.pk = ldp4(PROJ + m_ * NEV + 1024 + hc); raw.pv = ldp4(PROJ + m_ * NEV + 2048 + hc); \
            raw.wd = ld4(WAG + m_ * NLORA + hc); raw.wa = ld4(WAG + m_ * NLORA + 1024 + hc); \
            if (t_ > 0) { raw.qr = ldp4(PROJ + (m_ - 1) * NEV + hc); raw.qk = ldp4(PROJ + (m_ - 1) * NEV + 1024 + hc); raw.qv = ldp4(PROJ + (m_ - 1) * NEV + 2048 + hc); } \
            else if (!prompt) { const float* sh_ = A.in[2] + (size_t)(bs * 2 + e) * PRW; raw.qr = ld4(sh_ + hc); raw.qk = ld4(sh_ + 1024 + hc); raw.qv = ld4(sh_ + 2048 + hc); } \
            else { raw.qr = (f32x4){0.f, 0.f, 0.f, 0.f}; raw.qk = raw.qr; raw.qv = raw.qr; } } } while (0)
    RW_LOAD_RAW(0);
    for (int ci = 0; ci < nch; ++ci) {
        const int t0 = ci * 32, t = t0 + hi; const bool valid = t < T;
        LAS float* cbb = cb + (ci & 1) * (32 * 384); LAS float* obb = ob + (ci & 1) * (32 * 64);
        if (valid) {
            const f32x4 zr = raw.pr + (raw.qr - raw.pr) * mu_r, zk = raw.pk + (raw.qk - raw.pk) * mu_k, zv = raw.pv + (raw.qv - raw.pv) * mu_v;
            f32x4 kk = zk * k_k;
            const float ss = red16((kk[0] * kk[0] + kk[1] * kk[1]) + (kk[2] * kk[2] + kk[3] * kk[3]));
            kk = kk * (1.0f / fmaxf(sqrtf(ss), 1e-12f));
            const f32x4 kp = zk * (1.0f + (raw.wa - 1.0f) * k_a), bb = kk * raw.wa;
            LAS float* p = cbb + hi * 384 + 4 * lo;
            *(LAS f32x4*)(p) = zr; *(LAS f32x4*)(p + 64) = raw.wd; *(LAS f32x4*)(p + 128) = kp; *(LAS f32x4*)(p + 192) = kk; *(LAS f32x4*)(p + 256) = bb; *(LAS f32x4*)(p + 320) = zv;
        }
        __syncthreads();
        if (ci + 1 < nch) RW_LOAD_RAW(ci + 1);
        const int ns = (T - t0) < 32 ? (T - t0) : 32;
        if (stepper) {
            f32x4 r4[2], w4[2], kp4[2], kk4[2], bb4[2]; f32x2 v2;
#define RW_LD(s_) do { const LAS float* p_ = cbb + (s_) * 384 + 8 * ls; \
            r4[0] = *(const LAS f32x4*)(p_); r4[1] = *(const LAS f32x4*)(p_ + 4); w4[0] = *(const LAS f32x4*)(p_ + 64); w4[1] = *(const LAS f32x4*)(p_ + 68); \
            kp4[0] = *(const LAS f32x4*)(p_ + 128); kp4[1] = *(const LAS f32x4*)(p_ + 132); kk4[0] = *(const LAS f32x4*)(p_ + 192); kk4[1] = *(const LAS f32x4*)(p_ + 196); \
            bb4[0] = *(const LAS f32x4*)(p_ + 256); bb4[1] = *(const LAS f32x4*)(p_ + 260); v2 = *(const LAS f32x2*)(cbb + (s_) * 384 + 320 + 2 * hs); } while (0)
            RW_LD(0);
            for (int s = 0; s < ns; ++s) {
                const f32x4 cr0 = r4[0], cr1 = r4[1], cw0 = w4[0], cw1 = w4[1], ck0 = kp4[0], ck1 = kp4[1], cq0 = kk4[0], cq1 = kk4[1], cb0 = bb4[0], cb1 = bb4[1]; const f32x2 cv = v2;
                if (s + 1 < ns) RW_LD(s + 1);
                float sa[2], o[2];
#pragma unroll
                for (int i = 0; i < 2; ++i) { const f32x4 t = S[i][0] * cq0 + S[i][1] * cq1; sa[i] = -red8((t[0] + t[1]) + (t[2] + t[3])); }
#pragma unroll
                for (int i = 0; i < 2; ++i) { S[i][0] = S[i][0] * cw0 + cb0 * sa[i] + ck0 * cv[i]; S[i][1] = S[i][1] * cw1 + cb1 * sa[i] + ck1 * cv[i]; }
#pragma unroll
                for (int i = 0; i < 2; ++i) { const f32x4 t = S[i][0] * cr0 + S[i][1] * cr1; o[i] = red8((t[0] + t[1]) + (t[2] + t[3])); }
                if (ls == 0) *(LAS f32x2*)(obb + s * 64 + 2 * hs) = (f32x2){o[0], o[1]};
            }
#undef RW_LD
        }
        __syncthreads();
        if (valid) {
            const size_t m = (size_t)(row0 + t);
            const f32x4 o4 = *(const LAS f32x4*)(obb + hi * 64 + 4 * lo);
            const float mean = red16((o4[0] + o4[1]) + (o4[2] + o4[3])) * (1.0f / 64.0f);
            const f32x4 d = o4 - mean;
            const float var = red16((d[0] * d[0] + d[1] * d[1]) + (d[2] * d[2] + d[3] * d[3])) * (1.0f / 64.0f);
            const float rs = 1.0f / sqrtf(var + 64e-5f);
            const LAS float* p = cbb + hi * 384 + 4 * lo;
            const f32x4 r4 = *(const LAS f32x4*)(p), kp4 = *(const LAS f32x4*)(p + 128), v4 = *(const LAS f32x4*)(p + 320);
            const f32x4 rk = ld4(PARP(PAR_RK) + e * 1024 + hc);
            const float bonus = red16((r4[0] * kp4[0] * rk[0] + r4[1] * kp4[1] * rk[1]) + (r4[2] * kp4[2] * rk[2] + r4[3] * kp4[3] * rk[3]));
            const f32x4 on = d * rs * ld4(PARP(PAR_LNW) + e * 1024 + hc) + ld4(PARP(PAR_LNB) + e * 1024 + hc) + v4 * bonus;
            st4bf(YIN + m * D + hc, on * ld4(WAG + m * NLORA + 2048 + hc));
        }
    }
    float* so = AOUT + (prompt ? O_PRWKV + ((size_t)(q * 2 + e) * 16 + h) * 4096 : O_SRWKV + ((size_t)(bs * 2 + e) * 16 + h) * 4096);
    if (stepper) {
#pragma unroll
        for (int i = 0; i < 2; ++i)
#pragma unroll
            for (int c = 0; c < 2; ++c) *(f32x4*)(so + (2 * hs + i) * 64 + 8 * ls + 4 * c) = S[i][c];
    }
    __syncthreads();
}

__device__ __forceinline__ float hg_lb(const Args& A, int e, int ch) {
    if (e == 0) return 0.f;
    const float l0 = PARP(PAR_HGLB)[ch], l1 = PARP(PAR_HGLB)[1024 + ch]; return sigm(l1 - l0);
}
constexpr int HG_S = 130, HG_VS = 132;
typedef short hbf16x8 __attribute__((ext_vector_type(8)));
__device__ __forceinline__ hbf16x8 pack8_strided(const LAS float* p, int st) {
    v4u o; o.x = cvt_pk_bf16(p[0], p[st]); o.y = cvt_pk_bf16(p[2 * st], p[3 * st]); o.z = cvt_pk_bf16(p[4 * st], p[5 * st]); o.w = cvt_pk_bf16(p[6 * st], p[7 * st]); return __builtin_bit_cast(hbf16x8, o); }
__device__ __forceinline__ void hgrn_chunk_unit(const Args& A, Frame& F, int e, int b, int h, int c) {
    const int tid = F.tid, lane = F.lane, w = F.wave, g = lane >> 4, i = lane & 15;
    const bf16* PROJ = (const bf16*)(A.ws + WS_PROJ);
    float* OI = (float*)(A.ws + WS_OI); float* QT = (float*)(A.ws + WS_QT); float* HU = (float*)(A.ws + WS_HU); float* HD = (float*)(A.ws + WS_HD);
    LAS float* Qs = (LAS float*)F.lds; LAS float* Ks = Qs + 64 * HG_S; LAS float* Vs = Ks + 64 * HG_S; LAS float* Gs = Vs + 64 * HG_VS; LAS float* As = Gs;
    LAS float* GB = Gs + 64 * HG_S; LAS float* EJ = GB + 5 * 128;
    const int m0 = b * TP + c * 64, unit = (b * 8 + h) * 32 + c;
    f32x4 lbv;
#pragma unroll
    for (int j = 0; j < 4; ++j) lbv[j] = hg_lb(A, e, h * 128 + (tid & 31) * 4 + j);
    f32x4 qv4[4], fv4[4], iv4[4];
#pragma unroll
    for (int it = 0; it < 4; ++it) { const int idx = tid + 512 * it, row = idx >> 5, c4 = (idx & 31) * 4;
        const bf16* pr = PROJ + (size_t)(m0 + row) * NEV + PRW + h * 128 + c4; qv4[it] = ldp4(pr); fv4[it] = ldp4(pr + 1024); iv4[it] = ldp4(pr + 2048); }
#pragma unroll
    for (int it = 0; it < 4; ++it) {
        const int idx = tid + 512 * it, row = idx >> 5, c4 = (idx & 31) * 4;
        const f32x4 qv = qv4[it], fv = fv4[it], iv = iv4[it];
#pragma unroll
        for (int j = 0; j < 4; ++j) {
            const float lb = lbv[j], sg = fmaxf(sigm(fv[j]), 1e-37f);
            Qs[row * HG_S + c4 + j] = silu_(qv[j]);
            Gs[row * HG_S + c4 + j] = __logf(lb + (1.0f - lb) * sg);
            Ks[row * HG_S + c4 + j] = (1.0f - lb) * (1.0f - sg);
        }
        *(LAS f32x4*)(Vs + row * HG_VS + c4) = iv;
    }
    __syncthreads();
    LAS float* TQ = EJ + 512;
    { const int k = tid & 127, I = tid >> 7; float run = 0.f;
#pragma unroll
        for (int t = 0; t < 16; ++t) { run += Gs[(16 * I + t) * HG_S + k]; Gs[(16 * I + t) * HG_S + k] = run; }
        TQ[tid] = run; }
    __syncthreads();
    { const int J = tid >> 7, k = tid & 127; const float t0 = TQ[k], t1 = TQ[128 + k], t2 = TQ[256 + k], t3 = TQ[384 + k];
      const float gbJ = J == 0 ? 0.f : (J == 1 ? t0 : (J == 2 ? t0 + t1 : (t0 + t1) + t2)), gl = ((t0 + t1) + t2) + t3;
      GB[J * 128 + k] = gbJ; if (J == 3) GB[4 * 128 + k] = gl; EJ[tid] = __expf(gl - gbJ); if (J == 0) HD[unit * 128 + k] = __expf(gl); }
#pragma unroll
    for (int it = 0; it < 4; ++it) {
        const int idx = tid + 512 * it, row = idx >> 5, c4 = (idx & 31) * 4, I = row >> 4; f32x4 o;
#pragma unroll
        for (int j = 0; j < 4; ++j) { const int kc = c4 + j; const float q = Qs[row * HG_S + kc], G = Gs[row * HG_S + kc];
            const float gb = I == 0 ? 0.f : (I == 1 ? TQ[kc] : (I == 2 ? TQ[kc] + TQ[128 + kc] : (TQ[kc] + TQ[128 + kc]) + TQ[256 + kc]));
            o[j] = q * __expf(G + gb); Qs[row * HG_S + kc] = q * __expf(G); Ks[row * HG_S + kc] *= __expf(fminf(-G, 80.0f)); }
        *(f32x4*)(QT + (size_t)(m0 + row) * 1024 + h * 128 + c4) = o;
    }
    __syncthreads();
    for (int pi = w; pi < 10; pi += 8) {
        const int I = pi < 1 ? 0 : (pi < 3 ? 1 : (pi < 6 ? 2 : 3)), J = pi - (I * (I + 1)) / 2;
        f32x4 acc = {0.f, 0.f, 0.f, 0.f};
#pragma unroll 8
        for (int s = 0; s < 32; ++s) { const int k = 4 * s + g;
            float av = Qs[(16 * I + i) * HG_S + k]; if (I != J) av *= __expf(GB[I * 128 + k] - GB[J * 128 + k]);
            acc = __builtin_amdgcn_mfma_f32_16x16x4f32(av, Ks[(16 * J + i) * HG_S + k], acc, 0, 0, 0); }
#pragma unroll
        for (int r = 0; r < 4; ++r) As[(16 * I + 4 * g + r) * 66 + 16 * J + i] = (I != J || i <= 4 * g + r) ? acc[r] : 0.f;
    }
    __syncthreads();
    {
        hbf16x8 vB[2];
#pragma unroll
        for (int ks = 0; ks < 2; ++ks) vB[ks] = pack8_strided(Vs + (32 * ks + 8 * g) * HG_VS + 16 * w + i, HG_VS);
#pragma unroll
        for (int I = 0; I < 4; ++I) {
            f32x4 acc = {0.f, 0.f, 0.f, 0.f};
#pragma unroll
            for (int ks = 0; ks < 2; ++ks) if (32 * ks < 16 * (I + 1)) {
                hbf16x8 aA = pack8_strided(As + (16 * I + i) * 66 + 32 * ks + 8 * g, 1);
                if (32 * ks + 8 * g >= 16 * (I + 1)) aA = (hbf16x8){0, 0, 0, 0, 0, 0, 0, 0};
                acc = __builtin_amdgcn_mfma_f32_16x16x32_bf16(aA, vB[ks], acc, 0, 0, 0); }
#pragma unroll
            for (int r = 0; r < 4; ++r) OI[(size_t)(m0 + 16 * I + 4 * g + r) * 1024 + h * 128 + 16 * w + i] = acc[r];
        }
        hbf16x8 kA[2];
#pragma unroll
        for (int ks = 0; ks < 2; ++ks) { const LAS float* p = Ks + (32 * ks + 8 * g) * HG_S + 16 * w + i; const int J = (32 * ks + 8 * g) >> 4; const float ej = EJ[J * 128 + 16 * w + i];
            v4u o; o.x = cvt_pk_bf16(p[0] * ej, p[HG_S] * ej); o.y = cvt_pk_bf16(p[2 * HG_S] * ej, p[3 * HG_S] * ej); o.z = cvt_pk_bf16(p[4 * HG_S] * ej, p[5 * HG_S] * ej); o.w = cvt_pk_bf16(p[6 * HG_S] * ej, p[7 * HG_S] * ej);
            kA[ks] = __builtin_bit_cast(hbf16x8, o); }
#pragma unroll 2
        for (int vb = 0; vb < 8; ++vb) {
            f32x4 acc = {0.f, 0.f, 0.f, 0.f};
#pragma unroll
            for (int ks = 0; ks < 2; ++ks) acc = __builtin_amdgcn_mfma_f32_16x16x32_bf16(kA[ks], pack8_strided(Vs + (32 * ks + 8 * g) * HG_VS + 16 * vb + i, HG_VS), acc, 0, 0, 0);
#pragma unroll
            for (int r = 0; r < 4; ++r) HU[(size_t)unit * 16384 + (16 * w + 4 * g + r) * 128 + 16 * vb + i] = acc[r];
        }
    }
    __syncthreads();
}
constexpr int HC_S = 132, HC_T = 72;
#define HC_SW(rc_, t_) ((rc_) * HC_T + ((((t_) >> 3) ^ (((rc_) >> 2) & 7)) << 3) + ((t_) & 7))
__device__ __forceinline__ hbf16x8 pk8f(const f32x4& a, const f32x4& b) { v4u o; o.x = cvt_pk_bf16(a[0], a[1]); o.y = cvt_pk_bf16(a[2], a[3]); o.z = cvt_pk_bf16(b[0], b[1]); o.w = cvt_pk_bf16(b[2], b[3]); return __builtin_bit_cast(hbf16x8, o); }
__device__ __forceinline__ void hgrn_chunk_unit2(const Args& A, Frame& F, int e, int b, int h, int c) {
    const int tid = F.tid, lane = F.lane, w = F.wave, g = lane >> 4, i = lane & 15;
    const bf16* PROJ = (const bf16*)(A.ws + WS_PROJ);
    float* OI = (float*)(A.ws + WS_OI); float* QT = (float*)(A.ws + WS_QT); float* HU = (float*)(A.ws + WS_HU); float* HD = (float*)(A.ws + WS_HD);
    LAS float* Qs = (LAS float*)F.lds; LAS float* Ks = Qs + 64 * HC_S; LAS float* Gs = Ks + 64 * HC_S;
    LAS unsigned short* AsB = (LAS unsigned short*)Gs;
    LAS unsigned short* VT = (LAS unsigned short*)(Gs + 64 * HC_S);
    LAS unsigned short* KT = VT + 128 * HC_T;
    LAS float* GB = (LAS float*)(KT + 128 * HC_T); LAS float* TQ = GB + 5 * 128;
    const int m0 = b * TP + c * 64, unit = (b * 8 + h) * 32 + c;
    f32x4 lbv;
#pragma unroll
    for (int j = 0; j < 4; ++j) lbv[j] = hg_lb(A, e, h * 128 + (tid & 31) * 4 + j);
    v2u qr4[4], fr4[4], ir4[4];
#pragma unroll
    for (int it = 0; it < 4; ++it) { const int idx = tid + 512 * it, row = idx >> 5, c4 = (idx & 31) * 4;
        const bf16* pr = PROJ + (size_t)(m0 + row) * NEV + PRW + h * 128 + c4; qr4[it] = *(const v2u*)pr; fr4[it] = *(const v2u*)(pr + 1024); ir4[it] = *(const v2u*)(pr + 2048); }
#pragma unroll
    for (int it = 0; it < 4; ++it) {
        const int idx = tid + 512 * it, row = idx >> 5, c4 = (idx & 31) * 4;
        const f32x4 qv = {bf2f(qr4[it].x & 0xffffu), bf2f(qr4[it].x >> 16), bf2f(qr4[it].y & 0xffffu), bf2f(qr4[it].y >> 16)};
        const f32x4 fv = {bf2f(fr4[it].x & 0xffffu), bf2f(fr4[it].x >> 16), bf2f(fr4[it].y & 0xffffu), bf2f(fr4[it].y >> 16)};
        f32x4 Q4, G4, K4;
#pragma unroll
        for (int j = 0; j < 4; ++j) { const float lb = lbv[j], sg = fmaxf(sigm(fv[j]), 1e-37f);
            Q4[j] = silu_(qv[j]); G4[j] = __logf(lb + (1.0f - lb) * sg); K4[j] = (1.0f - lb) * (1.0f - sg); }
        *(LAS f32x4*)(Qs + row * HC_S + c4) = Q4; *(LAS f32x4*)(Gs + row * HC_S + c4) = G4; *(LAS f32x4*)(Ks + row * HC_S + c4) = K4;
        VT[HC_SW(c4 + 0, row)] = (unsigned short)(ir4[it].x & 0xffffu); VT[HC_SW(c4 + 1, row)] = (unsigned short)(ir4[it].x >> 16);
        VT[HC_SW(c4 + 2, row)] = (unsigned short)(ir4[it].y & 0xffffu); VT[HC_SW(c4 + 3, row)] = (unsigned short)(ir4[it].y >> 16);
    }
    __syncthreads();
    { const int k = tid & 127, I = tid >> 7; float run = 0.f;
#pragma unroll
        for (int t = 0; t < 16; ++t) { run += Gs[(16 * I + t) * HC_S + k]; Gs[(16 * I + t) * HC_S + k] = run; }
        TQ[tid] = run; }
    __syncthreads();
    { const int J = tid >> 7, k = tid & 127; const float t0 = TQ[k], t1 = TQ[128 + k], t2 = TQ[256 + k], t3 = TQ[384 + k];
      const float gbJ = J == 0 ? 0.f : (J == 1 ? t0 : (J == 2 ? t0 + t1 : (t0 + t1) + t2)), gl = ((t0 + t1) + t2) + t3;
      GB[J * 128 + k] = gbJ; if (J == 3) GB[4 * 128 + k] = gl; if (J == 0) HD[unit * 128 + k] = __expf(gl); }
#pragma unroll
    for (int it = 0; it < 4; ++it) {
        const int idx = tid + 512 * it, row = idx >> 5, c4 = (idx & 31) * 4, I = row >> 4;
        const f32x4 q4 = *(const LAS f32x4*)(Qs + row * HC_S + c4), G4 = *(const LAS f32x4*)(Gs + row * HC_S + c4), K4 = *(const LAS f32x4*)(Ks + row * HC_S + c4);
        const f32x4 t0 = *(const LAS f32x4*)(TQ + c4), t1 = *(const LAS f32x4*)(TQ + 128 + c4), t2 = *(const LAS f32x4*)(TQ + 256 + c4), t3 = *(const LAS f32x4*)(TQ + 384 + c4);
        const f32x4 z4 = {0.f, 0.f, 0.f, 0.f};
        const f32x4 gb = I == 0 ? z4 : (I == 1 ? t0 : (I == 2 ? t0 + t1 : (t0 + t1) + t2)), gl = ((t0 + t1) + t2) + t3;
        f32x4 o, Qn, Kn, ke;
#pragma unroll
        for (int j = 0; j < 4; ++j) { o[j] = q4[j] * __expf(G4[j] + gb[j]); Qn[j] = q4[j] * __expf(G4[j]); Kn[j] = K4[j] * __expf(fminf(-G4[j], 80.0f)); ke[j] = Kn[j] * __expf(gl[j] - gb[j]); }
        st4bf((bf16*)QT + (size_t)(m0 + row) * 1024 + h * 128 + c4, o);
        *(LAS f32x4*)(Qs + row * HC_S + c4) = Qn; *(LAS f32x4*)(Ks + row * HC_S + c4) = Kn;
        const unsigned k01 = cvt_pk_bf16(ke[0], ke[1]), k23 = cvt_pk_bf16(ke[2], ke[3]);
        KT[HC_SW(c4 + 0, row)] = (unsigned short)(k01 & 0xffffu); KT[HC_SW(c4 + 1, row)] = (unsigned short)(k01 >> 16);
        KT[HC_SW(c4 + 2, row)] = (unsigned short)(k23 & 0xffffu); KT[HC_SW(c4 + 3, row)] = (unsigned short)(k23 >> 16);
    }
    __syncthreads();
    for (int pi = w; pi < 10; pi += 8) {
        const int I = pi < 1 ? 0 : (pi < 3 ? 1 : (pi < 6 ? 2 : 3)), J = pi - (I * (I + 1)) / 2;
        f32x4 acc = {0.f, 0.f, 0.f, 0.f};
#pragma unroll
        for (int ks = 0; ks < 4; ++ks) { const int kb = 32 * ks + 8 * g;
            f32x4 a0 = *(const LAS f32x4*)(Qs + (16 * I + i) * HC_S + kb), a1 = *(const LAS f32x4*)(Qs + (16 * I + i) * HC_S + kb + 4);
            if (I != J) { const f32x4 d0 = *(const LAS f32x4*)(GB + I * 128 + kb) - *(const LAS f32x4*)(GB + J * 128 + kb), d1 = *(const LAS f32x4*)(GB + I * 128 + kb + 4) - *(const LAS f32x4*)(GB + J * 128 + kb + 4);
#pragma unroll
                for (int j = 0; j < 4; ++j) { a0[j] *= __expf(d0[j]); a1[j] *= __expf(d1[j]); } }
            const f32x4 b0 = *(const LAS f32x4*)(Ks + (16 * J + i) * HC_S + kb), b1 = *(const LAS f32x4*)(Ks + (16 * J + i) * HC_S + kb + 4);
            acc = __builtin_amdgcn_mfma_f32_16x16x32_bf16(pk8f(a0, a1), pk8f(b0, b1), acc, 0, 0, 0); }
#pragma unroll
        for (int r = 0; r < 4; ++r) { const int t = 4 * g + r; const float v = (I != J || i <= t) ? acc[r] : 0.f;
            AsB[(16 * I + t) * HC_T + 16 * J + i] = (unsigned short)(cvt_pk_bf16(v, 0.f) & 0xffffu); }
    }
    __syncthreads();
    {
        hbf16x8 vB[2];
#pragma unroll
        for (int ks = 0; ks < 2; ++ks) vB[ks] = *(const LAS hbf16x8*)(VT + HC_SW(16 * w + i, 32 * ks + 8 * g));
#pragma unroll
        for (int I = 0; I < 4; ++I) {
            f32x4 acc = {0.f, 0.f, 0.f, 0.f};
#pragma unroll
            for (int ks = 0; ks < 2; ++ks) if (32 * ks < 16 * (I + 1)) {
                hbf16x8 aA = *(const LAS hbf16x8*)(AsB + (16 * I + i) * HC_T + 32 * ks + 8 * g);
                if (32 * ks + 8 * g >= 16 * (I + 1)) aA = (hbf16x8){0, 0, 0, 0, 0, 0, 0, 0};
                acc = __builtin_amdgcn_mfma_f32_16x16x32_bf16(vB[ks], aA, acc, 0, 0, 0); }
            st4bf((bf16*)OI + (size_t)(m0 + 16 * I + i) * 1024 + h * 128 + 16 * w + 4 * g, acc);
        }
        hbf16x8 kA[2];
#pragma unroll
        for (int ks = 0; ks < 2; ++ks) kA[ks] = *(const LAS hbf16x8*)(KT + HC_SW(16 * w + i, 32 * ks + 8 * g));
#pragma unroll
        for (int vb = 0; vb < 8; ++vb) {
            f32x4 acc = {0.f, 0.f, 0.f, 0.f};
#pragma unroll
            for (int ks = 0; ks < 2; ++ks) acc = __builtin_amdgcn_mfma_f32_16x16x32_bf16(*(const LAS hbf16x8*)(VT + HC_SW(16 * vb + i, 32 * ks + 8 * g)), kA[ks], acc, 0, 0, 0);
            st4bf((bf16*)HU + (size_t)unit * 16384 + (16 * w + i) * 128 + 16 * vb + 4 * g, acc);
        }
    }
    __syncthreads();
}
__device__ __forceinline__ void hgrn_sample_unit(const Args& A, Frame& F, int e, int bs, int h) {
    const int tid = F.tid;
    const bf16* PROJ = (const bf16*)(A.ws + WS_PROJ); bf16* YIN = (bf16*)(A.ws + WS_YIN);
    LAS float* sq = (LAS float*)F.lds; LAS float* sf = sq + 512; LAS float* sk = sf + 512; LAS float* po = sk + 512; LAS float* pn = po + 2048;
    const int mrow = MP + bs * TS;
    { const int t = tid >> 7, k = tid & 127; const bf16* pr = PROJ + (size_t)(mrow + t) * NEV + PRW + h * 128 + k;
      const float qv = bf2f(pr[0]), fv = bf2f(pr[1024]), lb = hg_lb(A, e, h * 128 + k);
      sq[tid] = silu_(qv); sf[tid] = lb + (1.0f - lb) * sigm(fv); sk[tid] = (1.0f - lb) * sigm(-fv); }
    const int v = tid & 127, kq = tid >> 7;
    const size_t sbase = (((size_t)(bs * 2 + e) * 8 + h) * 128) * 128;
    float S[32];
#pragma unroll
    for (int j = 0; j < 32; ++j) S[j] = A.in[4][sbase + (size_t)(32 * kq + j) * 128 + v];
    float vt[4];
#pragma unroll
    for (int t = 0; t < 4; ++t) vt[t] = bf2f(PROJ[(size_t)(mrow + t) * NEV + PRW + 2048 + h * 128 + v]);
    __syncthreads();
#pragma unroll
    for (int t = 0; t < 4; ++t) { float o = 0.f;
#pragma unroll
        for (int j = 0; j < 32; ++j) { const int k = t * 128 + 32 * kq + j; S[j] = sf[k] * S[j] + sk[k] * vt[t]; o += S[j] * sq[k]; }
        po[(t * 4 + kq) * 128 + v] = o; }
    __syncthreads();
    { const int t = tid >> 7; const float o = (po[(t * 4 + 0) * 128 + v] + po[(t * 4 + 1) * 128 + v]) + (po[(t * 4 + 2) * 128 + v] + po[(t * 4 + 3) * 128 + v]);
      const float ss = wave_sum(o * o); if (F.lane == 0) pn[F.wave] = ss;
      __syncthreads();
      const float tot = pn[(F.wave & ~1)] + pn[(F.wave | 1)];
      const size_t m = (size_t)(mrow + t);
      const float og = bf2f(PROJ[m * NEV + PRW + 3072 + h * 128 + v]);
      const float y = o * (1.0f / sqrtf(tot * (1.0f / 128.0f) + 1e-5f)) * PARP(PAR_HGN)[e * 1024 + h * 128 + v] * silu_(og);
      YIN[m * D + 1024 + h * 128 + v] = (bf16)f2bf(y); }
    float* so = AOUT + O_SHGRN + sbase;
#pragma unroll
    for (int j = 0; j < 32; ++j) so[(size_t)(32 * kq + j) * 128 + v] = S[j];
    __syncthreads();
}
__device__ __forceinline__ void hgrn_state_scan(const Args& A, Frame& F, int e) {
    float* HU = (float*)(A.ws + WS_HU); const float* HD = (const float*)(A.ws + WS_HD);
    const int gt = F.blk * NTHR + F.tid, NGT = F.G * NTHR;
    for (int idx = gt; idx < BP * 8 * 128 * 32; idx += NGT) {
        const int v4 = (idx & 31) * 4, k = (idx >> 5) & 127, bh = idx >> 12;
        f32x4 S = {0.f, 0.f, 0.f, 0.f};
#pragma unroll 1
        for (int c0 = 0; c0 < 32; c0 += 8) {
            f32x4 u[8]; float dcy[8];
#pragma unroll
            for (int q = 0; q < 8; ++q) { const int unit = bh * 32 + c0 + q; u[q] = ldp4((const bf16*)HU + (size_t)unit * 16384 + k * 128 + v4); dcy[q] = HD[unit * 128 + k]; }
#pragma unroll
            for (int q = 0; q < 8; ++q) { const int unit = bh * 32 + c0 + q; st4bf((bf16*)HU + (size_t)unit * 16384 + k * 128 + v4, S); S = S * dcy[q] + u[q]; }
        }
        const int b = bh >> 3, h = bh & 7;
        *(f32x4*)(AOUT + O_PHGRN + (((size_t)(b * 2 + e) * 8 + h) * 128 + k) * 128 + v4) = S;
    }
}
struct HfRaw { v2u qt[4], hu[8]; };
__device__ __forceinline__ void hgrn_finish_load(const Args& A, Frame& F, int b, int h, int c, HfRaw& r) {
    const float* QT = (const float*)(A.ws + WS_QT); const float* HU = (const float*)(A.ws + WS_HU);
    const int tid = F.tid, m0 = b * TP + c * 64, unit = (b * 8 + h) * 32 + c;
#pragma unroll
    for (int it = 0; it < 4; ++it) { const int idx = tid + 512 * it, row = idx >> 5, c4 = (idx & 31) * 4; r.qt[it] = *(const v2u*)((const bf16*)QT + (size_t)(m0 + row) * 1024 + h * 128 + c4); }
#pragma unroll
    for (int it = 0; it < 8; ++it) { const int idx = tid + 512 * it, row = idx >> 5, c4 = (idx & 31) * 4; r.hu[it] = *(const v2u*)((const bf16*)HU + (size_t)unit * 16384 + row * 128 + c4); }
}
__device__ __forceinline__ void hgrn_finish_unit(const Args& A, Frame& F, int e, int b, int h, int c, const HfRaw& raw, bool has_next, int nb, int nh, int nc, HfRaw& nraw) {
    const int tid = F.tid, lane = F.lane, w = F.wave, g = lane >> 4, i = lane & 15;
    const bf16* PROJ = (const bf16*)(A.ws + WS_PROJ); const float* OI = (const float*)(A.ws + WS_OI); bf16* YIN = (bf16*)(A.ws + WS_YIN);
    LAS float* Qt = (LAS float*)F.lds; LAS float* Ss = Qt + 64 * HG_S; LAS float* Os = Ss + 128 * HG_VS;
    LAS unsigned short* QtB = (LAS unsigned short*)Qt;
    const int m0 = b * TP + c * 64;
#pragma unroll
    for (int it = 0; it < 4; ++it) { const int idx = tid + 512 * it, row = idx >> 5, c4 = (idx & 31) * 4; *(LAS v2u*)(QtB + row * 136 + c4) = raw.qt[it]; }
#pragma unroll
    for (int it = 0; it < 8; ++it) { const int idx = tid + 512 * it, row = idx >> 5, c4 = (idx & 31) * 4; *(LAS f32x4*)(Ss + row * HG_VS + c4) = cvq(raw.hu[it]); }
    __syncthreads();
    v2u oi[4];
#pragma unroll
    for (int tb = 0; tb < 4; ++tb) oi[tb] = *(const v2u*)((const bf16*)OI + (size_t)(m0 + 16 * tb + i) * 1024 + h * 128 + 16 * w + 4 * g);
    const int t = tid >> 3, vg = tid & 7; const size_t m = (size_t)(m0 + t);
    f32x4 og[4], gn[4];
#pragma unroll
    for (int jj = 0; jj < 4; ++jj) { const int ch = h * 128 + 4 * vg + 32 * jj; og[jj] = ldp4(PROJ + m * NEV + PRW + 3072 + ch); gn[jj] = ld4(PARP(PAR_HGN) + e * 1024 + ch); }
    if (has_next) hgrn_finish_load(A, F, nb, nh, nc, nraw);
    {
        hbf16x8 sB[4];
#pragma unroll
        for (int ks = 0; ks < 4; ++ks) sB[ks] = pack8_strided(Ss + (32 * ks + 8 * g) * HG_VS + 16 * w + i, HG_VS);
#pragma unroll
        for (int tb = 0; tb < 4; ++tb) {
            f32x4 acc = cvq(oi[tb]);
#pragma unroll
            for (int ks = 0; ks < 4; ++ks) acc = __builtin_amdgcn_mfma_f32_16x16x32_bf16(sB[ks], *(const LAS hbf16x8*)(QtB + (16 * tb + i) * 136 + 32 * ks + 8 * g), acc, 0, 0, 0);
            *(LAS f32x4*)(Os + (16 * tb + i) * HG_VS + 16 * w + 4 * g) = acc;
        }
    }
    __syncthreads();
    f32x4 acc[4]; float ss = 0.f;
#pragma unroll
    for (int jj = 0; jj < 4; ++jj) {
#pragma unroll
        for (int q = 0; q < 4; ++q) acc[jj][q] = Os[t * HG_VS + 4 * vg + 32 * jj + q];
        ss += (acc[jj][0] * acc[jj][0] + acc[jj][1] * acc[jj][1]) + (acc[jj][2] * acc[jj][2] + acc[jj][3] * acc[jj][3]); }
    const float rs = 1.0f / sqrtf(red8(ss) * (1.0f / 128.0f) + 1e-5f);
#pragma unroll
    for (int jj = 0; jj < 4; ++jj) { const int ch = h * 128 + 4 * vg + 32 * jj; f32x4 y;
#pragma unroll
        for (int q = 0; q < 4; ++q) y[q] = acc[jj][q] * rs * gn[jj][q] * silu_(og[jj][q]);
        st4bf(YIN + m * D + 1024 + ch, y); }
    __syncthreads();
}

__device__ __forceinline__ f32x4 oddin_sample4(const Args& A, int m, int col) {
    const bf16* sl = (const bf16*)(A.ws + WS_OSLAB) + (size_t)((((m - MP) >> 8) * 16 + (col >> 8)) * 8) * 65536 + ((m - MP) & 255) * 256 + (col & 255);
    f32x4 s = {0.f, 0.f, 0.f, 0.f};
#pragma unroll
    for (int p = 0; p < 8; ++p) s += ldp4(sl + (size_t)p * 65536);
    return s * ((const float*)(A.ws + WS_RSTD))[m];
}
__device__ __forceinline__ void o2_conv(const Args& A, Frame& F, int o_) {
    const bf16* XB = (const bf16*)(A.ws + WS_XB); bf16* XCB = (bf16*)(A.ws + WS_XCB); const bool split = F.G == 256;
    const int gt = F.blk * NTHR + F.tid, NGT = F.G * NTHR;
    if (split) for (int idx = gt; idx < (MP / 32) * 512; idx += NGT) {
        const int ch = (idx & 511) * 4, m0 = (idx >> 9) * 32, t0 = m0 & (TP - 1);
        const f32x4 cb = ld4(PARP(PAR_CONVB) + o_ * 2048 + ch); f32x4 cw[4];
#pragma unroll
        for (int j = 0; j < 4; ++j) cw[j] = ld4(PARP(PAR_CONVW) + (size_t)(o_ * 4 + j) * 2048 + ch);
        f32x4 w0 = {0.f, 0.f, 0.f, 0.f}, w1 = w0, w2 = w0;
        if (t0 > 0) { w0 = ldp4(XB + (size_t)(m0 - 3) * 2048 + ch); w1 = ldp4(XB + (size_t)(m0 - 2) * 2048 + ch); w2 = ldp4(XB + (size_t)(m0 - 1) * 2048 + ch); }
#pragma unroll
        for (int r0 = 0; r0 < 32; r0 += 16) {
            f32x4 x[16];
#pragma unroll
            for (int q = 0; q < 16; ++q) x[q] = ldp4(XB + (size_t)(m0 + r0 + q) * 2048 + ch);
#pragma unroll
            for (int q = 0; q < 16; ++q) { st4bf(XCB + (size_t)(m0 + r0 + q) * 2048 + ch, cb + w0 * cw[0] + w1 * cw[1] + w2 * cw[2] + x[q] * cw[3]); w0 = w1; w1 = w2; w2 = x[q]; }
        }
    }
    else for (int idx = gt; idx < M * 512; idx += NGT) {
        const int ch = (idx & 511) * 4, m = idx >> 9;
        int t, bs; if (m < MP) { t = m & (TP - 1); bs = -1; } else { t = (m - MP) & 3; bs = (m - MP) >> 2; }
        f32x4 acc = ld4(PARP(PAR_CONVB) + o_ * 2048 + ch);
#pragma unroll
        for (int j = 0; j < 4; ++j) { const int ti = t + j - 3; f32x4 x;
            if (ti >= 0) x = (split && m >= MP) ? oddin_sample4(A, m + j - 3, 2048 + ch) : ldp4(XB + (size_t)(m + j - 3) * 2048 + ch);
            else if (bs >= 0) x = ld4(A.in[5] + ((size_t)(bs * 2 + o_) * 3 + (ti + 3)) * 2048 + ch);
            else x = (f32x4){0.f, 0.f, 0.f, 0.f};
            acc += x * ld4(PARP(PAR_CONVW) + (size_t)(o_ * 4 + j) * 2048 + ch); }
        st4bf(XCB + (size_t)m * 2048 + ch, acc);
    }
    if (split) for (int idx = gt; idx < BS * 512; idx += NGT) {
        const int ch = (idx & 511) * 4, bs = idx >> 9, m0 = MP + bs * TS;
        f32x4 xr[7];
#pragma unroll
        for (int i = 0; i < 3; ++i) xr[i] = ld4(A.in[5] + ((size_t)(bs * 2 + o_) * 3 + i) * 2048 + ch);
#pragma unroll
        for (int t = 0; t < 4; ++t) xr[3 + t] = oddin_sample4(A, m0 + t, 2048 + ch);
        const f32x4 cb = ld4(PARP(PAR_CONVB) + o_ * 2048 + ch); f32x4 cw[4];
#pragma unroll
        for (int j = 0; j < 4; ++j) cw[j] = ld4(PARP(PAR_CONVW) + (size_t)(o_ * 4 + j) * 2048 + ch);
#pragma unroll
        for (int t = 0; t < 4; ++t) st4bf(XCB + (size_t)(m0 + t) * 2048 + ch, cb + xr[t] * cw[0] + xr[t + 1] * cw[1] + xr[t + 2] * cw[2] + xr[t + 3] * cw[3]);
#pragma unroll
        for (int i = 0; i < 3; ++i) *(f32x4*)(AOUT + O_SCONV + ((size_t)(bs * 2 + o_) * 3 + i) * 2048 + ch) = xr[4 + i];
    }
    for (int idx = gt; idx < (split ? BP : NSEQ) * 3 * 512; idx += NGT) {
        const int ch = (idx & 511) * 4, r = idx >> 9, i = r % 3, q = r / 3;
        const int T = q < BP ? TP : TS, row0 = q < BP ? q * TP : MP + (q - BP) * TS;
        float* o = AOUT + (q < BP ? O_PCONV + ((size_t)(q * 2 + o_) * 3 + i) * 2048 : O_SCONV + ((size_t)((q - BP) * 2 + o_) * 3 + i) * 2048) + ch;
        *(f32x4*)o = (split && q >= BP) ? oddin_sample4(A, row0 + T - 3 + i, 2048 + ch) : ldp4(XB + (size_t)(row0 + T - 3 + i) * 2048 + ch);
    }
}
__device__ __forceinline__ f32x2 lru_a(const float* LA_, size_t o) { const unsigned w = *(const unsigned*)((const bf16*)LA_ + o); return (f32x2){__expf(bf2f(w & 0xffffu)), __expf(bf2f(w >> 16))}; }
__device__ __forceinline__ f32x2 lru_b(const float* LB_, size_t o) { const unsigned w = *(const unsigned*)((const bf16*)LB_ + o); return (f32x2){bf2f(w & 0xffffu), bf2f(w >> 16)}; }
__device__ __forceinline__ void o4_tail(const Args& A, Frame& F) {
    const float* LA_ = (const float*)(A.ws + WS_LRA); const float* LB_ = (const float*)(A.ws + WS_LRB); float* CP = (float*)(A.ws + WS_CP); float* CHh = (float*)(A.ws + WS_CH);
    __syncthreads();
    const int half = F.tid & 1, cp = (F.tid >> 1) & 63, chunk = F.tid >> 7;
#pragma unroll 1
    for (int L = F.blk; L < 32 * 16; L += F.G) {
        const int pm = L >> 4, pn = L & 15; const int ch = pn * 128 + cp * 2; const int b = pm >> 3, c = (pm & 7) * 4 + chunk;
        f32x2 P = {1.f, 1.f}, H = {0.f, 0.f}; const size_t r0 = (size_t)(pm * 256 + chunk * 64 + half * 32) * 2048 + ch;
#pragma unroll 1
        for (int t0 = 0; t0 < 32; t0 += 8) {
            f32x2 a8[8], b8[8];
#pragma unroll
            for (int q = 0; q < 8; ++q) { a8[q] = lru_a(LA_, r0 + (size_t)(t0 + q) * 2048); b8[q] = lru_b(LB_, r0 + (size_t)(t0 + q) * 2048); }
#pragma unroll
            for (int q = 0; q < 8; ++q) { H = a8[q] * H + b8[q]; P = P * a8[q]; }
        }
        f32x2 Po, Ho; Po.x = __shfl_xor(P.x, 1); Po.y = __shfl_xor(P.y, 1); Ho.x = __shfl_xor(H.x, 1); Ho.y = __shfl_xor(H.y, 1);
        if (half == 0) { *(f32x2*)(CP + (size_t)(b * 32 + c) * 2048 + ch) = P * Po; *(f32x2*)(CHh + (size_t)(b * 32 + c) * 2048 + ch) = Po * H + Ho; }
    }
}
__device__ __forceinline__ void o4_lru_chunks(const Args& A, Frame& F) {
    const float* LA_ = (const float*)(A.ws + WS_LRA); const float* LB_ = (const float*)(A.ws + WS_LRB); float* CP = (float*)(A.ws + WS_CP); float* CHh = (float*)(A.ws + WS_CH);
    const int gt = F.blk * NTHR + F.tid, NGT = F.G * NTHR;
    for (int idx = gt; idx < BP * 32 * 1024; idx += NGT) {
        const int ch = (idx & 1023) * 2, c = (idx >> 10) & 31, b = idx >> 15;
        f32x2 P = {1.f, 1.f}, H = {0.f, 0.f}; const size_t r0 = (size_t)(b * TP + c * 64) * 2048 + ch;
#pragma unroll 1
        for (int t0 = 0; t0 < 64; t0 += 8) {
            f32x2 a8[8], b8[8];
#pragma unroll
            for (int q = 0; q < 8; ++q) { a8[q] = lru_a(LA_, r0 + (size_t)(t0 + q) * 2048); b8[q] = lru_b(LB_, r0 + (size_t)(t0 + q) * 2048); }
#pragma unroll
            for (int q = 0; q < 8; ++q) { H = a8[q] * H + b8[q]; P = P * a8[q]; }
        }
        *(f32x2*)(CP + (size_t)(b * 32 + c) * 2048 + ch) = P; *(f32x2*)(CHh + (size_t)(b * 32 + c) * 2048 + ch) = H;
    }
}
__device__ __forceinline__ void o5_lru_scan(const Args& A, Frame& F, int o_) {
    const float* LA_ = (const float*)(A.ws + WS_LRA); const float* LB_ = (const float*)(A.ws + WS_LRB); const float* CP = (const float*)(A.ws + WS_CP); const float* CHh = (const float*)(A.ws + WS_CH);
    const bf16* GATE = (const bf16*)(A.ws + WS_GATE); bf16* YIN = (bf16*)(A.ws + WS_YIN);
    const int gt = F.blk * NTHR + F.tid, NGT = F.G * NTHR;
    for (int idx = gt; idx < BP * 32 * 1024 + BS * 1024; idx += NGT) {
        int ch, nt_; size_t r0; f32x2 H; float* so = nullptr;
        if (idx < BP * 32 * 1024) {
            ch = (idx & 1023) * 2; const int c = (idx >> 10) & 31, b = idx >> 15; H = (f32x2){0.f, 0.f};
#pragma unroll 1
            for (int cb = 0; cb < c; cb += 8) {
                f32x2 p8[8], h8[8];
#pragma unroll
                for (int q = 0; q < 8; ++q) { const int cc = (cb + q < c) ? cb + q : c - 1; const size_t o = (size_t)(b * 32 + cc) * 2048 + ch; p8[q] = *(const f32x2*)(CP + o); h8[q] = *(const f32x2*)(CHh + o); }
#pragma unroll
                for (int q = 0; q < 8; ++q) if (cb + q < c) H = p8[q] * H + h8[q];
            }
            r0 = (size_t)(b * TP + c * 64) * 2048 + ch; nt_ = 64; if (c == 31) so = AOUT + O_PLRU + (size_t)(b * 2 + o_) * 2048 + ch;
        } else {
            const int r = idx - BP * 32 * 1024; ch = (r & 1023) * 2; const int bs = r >> 10;
            H = *(const f32x2*)(A.in[6] + (size_t)(bs * 2 + o_) * 2048 + ch); r0 = (size_t)(MP + bs * TS) * 2048 + ch; nt_ = TS; so = AOUT + O_SLRU + (size_t)(bs * 2 + o_) * 2048 + ch;
        }
#pragma unroll 1
        for (int t0 = 0; t0 < nt_; t0 += 4) {
            f32x2 a4[4], b4[4]; unsigned g4[4];
#pragma unroll
            for (int q = 0; q < 4; ++q) { const size_t o = r0 + (size_t)(t0 + q) * 2048; a4[q] = lru_a(LA_, o); b4[q] = lru_b(LB_, o);
                if (F.G == 256 && idx >= BP * 32 * 1024) {
                    const int m = (int)(o >> 11); const bf16* sl = (const bf16*)(A.ws + WS_OSLAB) + (size_t)((((m - MP) >> 8) * 16 + (ch >> 8)) * 8) * 65536 + ((m - MP) & 255) * 256 + (ch & 255);
                    unsigned w8[8];
#pragma unroll
                    for (int p = 0; p < 8; ++p) w8[p] = *(const unsigned*)(sl + (size_t)p * 65536);
                    float s0 = 0.f, s1 = 0.f;
#pragma unroll
                    for (int p = 0; p < 8; ++p) { s0 += bf2f(w8[p] & 0xffffu); s1 += bf2f(w8[p] >> 16); }
                    const float rs = ((const float*)(A.ws + WS_RSTD))[m];
                    g4[q] = cvt_pk_bf16(pg8::gelu_tanh(s0 * rs), pg8::gelu_tanh(s1 * rs));
                } else g4[q] = *(const unsigned*)(GATE + o); }
#pragma unroll
            for (int q = 0; q < 4; ++q) { const size_t o = r0 + (size_t)(t0 + q) * 2048; H = a4[q] * H + b4[q];
                *(unsigned*)(YIN + o) = cvt_pk_bf16(H[0] * bf2f(g4[q] & 0xffffu), H[1] * bf2f(g4[q] >> 16)); }
        }
        if (so) *(f32x2*)so = H;
    }
}
#ifndef R1W_SHFL_SCAN
#define R1W_SHFL_SCAN 0
#endif
#ifndef R1W_LDS_TINV
#define R1W_LDS_TINV 1
#endif
#ifndef R1W_MASK
#define R1W_MASK 31
#endif
#define R1O_MASK (31 & ~R1W_MASK)

__device__ __forceinline__ f32x4 mm16(const LAS float* a, int sai, int sak, const LAS float* b, int sbk, int sbj, int K, f32x4 acc, int lane) {
    const int i = lane & 15, g = lane >> 4;
#pragma unroll
    for (int s = 0; s < K / 4; ++s) acc = __builtin_amdgcn_mfma_f32_16x16x4f32(a[i * sai + (4 * s + g) * sak], b[(4 * s + g) * sbk + i * sbj], acc, 0, 0, 0);
    return acc;
}
constexpr int R1_RS = 68, R1_TS = 20, R1_HSZ = 16064;
constexpr int R1_RT = 0, R1_KAP = 1088, R1_BT = 2176, R1_KT = 3264,
              R1_KAPT = 4352, R1_BTT = 5632, R1_KTT = 6912, R1_VVT = 8192, R1_TKT = 9472, R1_W1T = 10752, R1_LKVT = 12032,
              R1_LB = 13312, R1_LK = 13632, R1_MRK = 13952, R1_MRB = 14272, R1_TM = 14592, R1_GAM = 14912, R1_GC = 16000;
__device__ __forceinline__ f32x4 mm4(const LAS float* a, const LAS float* b, f32x4 acc) {
    const f32x4 av = *(const LAS f32x4*)a, bv = *(const LAS f32x4*)b;
#pragma unroll
    for (int s = 0; s < 4; ++s) acc = __builtin_amdgcn_mfma_f32_16x16x4f32(av[s], bv[s], acc, 0, 0, 0);
    return acc;
}
__device__ __forceinline__ v4u pack8(const f32x4& a, const f32x4& b) { v4u o; o.x = cvt_pk_bf16(a[0], a[1]); o.y = cvt_pk_bf16(a[2], a[3]); o.z = cvt_pk_bf16(b[0], b[1]); o.w = cvt_pk_bf16(b[2], b[3]); return o; }

struct R1Raw { f32x4 pr, pk, pv, qr, qk, qv, wd, wa; };
__device__ __forceinline__ void rwkv_r1_load(const Args& A, Frame& F, int b, int h, int cp, R1Raw& r) {
    const bf16* PROJ = (const bf16*)(A.ws + WS_PROJ); const float* WAG = (const float*)(A.ws + WS_WAG);
    const int tt = F.tid >> 4, cg = F.tid & 15, hc = h * 64 + 4 * cg, tabs = cp * 32 + tt; const size_t m = (size_t)b * TP + tabs;
    r.pr = ldp4(PROJ + m * NEV + hc); r.pk = ldp4(PROJ + m * NEV + 1024 + hc); r.pv = ldp4(PROJ + m * NEV + 2048 + hc);
    r.qr = (f32x4){0.f, 0.f, 0.f, 0.f}; r.qk = r.qr; r.qv = r.qr;
    if (tabs > 0) { r.qr = ldp4(PROJ + (m - 1) * NEV + hc); r.qk = ldp4(PROJ + (m - 1) * NEV + 1024 + hc); r.qv = ldp4(PROJ + (m - 1) * NEV + 2048 + hc); }
    r.wd = ld4(WAG + m * NLORA + hc); r.wa = ld4(WAG + m * NLORA + 1024 + hc);
}
__device__ __forceinline__ void rwkv_r1_unit(const Args& A, Frame& F, int e, int b, int h, int cp, const R1Raw& raw) {
    const int tid = F.tid, tt = tid >> 4, cg = tid & 15, ts = tt & 15;
    const int hf = F.wave >> 2, wl = F.wave & 3, lane = F.lane, g = lane >> 4, i = lane & 15;
    LAS float* HS = (LAS float*)F.lds + (tt >> 4) * R1_HSZ;
    LAS float* HM = (LAS float*)F.lds + hf * R1_HSZ;
    const int hc = h * 64 + 4 * cg;
#ifndef R1_REP12
#define R1_REP12 1
#endif
    for (int rp12 = 0; rp12 < R1_REP12; ++rp12) {
    const float* mu = PARP(PAR_MU) + (size_t)e * PRW;
    const f32x4 zr = raw.pr + (raw.qr - raw.pr) * ld4(mu + hc), zk = raw.pk + (raw.qk - raw.pk) * ld4(mu + 1024 + hc), zv = raw.pv + (raw.qv - raw.pv) * ld4(mu + 2048 + hc);
    f32x4 kk = zk * ld4(PARP(PAR_KK) + e * 1024 + hc);
    const float ss = red16((kk[0] * kk[0] + kk[1] * kk[1]) + (kk[2] * kk[2] + kk[3] * kk[3]));
    kk = kk * (1.0f / fmaxf(sqrtf(ss), 1e-12f));
    const f32x4 kp = zk * (1.0f + (raw.wa - 1.0f) * ld4(PARP(PAR_KA) + e * 1024 + hc)), bb = kk * raw.wa;
    *(LAS f32x4*)(HS + R1_GAM + ts * 68 + 4 * cg) = raw.wd;
    {
        const f32x4 rk = ld4(PARP(PAR_RK) + e * 1024 + hc);
        const float bonus = red16((zr[0] * kp[0] * rk[0] + zr[1] * kp[1] * rk[1]) + (zr[2] * kp[2] * rk[2] + zr[3] * kp[3] * rk[3]));
        if (R1O_MASK & 16) *(f32x4*)((float*)(A.ws + WS_WAG) + ((size_t)b * TP + cp * 32 + tt) * NLORA + hc) = zv * bonus;
    }
    __syncthreads();
    {
        f32x4 gm = {1.f, 1.f, 1.f, 1.f}, gp = gm;
#pragma unroll
        for (int j = 0; j < 16; ++j) { const f32x4 wv = *(const LAS f32x4*)(HS + R1_GAM + j * 68 + 4 * cg); if (j <= ts) gm *= wv; if (j < ts) gp *= wv; }
        f32x4 inv;
#pragma unroll
        for (int j = 0; j < 4; ++j) inv[j] = 1.0f / gm[j];
        const f32x4 rt = zr * gm, kap = kk * gp, bt = bb * inv, kt = kp * inv;
        LAS float* pn = HS + ts * R1_RS + 4 * cg;
        *(LAS f32x4*)(pn + R1_RT) = rt; *(LAS f32x4*)(pn + R1_KAP) = kap; *(LAS f32x4*)(pn + R1_BT) = bt; *(LAS f32x4*)(pn + R1_KT) = kt;
        LAS float* pt = HS + (4 * cg) * R1_TS + ts;
#pragma unroll
        for (int j = 0; j < 4; ++j) { pt[R1_KAPT + j * R1_TS] = kap[j]; pt[R1_BTT + j * R1_TS] = bt[j]; pt[R1_KTT + j * R1_TS] = kt[j]; pt[R1_VVT + j * R1_TS] = zv[j]; }
        if (ts == 15) *(LAS f32x4*)(HS + R1_GC + 4 * cg) = gm;
    }
    __syncthreads();
    }
    const f32x4 z4 = {0.f, 0.f, 0.f, 0.f};
#define R1_ROWN(arr_, r_) (HM + (arr_) + (r_) * R1_RS + 16 * g)
#define R1_COLT(arr_, c_) (HM + (arr_) + (c_) * R1_TS + 4 * g)
#define R1_ROWM(arr_, r_) (HM + (arr_) + (r_) * R1_TS + 4 * g)
    {
        const LAS float* a = R1_ROWN((wl < 2) ? R1_KAP : R1_RT, i); const LAS float* bm = R1_ROWN((wl & 1) ? R1_KT : R1_BT, i);
        f32x4 d = z4;
#pragma unroll
        for (int q = 0; q < 4; ++q) d = mm4(a + 4 * q, bm + 4 * q, d);
        LAS float* o = HM + (wl == 0 ? R1_LB : (wl == 1 ? R1_LK : (wl == 2 ? R1_MRB : R1_MRK)));
#pragma unroll
        for (int r = 0; r < 4; ++r) { const int t = 4 * g + r; const bool keep = (wl < 2) ? (i < t) : (i <= t); o[t * R1_TS + i] = keep ? d[r] : 0.f; }
    }
    __syncthreads();
    {
        const f32x4 d = mm4(R1_ROWM(R1_LK, i), R1_COLT(R1_VVT, 16 * wl + i), z4);
        *(LAS f32x4*)(HM + R1_LKVT + (16 * wl + i) * R1_TS + 4 * g) = d;
        if (wl == 0) { float tr[16];
#pragma unroll
            for (int t = 0; t < 16; ++t) { float v = (t == i) ? 1.0f : 0.0f;
#pragma unroll
                for (int j = 0; j < t; ++j) v -= HM[R1_LB + t * R1_TS + j] * tr[j];
                tr[t] = v; HM[R1_TM + t * R1_TS + i] = v; } }
    }
    __syncthreads();
    {
        const f32x4 d1 = mm4(R1_ROWM(R1_TM, i), R1_COLT(R1_KAPT, 16 * wl + i), z4), d2 = mm4(R1_ROWM(R1_TM, i), R1_COLT(R1_LKVT, 16 * wl + i), z4);
        *(LAS f32x4*)(HM + R1_TKT + (16 * wl + i) * R1_TS + 4 * g) = d1; *(LAS f32x4*)(HM + R1_W1T + (16 * wl + i) * R1_TS + 4 * g) = d2;
    }
    __syncthreads();
    {
        const size_t cid = ((size_t)(b * 16 + h) * 128 + cp * 2 + hf);
        const size_t mrow = (size_t)b * TP + cp * 32 + hf * 16;
        {
            const f32x4 d1 = mm4(R1_COLT(R1_VVT, 16 * wl + i), R1_ROWM(R1_MRK, i), z4), d2 = mm4(R1_COLT(R1_W1T, 16 * wl + i), R1_ROWM(R1_MRB, i), z4);
            if (R1O_MASK & 1) *(f32x4*)((float*)(A.ws + WS_OB) + (mrow + i) * 1024 + h * 64 + 16 * wl + 4 * g) = d1 - d2;
        }
        if (wl < 2) {
            f32x4 q[2];
#pragma unroll
            for (int c2 = 0; c2 < 2; ++c2) { const int a = 2 * wl + c2; const f32x4 d = mm4(R1_COLT(R1_TKT, 16 * a + i), R1_ROWM(R1_MRB, i), z4);
                q[c2] = *(const LAS f32x4*)(HM + R1_RT + i * R1_RS + 16 * a + 4 * g) - d; }
            if (R1O_MASK & 2) *(v4u*)((bf16*)(A.ws + WS_RQ) + ((cid * 2 + wl) * 64 + lane) * 8) = pack8(q[0], q[1]);
        }
        const float gci = HM[R1_GC + 16 * wl + i];
#pragma unroll
        for (int kp2 = 0; kp2 < 2; ++kp2) {
            f32x4 q[2];
#pragma unroll
            for (int c2 = 0; c2 < 2; ++c2) { const int a = 2 * kp2 + c2; const f32x4 d = mm4(R1_COLT(R1_TKT, 16 * a + i), R1_COLT(R1_BTT, 16 * wl + i), z4);
#pragma unroll
                for (int r = 0; r < 4; ++r) q[c2][r] = (((a == wl && 4 * g + r == i) ? 1.0f : 0.0f) - d[r]) * gci; }
            if (R1O_MASK & 4) *(v4u*)((bf16*)(A.ws + WS_PST) + (((cid * 4 + wl) * 2 + kp2) * 64 + lane) * 8) = pack8(q[0], q[1]);
        }
        const f32x4 gcr = *(const LAS f32x4*)(HM + R1_GC + 16 * wl + 4 * g);
#pragma unroll
        for (int a = 0; a < 4; ++a) {
            const f32x4 d1 = mm4(R1_COLT(R1_KTT, 16 * wl + i), R1_COLT(R1_VVT, 16 * a + i), z4), d2 = mm4(R1_COLT(R1_BTT, 16 * wl + i), R1_COLT(R1_W1T, 16 * a + i), z4);
            if (R1O_MASK & 8) *(f32x4*)((float*)(A.ws + WS_QST) + (((cid * 4 + a) * 4 + wl) * 64 + lane) * 4) = (d1 - d2) * gcr;
        }
    }
#undef R1_ROWN
#undef R1_COLT
#undef R1_ROWM
    __syncthreads();
}

template <int CTRL> __device__ __forceinline__ float dpp1(float v) {
    return __builtin_bit_cast(float, __builtin_amdgcn_update_dpp(0x3f800000, __builtin_bit_cast(int, v), CTRL, 0xf, 0xf, false)); }
__device__ __forceinline__ f32x4 mmr(const f32x4& av, const f32x4& bv, f32x4 acc) {
#pragma unroll
    for (int s = 0; s < 4; ++s) acc = __builtin_amdgcn_mfma_f32_16x16x4f32(av[s], bv[s], acc, 0, 0, 0);
    return acc;
}
typedef short bf16x4_ __attribute__((ext_vector_type(4)));
__device__ __forceinline__ bf16x4_ tobf4(const f32x4& v) { v2u w; w.x = cvt_pk_bf16(v[0], v[1]); w.y = cvt_pk_bf16(v[2], v[3]); return __builtin_bit_cast(bf16x4_, w); }
constexpr int R1W_LDS = 19200;
constexpr int R1W_GC = 4352, R1W_PARS = 4416;
struct R1WRaw { v2u pr[4], pk[4], pv[4], qr[4], qk[4], qv[4], wd[4], wa[4]; };
__device__ __forceinline__ f32x4 cv4(const v2u w) { return (f32x4){bf2f(w.x & 0xffffu), bf2f(w.x >> 16), bf2f(w.y & 0xffffu), bf2f(w.y >> 16)}; }
__device__ __forceinline__ void rwkv_r1w_load(const Args& A, int lane, int b, int h, int c, R1WRaw& r) {
    const bf16* PROJ = (const bf16*)(A.ws + WS_PROJ); const float* WAG = (const float*)(A.ws + WS_WAG);
    const int g = lane >> 4, i = lane & 15, tabs = c * 16 + i, hc = h * 64 + 4 * g; const size_t m = (size_t)b * TP + tabs, mq = tabs > 0 ? m - 1 : m;
#pragma unroll
    for (int a = 0; a < 4; ++a) { r.pr[a] = *(const v2u*)(PROJ + m * NEV + hc + 16 * a); r.pk[a] = *(const v2u*)(PROJ + m * NEV + 1024 + hc + 16 * a); r.pv[a] = *(const v2u*)(PROJ + m * NEV + 2048 + hc + 16 * a);
        r.qr[a] = *(const v2u*)(PROJ + mq * NEV + hc + 16 * a); r.qk[a] = *(const v2u*)(PROJ + mq * NEV + 1024 + hc + 16 * a); r.qv[a] = *(const v2u*)(PROJ + mq * NEV + 2048 + hc + 16 * a);
        r.wd[a] = *(const v2u*)((const bf16*)WAG + m * NLORA + hc + 16 * a); r.wa[a] = *(const v2u*)((const bf16*)WAG + m * NLORA + 1024 + hc + 16 * a); }
}
__device__ __forceinline__ void rwkv_r1w_unit(const Args& A, Frame& F, int e, int b, int h, int c, const R1WRaw& raw, bool has_next, int nb, int nc, R1WRaw& nraw) {
    const int lane = F.lane, g = lane >> 4, i = lane & 15;
    LAS float* WL = (LAS float*)(F.lds + __builtin_amdgcn_readfirstlane(F.wave) * R1W_LDS);
    float* WAG = (float*)(A.ws + WS_WAG);
    const int tabs = c * 16 + i, hc = h * 64 + 4 * g; const size_t m = (size_t)b * TP + tabs;
    const f32x4 z4 = {0.f, 0.f, 0.f, 0.f};
    const LAS float* PS = WL + R1W_PARS + 4 * g;
    f32x4 zr[4], zk[4], zv[4], wd[4], wa[4];
#pragma unroll
    for (int a = 0; a < 4; ++a) {
        const f32x4 pr = cv4(raw.pr[a]), pk = cv4(raw.pk[a]), pv = cv4(raw.pv[a]);
        f32x4 qr = cv4(raw.qr[a]), qk = cv4(raw.qk[a]), qv = cv4(raw.qv[a]);
        if (tabs == 0) { qr = z4; qk = z4; qv = z4; }
        zr[a] = pr + (qr - pr) * *(const LAS f32x4*)(PS + 16 * a); zk[a] = pk + (qk - pk) * *(const LAS f32x4*)(PS + 64 + 16 * a); zv[a] = pv + (qv - pv) * *(const LAS f32x4*)(PS + 128 + 16 * a);
        { const f32x4 lw = cv4(raw.wd[a]); wd[a] = (f32x4){__expf(lw[0]), __expf(lw[1]), __expf(lw[2]), __expf(lw[3])}; } wa[a] = cv4(raw.wa[a]);
    }
    f32x4 rt[4], kap[4], bt[4], kt[4], gcr[4];
    {
        f32x4 kk[4], kp[4]; float ss = 0.f, bon = 0.f;
#pragma unroll
        for (int a = 0; a < 4; ++a) { kk[a] = zk[a] * *(const LAS f32x4*)(PS + 192 + 16 * a); ss += (kk[a][0] * kk[a][0] + kk[a][1] * kk[a][1]) + (kk[a][2] * kk[a][2] + kk[a][3] * kk[a][3]); }
        ss += __shfl_xor(ss, 16); ss += __shfl_xor(ss, 32);
        const float rn = 1.0f / fmaxf(sqrtf(ss), 1e-12f);
#pragma unroll
        for (int a = 0; a < 4; ++a) { kk[a] = kk[a] * rn; kp[a] = zk[a] * (1.0f + (wa[a] - 1.0f) * *(const LAS f32x4*)(PS + 256 + 16 * a));
            const f32x4 rk = *(const LAS f32x4*)(PS + 320 + 16 * a); const f32x4 t3 = zr[a] * kp[a] * rk; bon += (t3[0] + t3[1]) + (t3[2] + t3[3]); }
        bon += __shfl_xor(bon, 16); bon += __shfl_xor(bon, 32);
        if (R1W_MASK & 16)
#pragma unroll
        for (int a = 0; a < 4; ++a) st4bf((bf16*)WAG + m * NLORA + hc + 16 * a, zv[a] * bon);
#pragma unroll
        for (int a = 0; a < 4; ++a) {
            f32x4 gm, gp;
#if R1W_SHFL_SCAN
            gm = (f32x4){1.f, 1.f, 1.f, 1.f}; gp = gm;
            *(LAS f32x4*)(WL + i * 68 + 16 * a + 4 * g) = wd[a];
#pragma unroll
            for (int j = 0; j < 16; ++j) { const f32x4 wv = *(const LAS f32x4*)(WL + j * 68 + 16 * a + 4 * g); if (j <= i) gm *= wv; if (j < i) gp *= wv; }
#else
#pragma unroll
            for (int r = 0; r < 4; ++r) { float x = wd[a][r]; x *= dpp1<0x111>(x); x *= dpp1<0x112>(x); x *= dpp1<0x114>(x); x *= dpp1<0x118>(x); gm[r] = x; gp[r] = dpp1<0x111>(x); }
#endif
            f32x4 inv;
#pragma unroll
            for (int r = 0; r < 4; ++r) inv[r] = __builtin_amdgcn_rcpf(gm[r]);
            rt[a] = zr[a] * gm; kap[a] = kk[a] * gp; bt[a] = kk[a] * wa[a] * inv; kt[a] = kp[a] * inv;
            if (i == 15) *(LAS f32x4*)(WL + R1W_GC + 16 * a + 4 * g) = gm;
        }
    }
#pragma unroll
    for (int a = 0; a < 4; ++a) { LAS float* pw = WL + i * 68 + 16 * a + 4 * g;
        *(LAS f32x4*)(pw) = zv[a]; *(LAS f32x4*)(pw + 1088) = kap[a]; *(LAS f32x4*)(pw + 2176) = bt[a]; *(LAS f32x4*)(pw + 3264) = kt[a]; }
    f32x4 Lb = z4, Lk = z4, Mrb = z4, Mrk = z4, LbD = z4;
#pragma unroll
    for (int a = 0; a < 4; ++a) { LbD = mmr(kap[a], bt[a], LbD); Lb = mmr(bt[a], kap[a], Lb); Lk = mmr(kt[a], kap[a], Lk); Mrb = mmr(bt[a], rt[a], Mrb); Mrk = mmr(kt[a], rt[a], Mrk); }
#pragma unroll
    for (int r = 0; r < 4; ++r) { const int sc = 4 * g + r; if (!(sc < i)) { Lb[r] = 0.f; Lk[r] = 0.f; } if (!(sc <= i)) { Mrb[r] = 0.f; Mrk[r] = 0.f; } if (!(i < sc)) LbD[r] = 0.f; }
    f32x4 VT[4], KAPT[4], BTT[4], KTT[4]; float gci[4];
#pragma unroll
    for (int a = 0; a < 4; ++a) {
#pragma unroll
        for (int s = 0; s < 4; ++s) { const LAS float* pr_ = WL + (4 * g + s) * 68 + 16 * a + i; VT[a][s] = pr_[0]; KAPT[a][s] = pr_[1088]; BTT[a][s] = pr_[2176]; KTT[a][s] = pr_[3264]; }
        gci[a] = WL[R1W_GC + 16 * a + i]; gcr[a] = *(const LAS f32x4*)(WL + R1W_GC + 16 * a + 4 * g);
    }
    f32x4 LKVT[4];
#pragma unroll
    for (int a = 0; a < 4; ++a) LKVT[a] = mmr(Lk, VT[a], z4);
    f32x4 Trow;
    {
        f32x4 idm;
#pragma unroll
        for (int r = 0; r < 4; ++r) idm[r] = (4 * g + r == i) ? 1.0f : 0.0f;
        const f32x4 L2D = mmr(Lb, LbD, z4), L2r = mmr(LbD, Lb, z4);
        const f32x4 L4D = mmr(L2r, L2D, z4), L4r = mmr(L2D, L2r, z4);
        const f32x4 L8D = mmr(L4r, L4D, z4);
        const f32x4 X1 = mmr(L2D + idm, idm - Lb, z4), X2 = mmr(L4D + idm, X1, z4);
        Trow = mmr(L8D + idm, X2, z4);
    }
    f32x4 TKT[4], W1T[4];
#pragma unroll
    for (int a = 0; a < 4; ++a) { TKT[a] = mmr(Trow, KAPT[a], z4); W1T[a] = mmr(Trow, LKVT[a], z4); }
    __builtin_amdgcn_sched_barrier(0);
    if (has_next) rwkv_r1w_load(A, lane, nb, h, nc, nraw);
    __builtin_amdgcn_sched_barrier(0);
    const size_t cid = (size_t)(b * 16 + h) * 128 + c; const size_t mrow = (size_t)b * TP + c * 16;
#pragma unroll
    for (int wl = 0; wl < 4; ++wl) {
        const f32x4 d1 = mmr(VT[wl], Mrk, z4), d2 = mmr(W1T[wl], Mrb, z4);
        if (R1W_MASK & 1) st4bf((bf16*)(A.ws + WS_OB) + (mrow + i) * 1024 + h * 64 + 16 * wl + 4 * g, d1 - d2);
    }
#pragma unroll
    for (int w2 = 0; w2 < 2; ++w2) {
        const f32x4 q0 = rt[2 * w2] - mmr(TKT[2 * w2], Mrb, z4), q1 = rt[2 * w2 + 1] - mmr(TKT[2 * w2 + 1], Mrb, z4);
        if (R1W_MASK & 2) *(v4u*)((bf16*)(A.ws + WS_RQ) + ((cid * 2 + w2) * 64 + lane) * 8) = pack8(q0, q1);
    }
    bf16x4_ TKb[4], BTb[4], nBTb[4], KTb[4], VTb[4], W1b[4];
#pragma unroll
    for (int a = 0; a < 4; ++a) { TKb[a] = tobf4(TKT[a]); BTb[a] = tobf4(BTT[a]); nBTb[a] = tobf4(z4 - BTT[a]); KTb[a] = tobf4(KTT[a]); VTb[a] = tobf4(VT[a]); W1b[a] = tobf4(W1T[a]); }
#pragma unroll
    for (int wl = 0; wl < 4; ++wl) {
#pragma unroll
        for (int kp2 = 0; kp2 < 2; ++kp2) {
            f32x4 q[2];
#pragma unroll
            for (int c2 = 0; c2 < 2; ++c2) { const int a = 2 * kp2 + c2; const f32x4 d = __builtin_amdgcn_mfma_f32_16x16x16bf16_1k(TKb[a], BTb[wl], z4, 0, 0, 0);
#pragma unroll
                for (int r = 0; r < 4; ++r) q[c2][r] = (((a == wl && 4 * g + r == i) ? 1.0f : 0.0f) - d[r]) * gci[wl]; }
            if (R1W_MASK & 4) *(v4u*)((bf16*)(A.ws + WS_PST) + (((cid * 4 + wl) * 2 + kp2) * 64 + lane) * 8) = pack8(q[0], q[1]);
        }
#pragma unroll
        for (int a = 0; a < 4; ++a) {
            f32x4 d = __builtin_amdgcn_mfma_f32_16x16x16bf16_1k(KTb[wl], VTb[a], z4, 0, 0, 0);
            d = __builtin_amdgcn_mfma_f32_16x16x16bf16_1k(nBTb[wl], W1b[a], d, 0, 0, 0);
            if (R1W_MASK & 8) { const f32x4 qv_ = d * gcr[wl]; v2u qp_; qp_.x = cvt_pk_bf16(qv_[0], qv_[1]); qp_.y = cvt_pk_bf16(qv_[2], qv_[3]);
                *(v2u*)((bf16*)(A.ws + WS_QST) + (((cid * 4 + a) * 4 + wl) * 64 + lane) * 4) = qp_; }
        }
    }
}
__device__ __forceinline__ void rwkv_r1w_phase(const Args& A, Frame& F, int e) {
    const int NGW = F.G * NWAVES, gw = F.blk * NWAVES + F.wave, NU = BP * 16 * 128;
    if (gw >= NU) return;
    const int h = (gw >> 7) & 15;
    {
        LAS float* WL = (LAS float*)(F.lds + __builtin_amdgcn_readfirstlane(F.wave) * R1W_LDS);
        const float* mu = PARP(PAR_MU) + (size_t)e * PRW; const int hl = h * 64 + F.lane;
        const float p0 = mu[hl], p1 = mu[1024 + hl], p2 = mu[2048 + hl], p3 = PARP(PAR_KK)[e * 1024 + hl], p4 = PARP(PAR_KA)[e * 1024 + hl], p5 = PARP(PAR_RK)[e * 1024 + hl];
        __builtin_amdgcn_sched_barrier(0);
        WL[R1W_PARS + F.lane] = p0; WL[R1W_PARS + 64 + F.lane] = p1; WL[R1W_PARS + 128 + F.lane] = p2; WL[R1W_PARS + 192 + F.lane] = p3; WL[R1W_PARS + 256 + F.lane] = p4; WL[R1W_PARS + 320 + F.lane] = p5;
    }
    R1WRaw raw = {}, nraw = {};
    rwkv_r1w_load(A, F.lane, gw >> 11, h, gw & 127, raw);
#pragma unroll 1
    for (int u = gw; u < NU; u += NGW) { asm volatile("" : "+v"(F.lane)); const int un = u + NGW;
        rwkv_r1w_unit(A, F, e, u >> 11, h, u & 127, raw, un < NU, un >> 11, un & 127, nraw); raw = nraw; }
}

#ifndef R2_PF
#define R2_PF 0
#define R2_PF_AHEAD 6
#endif
#if R2_PF
#define R2_PROG(c_) do { if (F.tid == 0) prog[0] = (c_); } while (0)
#else
#define R2_PROG(c_) do { } while (0)
#endif
__device__ __forceinline__ void rwkv_r2_head(const Args& A, Frame& F, int e, int b, int h) {
    typedef short bf16x8 __attribute__((ext_vector_type(8)));
    const int w = F.wave, lane = F.lane, g = lane >> 4, i = lane & 15;
    const size_t cid0 = (size_t)(b * 16 + h) * 128;
    const bf16* PST = (const bf16*)(A.ws + WS_PST); const float* QST = (const float*)(A.ws + WS_QST); const bf16* RQS = (const bf16*)(A.ws + WS_RQ); float* OB = (float*)(A.ws + WS_OB);
#if R2_PF
    LAS volatile int* prog = (LAS volatile int*)(F.lds + 4096);
    if (F.tid == 0) prog[0] = 0;
    __syncthreads();
    if (F.wave >= 4) {
        const int pl = (F.wave - 4) * 64 + lane; unsigned sink = 0;
        const char* base; size_t stride;
        if (pl < 64) { base = (const char*)PST + cid0 * 8192 + pl * 128; stride = 8192; }
        else if (pl < 80) { base = (const char*)RQS + cid0 * 2048 + (pl - 64) * 128; stride = 2048; }
        else if (pl < 208) { base = (const char*)QST + cid0 * 16384 + (pl - 80) * 128; stride = 16384; }
        else { const int r = ((pl - 208) >> 1) & 15, hf = (pl - 208) & 1; base = (const char*)OB + (((size_t)b * TP + r) * 1024 + h * 64) * 4 + hf * 128; stride = 65536; }
#pragma unroll 1
        for (int c0 = 0; c0 < 128; c0 += 8) {
            while (prog[0] + R2_PF_AHEAD < c0) __builtin_amdgcn_s_sleep(8);
            if (pl < 240) { unsigned v[8];
#pragma unroll
                for (int q = 0; q < 8; ++q) v[q] = *(const unsigned*)(base + (size_t)(c0 + q) * stride);
#pragma unroll
                for (int q = 0; q < 8; ++q) sink += v[q]; }
        }
        if (sink == 0x9e3779b9u) prog[1] = (int)sink;
        return;
    }
#else
    if (F.wave >= 4) return;
#endif
    f32x4 S[4];
#pragma unroll
    for (int k = 0; k < 4; ++k) S[k] = (f32x4){0.f, 0.f, 0.f, 0.f};
    struct R2Set { v4u P[4][2], RQ[2]; v2u Q[4], O; };
    R2Set s0 = {}, s1 = {}, s2 = {};
    float* OB2 = (float*)(A.ws + WS_OB2);
#define R2_LOAD(S_, c_) do { const size_t cid_ = cid0 + (c_); \
        _Pragma("unroll") for (int kb_ = 0; kb_ < 4; ++kb_) { _Pragma("unroll") for (int kp_ = 0; kp_ < 2; ++kp_) S_.P[kb_][kp_] = *(const v4u*)(PST + (((cid_ * 4 + kb_) * 2 + kp_) * 64 + lane) * 8); \
            S_.Q[kb_] = *(const v2u*)((const bf16*)QST + (((cid_ * 4 + w) * 4 + kb_) * 64 + lane) * 4); } \
        _Pragma("unroll") for (int kp_ = 0; kp_ < 2; ++kp_) S_.RQ[kp_] = *(const v4u*)(RQS + ((cid_ * 2 + kp_) * 64 + lane) * 8); \
        S_.O = *(const v2u*)((const bf16*)OB + ((size_t)b * TP + (c_) * 16 + i) * 1024 + h * 64 + 16 * w + 4 * g); } while (0)
#define R2_BODY(c_, CUR, NX2) do { R2_PROG(c_); if ((c_) + 2 < 128) R2_LOAD(NX2, (c_) + 2); \
        const v4u s0_ = pack8(S[0], S[1]), s1_ = pack8(S[2], S[3]); \
        const bf16x8 sp0 = __builtin_bit_cast(bf16x8, s0_), sp1 = __builtin_bit_cast(bf16x8, s1_); \
        f32x4 Oc = __builtin_amdgcn_mfma_f32_16x16x32_bf16(sp0, __builtin_bit_cast(bf16x8, CUR.RQ[0]), cv4(CUR.O), 0, 0, 0); \
        Oc = __builtin_amdgcn_mfma_f32_16x16x32_bf16(sp1, __builtin_bit_cast(bf16x8, CUR.RQ[1]), Oc, 0, 0, 0); \
        st4bf((bf16*)OB2 + ((size_t)b * TP + (c_) * 16 + i) * 1024 + h * 64 + 16 * w + 4 * g, Oc); \
        _Pragma("unroll") for (int kb = 0; kb < 4; ++kb) { f32x4 n = cv4(CUR.Q[kb]); \
            n = __builtin_amdgcn_mfma_f32_16x16x32_bf16(__builtin_bit_cast(bf16x8, CUR.P[kb][0]), sp0, n, 0, 0, 0); \
            n = __builtin_amdgcn_mfma_f32_16x16x32_bf16(__builtin_bit_cast(bf16x8, CUR.P[kb][1]), sp1, n, 0, 0, 0); S[kb] = n; } } while (0)
    R2_LOAD(s0, 0); R2_LOAD(s1, 1);
#pragma unroll 1
    for (int c = 0; c < 126; c += 3) { R2_BODY(c, s0, s2); R2_BODY(c + 1, s1, s0); R2_BODY(c + 2, s2, s1); }
    R2_BODY(126, s0, s2); R2_BODY(127, s1, s0);
#undef R2_BODY
#undef R2_LOAD
    float* so = AOUT + O_PRWKV + ((size_t)(b * 2 + e) * 16 + h) * 4096;
#pragma unroll
    for (int kb = 0; kb < 4; ++kb) *(f32x4*)(so + (16 * w + i) * 64 + 16 * kb + 4 * g) = S[kb];
}

struct R3Raw { v2u o4, bv, g4; };
__device__ __forceinline__ void rwkv_r3_load(const Args& A, Frame& F, int b, int h, int cp, R3Raw& r) {
    const float* WAG = (const float*)(A.ws + WS_WAG);
    const int tt = F.tid >> 4, cg = F.tid & 15, hc = h * 64 + 4 * cg; const size_t m = (size_t)b * TP + cp * 32 + tt;
    r.o4 = *(const v2u*)((const bf16*)(A.ws + WS_OB2) + m * 1024 + hc); r.bv = *(const v2u*)((const bf16*)WAG + m * NLORA + hc); r.g4 = *(const v2u*)((const bf16*)WAG + m * NLORA + 2048 + hc);
}
__device__ __forceinline__ void rwkv_r3_finish(const Args& A, Frame& F, int e, int b, int h, int cp, const R3Raw& r) {
    bf16* YIN = (bf16*)(A.ws + WS_YIN);
    const int tt = F.tid >> 4, cg = F.tid & 15, hc = h * 64 + 4 * cg; const size_t m = (size_t)b * TP + cp * 32 + tt;
    const f32x4 o4 = cv4(r.o4);
    const float mean = red16((o4[0] + o4[1]) + (o4[2] + o4[3])) * (1.0f / 64.0f);
    const f32x4 d = o4 - mean;
    const float var = red16((d[0] * d[0] + d[1] * d[1]) + (d[2] * d[2] + d[3] * d[3])) * (1.0f / 64.0f);
    const float rs = 1.0f / sqrtf(var + 64e-5f);
    const f32x4 on = d * rs * ld4(PARP(PAR_LNW) + e * 1024 + hc) + ld4(PARP(PAR_LNB) + e * 1024 + hc) + cv4(r.bv);
    st4bf(YIN + m * D + hc, on * cv4(r.g4));
}

__device__ __forceinline__ void rwkv_sample8(const Args& A, Frame& F, int e, int u8) {
    const int tid = F.tid, hi = tid >> 4, lo = tid & 15, lane = F.lane, wv = F.wave;
    const bf16* PROJ = (const bf16*)(A.ws + WS_PROJ); const float* WAG = (const float*)(A.ws + WS_WAG); bf16* YIN = (bf16*)(A.ws + WS_YIN);
    LAS float* cb = (LAS float*)F.lds; LAS float* ob = cb + 32 * 384;
    const int bs = u8 >> 1, hbase = (u8 & 1) * 8;
    const int hw = hbase + wv; const size_t sidx = ((size_t)(bs * 2 + e) * 16 + hw) * 4096 + lane * 64;
    f32x4 S[16];
#pragma unroll
    for (int q = 0; q < 16; ++q) S[q] = ld4(A.in[3] + sidx + 4 * q);
    {
        const int j = hi >> 2, t = hi & 3, h = hbase + j, hc = h * 64 + 4 * lo; const size_t m = (size_t)(MP + bs * TS + t);
        const float* mu = PARP(PAR_MU) + (size_t)e * PRW;
        const f32x4 pr = ldp4(PROJ + m * NEV + hc), pk = ldp4(PROJ + m * NEV + 1024 + hc), pv = ldp4(PROJ + m * NEV + 2048 + hc);
        f32x4 qr, qk, qv;
        if (t > 0) { qr = ldp4(PROJ + (m - 1) * NEV + hc); qk = ldp4(PROJ + (m - 1) * NEV + 1024 + hc); qv = ldp4(PROJ + (m - 1) * NEV + 2048 + hc); }
        else { const float* sh = A.in[2] + (size_t)(bs * 2 + e) * PRW; qr = ld4(sh + hc); qk = ld4(sh + 1024 + hc); qv = ld4(sh + 2048 + hc); }
        const f32x4 lw_ = ldp4((const bf16*)WAG + m * NLORA + hc), wd = {__expf(lw_[0]), __expf(lw_[1]), __expf(lw_[2]), __expf(lw_[3])}, wa = ldp4((const bf16*)WAG + m * NLORA + 1024 + hc);
        const f32x4 zr = pr + (qr - pr) * ld4(mu + hc), zk = pk + (qk - pk) * ld4(mu + 1024 + hc), zv = pv + (qv - pv) * ld4(mu + 2048 + hc);
        f32x4 kk = zk * ld4(PARP(PAR_KK) + e * 1024 + hc);
        const float ss = red16((kk[0] * kk[0] + kk[1] * kk[1]) + (kk[2] * kk[2] + kk[3] * kk[3]));
        kk = kk * (1.0f / fmaxf(sqrtf(ss), 1e-12f));
        const f32x4 kp = zk * (1.0f + (wa - 1.0f) * ld4(PARP(PAR_KA) + e * 1024 + hc)), bb = kk * wa;
        LAS float* p = cb + hi * 384 + 4 * lo;
        *(LAS f32x4*)(p) = zr; *(LAS f32x4*)(p + 64) = wd; *(LAS f32x4*)(p + 128) = kp; *(LAS f32x4*)(p + 192) = kk; *(LAS f32x4*)(p + 256) = bb; *(LAS f32x4*)(p + 320) = zv;
    }
    __syncthreads();
#pragma unroll 1
    for (int t = 0; t < 4; ++t) {
        const LAS float* p = cb + (wv * 4 + t) * 384; const float vv = p[320 + lane];
        f32x4 a4 = {0.f, 0.f, 0.f, 0.f};
#pragma unroll
        for (int q = 0; q < 16; ++q) a4 += S[q] * *(const LAS f32x4*)(p + 192 + 4 * q);
        const float sa = -((a4[0] + a4[1]) + (a4[2] + a4[3]));
        f32x4 o4 = {0.f, 0.f, 0.f, 0.f};
#pragma unroll
        for (int q = 0; q < 16; ++q) { S[q] = S[q] * *(const LAS f32x4*)(p + 64 + 4 * q) + *(const LAS f32x4*)(p + 256 + 4 * q) * sa + *(const LAS f32x4*)(p + 128 + 4 * q) * vv; o4 += S[q] * *(const LAS f32x4*)(p + 4 * q); }
        ob[(wv * 4 + t) * 64 + lane] = (o4[0] + o4[1]) + (o4[2] + o4[3]);
    }
    {
        float* so = AOUT + O_SRWKV + sidx;
#pragma unroll
        for (int q = 0; q < 16; ++q) *(f32x4*)(so + 4 * q) = S[q];
    }
    __syncthreads();
    {
        const int j = hi >> 2, t = hi & 3, h = hbase + j, hc = h * 64 + 4 * lo; const size_t m = (size_t)(MP + bs * TS + t);
        const f32x4 o4 = *(const LAS f32x4*)(ob + hi * 64 + 4 * lo);
        const float mean = red16((o4[0] + o4[1]) + (o4[2] + o4[3])) * (1.0f / 64.0f);
        const f32x4 d = o4 - mean;
        const float var = red16((d[0] * d[0] + d[1] * d[1]) + (d[2] * d[2] + d[3] * d[3])) * (1.0f / 64.0f);
        const float rs = 1.0f / sqrtf(var + 64e-5f);
        const LAS float* p = cb + hi * 384 + 4 * lo;
        const f32x4 r4 = *(const LAS f32x4*)(p), kp4 = *(const LAS f32x4*)(p + 128), v4 = *(const LAS f32x4*)(p + 320);
        const f32x4 rk = ld4(PARP(PAR_RK) + e * 1024 + hc);
        const float bonus = red16((r4[0] * kp4[0] * rk[0] + r4[1] * kp4[1] * rk[1]) + (r4[2] * kp4[2] * rk[2] + r4[3] * kp4[3] * rk[3]));
        const f32x4 on = d * rs * ld4(PARP(PAR_LNW) + e * 1024 + hc) + ld4(PARP(PAR_LNB) + e * 1024 + hc) + v4 * bonus;
        st4bf(YIN + m * D + hc, on * ldp4((const bf16*)WAG + m * NLORA + 2048 + hc));
    }
    __syncthreads();
}

constexpr int NPH = 61;
#ifndef MK_FUSED
#define MK_FUSED 1
#endif

__global__ void __launch_bounds__(NTHR, 2) mega(Args A) {
    extern __shared__ __attribute__((aligned(16))) unsigned char lds_raw[];
    Frame F; F.lds = (LAS unsigned char*)lds_raw; F.tid = threadIdx.x; F.lane = F.tid & 63; F.wave = __builtin_amdgcn_readfirstlane(F.tid >> 6); F.G = gridDim.x; F.blk = blockIdx.x;
    volatile LAS unsigned* MISC = (volatile LAS unsigned*)(F.lds + MISC_OFF);
    if (F.tid < 32) MISC[F.tid] = 0u;
    __syncthreads();
    const int lo = A.ph_lo, hi = A.ph_hi;
    XcdBarrier bar; bar.bar = (unsigned*)(A.ws + WS_CTL) + CW_BAR + A.li * XCD_BAR_WORDS; bar.x = 0; bar.st = nullptr;
    if (hi - lo > 1) bar = xcd_barrier_post(bar.bar, MISC + 8);
#ifndef SEL_MASK
#define SEL_MASK 0xFFFFFFFFu
#endif
#ifndef REP_MASK
#define REP_MASK 0u
#endif
#ifndef REP_N
#define REP_N 2
#endif
#ifndef FOLD_O4
#define FOLD_O4 1
#endif
#define SITE(n) ((SEL_MASK >> (n)) & 1u)
#define NREP(n) (((REP_MASK >> (n)) & 1u) ? REP_N : 1)
#define PH_BEGIN(n) if (ph >= lo && ph < hi) { asm volatile("" : "+v"(F.tid), "+v"(F.lane), "+s"(F.wave), "+s"(F.blk), "+s"(F.G), "+s"(A.ws), "+s"(A.out)); \
    if (SITE(n)) for (int rep_ = 0; rep_ < NREP(n); ++rep_) { if (rep_) xcd_barrier(bar);
#ifndef BAR_REP
#define BAR_REP 1
#endif
#define PH_END } if (ph + 1 < hi) for (int br_ = 0; br_ < BAR_REP; ++br_) xcd_barrier(bar); } ++ph;
    int ph = 0;
    PH_BEGIN(1) p0_prologue(A, F); PH_END
#pragma nounroll
    for (int l = 0; l < 4; ++l) {
        const int e = l >> 1; const bool even = !(l & 1);
#pragma nounroll
        for (int s = 0; s < 3; ++s) {
            if (s != 1) {
                const int mat = l * 2 + (s >> 1);
                PH_BEGIN(2) {
                    pg8::Gemm g{(const bf16*)(A.ws + WS_XN), (const bf16*)(A.ws + WS_WGU) + (size_t)mat * (SZ_WGU / 2), D, D}; pg8::StaticOrder S; S.init(M, 2 * FF, D, F.G, F.blk);
                    pg8::EpiSwiGLU E{(bf16*)(A.ws + WS_H), FF, (const float*)(A.ws + WS_RSTD)};
                    pg8::gemm_phase<pg8::EpiSwiGLU, pg8::StaticOrder, true, true>(F.lds, g, S, E);
                } PH_END
            } else if (even) {
                PH_BEGIN(3) {
                    pg8::Gemm g{(const bf16*)(A.ws + WS_XN), (const bf16*)(A.ws + WS_WEVIN) + (size_t)e * (SZ_WEVIN / 2), D, D}; pg8::StaticOrder S; S.init(M, NEV, D, F.G, F.blk);
                    pg8::EpiStoreBf16 E{(bf16*)(A.ws + WS_PROJ), NEV, (const float*)(A.ws + WS_RSTD)};
                    pg8::gemm_phase<pg8::EpiStoreBf16, pg8::StaticOrder, true, true>(F.lds, g, S, E);
                } PH_END
                PH_BEGIN(4) e2_prep(A, F, e); PH_END
                PH_BEGIN(5) {
                    pg8::Gemm g{(const bf16*)(A.ws + WS_LA), (const bf16*)(A.ws + WS_WLORA) + (size_t)e * NLORA * KLORA, KLORA, KLORA}; pg8::LoraOrder S; S.so.init(M, NLORA, KLORA, F.G, F.blk); { int nt4 = 4; asm volatile("" : "+s"(nt4)); S.nt = nt4; }
                    pg8::EpiLora E{(bf16*)(A.ws + WS_WAG), PARP(PAR_W0) + e * 1024, PARP(PAR_A0) + e * 1024};
                    pg8::gemm_phase<pg8::EpiLora, pg8::LoraOrder, true, true>(F.lds, g, S, E);
                } PH_END
#ifndef R1W
#define R1W 1
#endif
#if R1W
                PH_BEGIN(16) {
#if !R1O_MASK
                    rwkv_r1w_phase(A, F, e);
#endif
#if R1O_MASK
                    { R1Raw raw = {}, nraw = {}; if (F.blk < 4096) rwkv_r1_load(A, F, F.blk >> 10, (F.blk >> 6) & 15, F.blk & 63, raw);
                    for (int u = F.blk; u < 4096; u += F.G) { asm volatile("" : "+v"(F.tid), "+v"(F.lane), "+s"(F.wave), "+s"(A.ws)); const int un = u + F.G; if (un < 4096) rwkv_r1_load(A, F, un >> 10, (un >> 6) & 15, un & 63, nraw);
                        rwkv_r1_unit(A, F, e, u >> 10, (u >> 6) & 15, u & 63, raw); raw = nraw; } }
                    xcd_barrier(bar);
                    rwkv_r1w_phase(A, F, e);
#endif
                } PH_END
#else
                PH_BEGIN(16) { R1Raw raw = {}, nraw = {}; if (F.blk < 4096) rwkv_r1_load(A, F, F.blk >> 10, (F.blk >> 6) & 15, F.blk & 63, raw);
                    for (int u = F.blk; u < 4096; u += F.G) { asm volatile("" : "+v"(F.tid), "+v"(F.lane), "+s"(F.wave), "+s"(A.ws)); const int un = u + F.G; if (un < 4096) rwkv_r1_load(A, F, un >> 10, (un >> 6) & 15, un & 63, nraw);
                        rwkv_r1_unit(A, F, e, u >> 10, (u >> 6) & 15, u & 63, raw); raw = nraw; } } PH_END
#endif
                PH_BEGIN(6) {
#ifndef REP_E4A
#define REP_E4A 1
#define REP_E4B 1
#define REP_E4C 1
#define REP_E4D 1
#endif
#ifndef R2_TWICE
#define R2_TWICE 0
#endif
#ifndef R2_ONLY_FIRST_REP
#define R2_ONLY_FIRST_REP 0
#endif
                    if (F.blk < 64 && !(R2_ONLY_FIRST_REP && rep_ > 0)) { rwkv_r2_head(A, F, e, F.blk >> 4, F.blk & 15);
#if R2_TWICE
                        asm volatile("" : "+v"(F.tid), "+v"(F.lane), "+s"(F.wave)); rwkv_r2_head(A, F, e, F.blk >> 4, F.blk & 15);
#endif
                    }
                    {
                        unsigned* ctr = (unsigned*)(A.ws + WS_CTL) + 2048 + 64 * e + 16 * rep_;
                        unsigned nxt = 0;
                        if (F.tid == 0) nxt = __hip_atomic_fetch_add(ctr, 1u, __ATOMIC_RELAXED, __HIP_MEMORY_SCOPE_AGENT);
                        for (;;) {
                            asm volatile("" : "+v"(F.tid), "+v"(F.lane), "+s"(F.wave), "+s"(A.ws));
                            if (F.tid == 0) MISC[16] = nxt;
                            __syncthreads(); const int w = (int)MISC[16]; __syncthreads();
                            if (w >= 2304) break;
                            if (F.tid == 0) nxt = __hip_atomic_fetch_add(ctr, 1u, __ATOMIC_RELAXED, __HIP_MEMORY_SCOPE_AGENT);
                            if (w < 1024) { for (int rq = 0; rq < REP_E4B; ++rq) hgrn_chunk_unit2(A, F, e, w >> 8, (w >> 5) & 7, w & 31); }
                            else if (w < 2048) { for (int rq = 0; rq < REP_E4C; ++rq) hgrn_sample_unit(A, F, e, (w - 1024) >> 3, w & 7); }
                            else rwkv_sample8(A, F, e, w - 2048);
                        }
                    }
                } PH_END
                PH_BEGIN(7) hgrn_state_scan(A, F, e); PH_END
                PH_BEGIN(8) { { HfRaw hr = {}, hn = {}; if (F.blk < 1024) hgrn_finish_load(A, F, F.blk >> 8, (F.blk >> 5) & 7, F.blk & 31, hr);
                    for (int w = F.blk; w < 1024; w += F.G) { asm volatile("" : "+v"(F.tid), "+v"(F.lane), "+s"(F.wave), "+s"(A.ws)); const int wn = w + F.G;
                        hgrn_finish_unit(A, F, e, w >> 8, (w >> 5) & 7, w & 31, hr, wn < 1024, wn >> 8, (wn >> 5) & 7, wn & 31, hn); hr = hn; } }
                    for (int u = F.blk; u < 4096; u += 4 * F.G) {
                        R3Raw r3[4] = {};
#pragma unroll
                        for (int q = 0; q < 4; ++q) { const int uq = u + q * F.G; if (uq < 4096) rwkv_r3_load(A, F, uq >> 10, (uq >> 6) & 15, uq & 63, r3[q]); }
#pragma unroll
                        for (int q = 0; q < 4; ++q) { const int uq = u + q * F.G; if (uq < 4096) rwkv_r3_finish(A, F, e, uq >> 10, (uq >> 6) & 15, uq & 63, r3[q]); }
                    } } PH_END
            } else {
                PH_BEGIN(9) {
                    pg8::Gemm g{(const bf16*)(A.ws + WS_XN), (const bf16*)(A.ws + WS_WODIN) + (size_t)e * (SZ_WODIN / 2), D, D}; pg8::OddInOrder S; S.init(F.G, F.blk);
                    pg8::EpiOddIn E{(bf16*)(A.ws + WS_GATE), (bf16*)(A.ws + WS_XB), (const float*)(A.ws + WS_RSTD), (bf16*)(A.ws + WS_OSLAB)};
                    pg8::gemm_phase<pg8::EpiOddIn, pg8::OddInOrder, true, true>(F.lds, g, S, E);
                } PH_END
                PH_BEGIN(10) o2_conv(A, F, e); PH_END
                PH_BEGIN(11) {
                    pg8::Gemm g{(const bf16*)(A.ws + WS_XCB), (const bf16*)(A.ws + WS_WLRU) + (size_t)e * 4096 * 256, 2048, 256}; int nt4 = 4; asm volatile("" : "+s"(nt4)); pg8::LruOrder S{F.G, F.blk, nt4};
                    pg8::EpiLru E{(const bf16*)(A.ws + WS_XCB), (bf16*)(A.ws + WS_LRA), (bf16*)(A.ws + WS_LRB), PARP(PAR_BA) + e * 2048, PARP(PAR_BX) + e * 2048, PARP(PAR_LAM) + e * 2048};
                    pg8::gemm_phase<pg8::EpiLru, pg8::LruOrder, true, true>(F.lds, g, S, E);
#if FOLD_O4
                    o4_tail(A, F);
#endif
                } PH_END
#if FOLD_O4
                PH_BEGIN(13) o5_lru_scan(A, F, e); PH_END
                ph += 3;
#else
                PH_BEGIN(12) o4_lru_chunks(A, F); PH_END
                PH_BEGIN(13) o5_lru_scan(A, F, e); PH_END
                ph += 2;
#endif
            }
            PH_BEGIN(14) {
                const bf16* Ap; const bf16* Bp; int K; float scale;
                if (s != 1) { Ap = (const bf16*)(A.ws + WS_H); K = FF; scale = 0.5f; Bp = (const bf16*)(A.ws + WS_WDN) + (size_t)(l * 2 + (s >> 1)) * (SZ_WDN / 2); }
                else { Ap = (const bf16*)(A.ws + WS_YIN); K = D; scale = 1.0f; Bp = (const bf16*)(A.ws + (even ? WS_WEVOUT : WS_WODOUT)) + (size_t)e * (SZ_WSQ / 2); }
                pg8::Gemm g{Ap, Bp, K, K}; pg8::ResidOrder S; S.init(K, F.G, F.blk);
                const bool fin = (s == 2 && l == 3);
                const float* gnext = s == 0 ? PARP(PAR_MIXN) + l * D : (s == 1 ? PARP(PAR_FFN2N) + l * D : PARP(PAR_FFN1N) + ((l + 1) & 3) * D);
                pg8::EpiResid E{(float*)(A.ws + WS_X), D, scale / (float)(NREP(14) * EPI_REP), (float*)(A.ws + WS_SLAB), (bf16*)(A.ws + WS_XN), fin ? nullptr : gnext, (float*)(A.ws + WS_SSP)};
                pg8::gemm_phase<pg8::EpiResid, pg8::ResidOrder, true, true>(F.lds, g, S, E);
            } PH_END
            PH_BEGIN(15) {
                const float* gain = s == 0 ? PARP(PAR_MIXN) + l * D : (s == 1 ? PARP(PAR_FFN2N) + l * D : (l < 3 ? PARP(PAR_FFN1N) + (l + 1) * D : PARP(PAR_FINN)));
                const int K = s != 1 ? FF : D, PU = K / 128; const int sf = F.G == 256 ? ((PU / 2) < 16 ? (PU / 2) : 16) : 0;
                if (s == 2 && l == 3) norm_phase(A, F, gain, true, sf, (s != 1 ? 0.5f : 1.0f) / (float)NREP(15)); else rstd_phase(A, F, gain, sf, (s != 1 ? 0.5f : 1.0f) / (float)NREP(15));
            } PH_END
        }
    }
}

extern "C" void kernel_launch(void* const* d_in, const int* in_sizes, int n_in, void* d_out, int out_size, void* d_ws, size_t ws_size, hipStream_t stream) {
    static int grid = 0;
    if (grid == 0) {
        if (n_in != 39 || (size_t)out_size != O_END || ws_size < WS_END) { fprintf(stderr, "kernel_launch: unexpected shapes (n_in %d out %d ws %zu need %zu)\n", n_in, out_size, ws_size, (size_t)WS_END); grid = -1; return; }
        int dev = 0, cus = 0;
        if (hipGetDevice(&dev) != hipSuccess || hipDeviceGetAttribute(&cus, hipDeviceAttributeMultiprocessorCount, dev) != hipSuccess) { grid = -1; return; }
        if (hipFuncSetAttribute((const void*)mega, hipFuncAttributeMaxDynamicSharedMemorySize, LDS_BYTES) != hipSuccess) { fprintf(stderr, "kernel_launch: hipFuncSetAttribute failed\n"); grid = -1; return; }
        int per_cu = 0;
        if (hipOccupancyMaxActiveBlocksPerMultiprocessor(&per_cu, (const void*)mega, NTHR, LDS_BYTES) != hipSuccess || per_cu < 1) fprintf(stderr, "kernel_launch: occupancy query reports %d blocks per CU\n", per_cu);
        (void)hipGetLastError();
        grid = cus;
    }
    if (grid < 0) return;
    (void)hipMemsetAsync((char*)d_ws + WS_CTL, 0, CTL_ZERO_BYTES, stream);
    Args a{};
    for (int i = 0; i < 39; ++i) a.in[i] = (const float*)d_in[i];
    a.out = (GAS float*)d_out; a.ws = (GAS unsigned char*)d_ws; a.li = 0; a.pad = 0;
#if MK_FUSED
    a.ph_lo = 0; a.ph_hi = NPH;
    hipLaunchKernelGGL(mega, dim3(grid), dim3(NTHR), LDS_BYTES, stream, a);
#else
    for (int p = 0; p < NPH; ++p) {
        if (p >= 1 && (((p - 1) % 15) == 8 || ((p - 1) % 15) == 9) && (((p - 1) / 15) & 1)) continue;
        a.ph_lo = p; a.ph_hi = p + 1;
        hipLaunchKernelGGL(mega, dim3(grid), dim3(NTHR), LDS_BYTES, stream, a);
    }
#endif
}
```

```cpp
#include <hip/hip_runtime.h>
#include <cstdio>
#include <cstdint>

#ifndef EPI_REP
#define EPI_REP 1
#endif
constexpr int D = 2048, MP = 8192, MS = 512, M = MP + MS, FF = 5632;
constexpr int TP = 2048, BP = 4, TS = 4, BS = 128, NSEQ = BP + BS;
constexpr int RW = 1024, RH = 16, PRW = 3520, PEV = 7616, NEV = 7680;
constexpr int HGH = 8;
constexpr int NLORA = 3072, KLORA = 512;
constexpr int NWAVES = 8, NTHR = 512;

namespace pg8 {
#define PG8_LAS __attribute__((address_space(3)))
typedef unsigned short bf16_t;
typedef short bf16x8 __attribute__((ext_vector_type(8)));
typedef float f32x4 __attribute__((ext_vector_type(4)));
typedef float f32x2 __attribute__((ext_vector_type(2)));
typedef unsigned u32x4 __attribute__((ext_vector_type(4)));
typedef unsigned u32x2 __attribute__((ext_vector_type(2)));
constexpr int BM = 256, BK = 64, HALF = 128, HTB = HALF * BK * 2  , STAGE_BYTES = 8 * HTB, NXCD = 8, WGM = 8;

__host__ __device__ __forceinline__ int lds_byte(int r, int c) { const int st = (r >> 4) * 2 + (c >> 5), rr = r & 15, cc = c & 31, ob = rr * 64 + cc * 2; return st * 1024 + (ob ^ (((ob >> 9) & 1) << 5)); }
__host__ __device__ __forceinline__ void stage_rc(int b, int& R, int& C) { const int st = b / 1024, sb = b % 1024, swz = sb ^ (((sb >> 9) & 1) << 5); R = (st >> 1) * 16 + swz / 64; C = (st & 1) * 32 + (swz % 64) / 2; }
__host__ __device__ __forceinline__ int perm32(int rho) { const int n = rho >> 4, i = rho & 15; return 8 * (i >> 2) + 4 * n + (i & 3); }

struct Unit { int pm, pn, ka, kb, nt, slab; };
struct Gemm { const bf16_t* A; const bf16_t* Bt; int lda, ldb; };

struct StaticOrder {
    int nM, nN, nwg, G, c, nt;
    __device__ void init(int Mr, int N, int K, int G_, int c_) { nM = Mr / BM; nN = N / BM; nwg = nM * nN; G = G_; c = c_; nt = K / BK; }
    __device__ bool next(int i, Unit& u) const {
        const long L = (long)i * G + c; if (L >= nwg) return false;
        int wgid = (int)L; { const int q = nwg / NXCD, r = nwg % NXCD, xcd = wgid % NXCD, off = wgid / NXCD; wgid = (xcd < r ? xcd * (q + 1) : r * (q + 1) + (xcd - r) * q) + off; }
        const int nig = WGM * nN, gid = wgid / nig, fm = gid * WGM, gsz = (nM - fm) < WGM ? (nM - fm) : WGM;
        u.pm = fm + ((wgid % nig) % gsz); u.pn = (wgid % nig) / gsz; u.ka = 0; u.kb = 0; u.nt = nt; u.slab = -1; return true;
    }
    __device__ __forceinline__ void a_ready(const Unit&) const {}
    __device__ __forceinline__ void done(const Unit&) const {}
};
struct LoraOrder {
    StaticOrder so; int nt;
    __device__ bool next(int i, Unit& u) const { if (!so.next(i, u)) return false; const int off = ((u.pn >> 2) == 2) ? 192 : 0; u.ka = off; u.kb = off; u.nt = nt; return true; }
    __device__ __forceinline__ void a_ready(const Unit&) const {}
    __device__ __forceinline__ void done(const Unit&) const {}
};
__device__ __forceinline__ void resid_tile(int L, int& pm, int& pn) {
    if (L >= 256) { pm = 32 + ((L - 256) >> 3); pn = (L - 256) & 7; return; }
    const int wgid = (L % NXCD) * 32 + L / NXCD; pm = 8 * (wgid / 64) + ((wgid % 64) % 8); pn = (wgid % 64) / 8;
}
struct ResidOrder {
    StaticOrder so; int SF, PU; bool split;
    __device__ void init(int K, int G_, int c_) { so.init(M, 2048, K, G_, c_); PU = K / 128; SF = (PU / 2) < 16 ? (PU / 2) : 16; split = (G_ == 256); }
    __device__ bool next(int i, Unit& u) const {
        if (!split) return so.next(i, u);
        const int j = so.c / SF, p = so.c % SF; const bool piece = j < 16;
        if ((i == 0 && !piece) || (i == 1 && piece)) { resid_tile(so.c, u.pm, u.pn); u.ka = 0; u.kb = 0; u.nt = so.nt; u.slab = -1; return true; }
        if (i == 0) { resid_tile(256 + j, u.pm, u.pn); const int p0 = (p * PU) / SF, p1 = ((p + 1) * PU) / SF; u.ka = p0 * 128; u.kb = p0 * 128; u.nt = (p1 - p0) * 2; u.slab = j * SF + p; return true; }
        return false;
    }
    __device__ __forceinline__ void a_ready(const Unit&) const {}
    __device__ __forceinline__ void done(const Unit&) const {}
};
struct OddInOrder {
    StaticOrder so; bool split;
    __device__ void init(int G_, int c_) { so.init(M, 4096, 2048, G_, c_); split = (G_ == 256); }
    __device__ bool next(int i, Unit& u) const {
        if (!split) return so.next(i, u);
        if (i == 0) { const int j = so.c >> 3, p = so.c & 7; u.pm = 32 + (j >> 4); u.pn = j & 15; u.ka = p * 256; u.kb = p * 256; u.nt = 4; u.slab = so.c; return true; }
        if (i > 2) return false;
        const int L = (i - 1) * 256 + so.c, wgid = (L % NXCD) * 64 + L / NXCD;
        u.pm = 8 * (wgid / 128) + ((wgid % 128) % 8); u.pn = (wgid % 128) / 8; u.ka = 0; u.kb = 0; u.nt = so.nt; u.slab = -1; return true;
    }
    __device__ __forceinline__ void a_ready(const Unit&) const {}
    __device__ __forceinline__ void done(const Unit&) const {}
};
struct LruOrder {
    int G, c, nt;
    __device__ bool next(int i, Unit& u) const {
        const int L = i * G + c; if (L >= (M / BM) * 16) return false;
        u.pm = L >> 4; u.pn = L & 15; u.ka = 256 * (u.pn >> 1); u.kb = 0; u.nt = nt; u.slab = -1; return true;
    }
    __device__ __forceinline__ void a_ready(const Unit&) const {}
    __device__ __forceinline__ void done(const Unit&) const {}
};

__device__ __forceinline__ unsigned cvt_pk_bf16(float lo, float hi) {
    typedef float f2_ __attribute__((ext_vector_type(2))); typedef __bf16 b2_ __attribute__((ext_vector_type(2)));
    return __builtin_bit_cast(unsigned, __builtin_convertvector((f2_){lo, hi}, b2_));
}
__device__ __forceinline__ float sigm(float x) { return __builtin_amdgcn_rcpf(1.0f + __expf(-x)); }
__device__ __forceinline__ float log1p_pos(float t) { return t < 0.01f ? t * (1.0f - t * (0.5f - t * 0.33333333f)) : __logf(1.0f + t); }
__device__ __forceinline__ float softplus_(float y) { return fmaxf(y, 0.0f) + log1p_pos(__expf(-fabsf(y))); }
__device__ __forceinline__ float silu_(float x) { return x * sigm(x); }
__device__ __forceinline__ float gelu_tanh(float x) { return x * sigm(1.5957691216057308f * (x + 0.044715f * x * x * x)); }
__device__ __forceinline__ float neg_expm1(float x) {
    if (x > -0.25f) { return -x * (1.0f + x * (0.5f + x * (0.16666667f + x * (0.041666668f + x * (0.0083333338f + x * 0.0013888889f))))); }
    return 1.0f - __expf(x);
}

struct EpiSwiGLU {
    static constexpr bool PERM = true, AFTER_DRAIN = false;
    bf16_t* H; int ldh; const float* rstd;
    __device__ __forceinline__ void operator()(const f32x4 (&acc)[2][2][4][2], const Unit& u, int wr, int wc, int fr, int fq) const {
        const int row0 = u.pm * BM + wr * 64 + fr, col0 = u.pn * HALF + wc * 32 + 8 * fq;
        float rsv[2][4];
#pragma unroll
        for (int ai = 0; ai < 2; ++ai)
#pragma unroll
            for (int m = 0; m < 4; ++m) rsv[ai][m] = rstd[row0 + ai * HALF + m * 16];
#pragma unroll
        for (int ai = 0; ai < 2; ++ai)
#pragma unroll
            for (int m = 0; m < 4; ++m) {
                bf16_t* rowp = H + (size_t)(row0 + ai * HALF + m * 16) * ldh + col0;
                const float rs = rsv[ai][m];
                const f32x4 g0 = acc[ai][0][m][0] * rs, g1 = acc[ai][0][m][1] * rs, u0 = acc[ai][1][m][0] * rs, u1 = acc[ai][1][m][1] * rs;
                u32x4 w;
                w.x = cvt_pk_bf16(silu_(g0[0]) * u0[0], silu_(g0[1]) * u0[1]); w.y = cvt_pk_bf16(silu_(g0[2]) * u0[2], silu_(g0[3]) * u0[3]);
                w.z = cvt_pk_bf16(silu_(g1[0]) * u1[0], silu_(g1[1]) * u1[1]); w.w = cvt_pk_bf16(silu_(g1[2]) * u1[2], silu_(g1[3]) * u1[3]);
                *(u32x4*)rowp = w;
            }
    }
};
struct EpiResid {
    static constexpr bool PERM = true, AFTER_DRAIN = false;
    bf16_t* X; int ldx; float scale; float* SLAB; bf16_t* XR; const float* gain; float* SSP;
    __device__ __forceinline__ void operator()(const f32x4 (&acc)[2][2][4][2], const Unit& u, int wr, int wc, int fr, int fq) const {
        if (u.slab >= 0) {
            bf16_t* base = (bf16_t*)SLAB + (size_t)u.slab * 65536 + (wr * 64 + fr) * 256 + wc * 32 + 8 * fq;
#pragma unroll
            for (int ai = 0; ai < 2; ++ai)
#pragma unroll
                for (int m = 0; m < 4; ++m)
#pragma unroll
                    for (int bj = 0; bj < 2; ++bj)
#pragma unroll
                        for (int n = 0; n < 2; ++n) { const f32x4 v = acc[ai][bj][m][n]; u32x2 w2; w2.x = cvt_pk_bf16(v[0], v[1]); w2.y = cvt_pk_bf16(v[2], v[3]); *(u32x2*)(base + (ai * HALF + m * 16) * 256 + bj * HALF + n * 4) = w2; }
            return;
        }
        const int row0 = u.pm * BM + wr * 64 + fr, col0 = u.pn * BM + wc * 32 + 8 * fq;
        f32x4 gv[2][2];
#pragma unroll
        for (int bj = 0; bj < 2; ++bj)
#pragma unroll
            for (int n = 0; n < 2; ++n) gv[bj][n] = gain ? *(const f32x4*)(gain + col0 + bj * HALF + n * 4) : (f32x4){0.f, 0.f, 0.f, 0.f};
#pragma unroll
        for (int aim = 0; aim < 4; ++aim) { const int ai = aim >> 1, mb = (aim & 1) * 2;
            u32x4 xv[4][2];
#pragma unroll
            for (int m = mb; m < mb + 2; ++m)
#pragma unroll
                for (int bj = 0; bj < 2; ++bj) xv[m][bj] = *(const u32x4*)(X + (size_t)(row0 + ai * HALF + m * 16) * ldx + col0 + bj * HALF);
#pragma unroll
            for (int m = mb; m < mb + 2; ++m) {
                const int row = row0 + ai * HALF + m * 16;
                bf16_t* rowp = X + (size_t)row * ldx + col0; float ssq = 0.f;
#pragma unroll
                for (int bj = 0; bj < 2; ++bj) {
                    const u32x4 w = xv[m][bj];
                    const f32x4 x0 = {__builtin_bit_cast(float, w.x << 16), __builtin_bit_cast(float, w.x & 0xffff0000u), __builtin_bit_cast(float, w.y << 16), __builtin_bit_cast(float, w.y & 0xffff0000u)};
                    const f32x4 x1 = {__builtin_bit_cast(float, w.z << 16), __builtin_bit_cast(float, w.z & 0xffff0000u), __builtin_bit_cast(float, w.w << 16), __builtin_bit_cast(float, w.w & 0xffff0000u)};
                    const f32x4 o0 = x0 + acc[ai][bj][m][0] * scale, o1 = x1 + acc[ai][bj][m][1] * scale;
                    u32x4 wo; wo.x = cvt_pk_bf16(o0[0], o0[1]); wo.y = cvt_pk_bf16(o0[2], o0[3]); wo.z = cvt_pk_bf16(o1[0], o1[1]); wo.w = cvt_pk_bf16(o1[2], o1[3]);
                    *(u32x4*)(rowp + bj * HALF) = wo;
                    if (gain) { ssq += ((o0[0] * o0[0] + o0[1] * o0[1]) + (o0[2] * o0[2] + o0[3] * o0[3])) + ((o1[0] * o1[0] + o1[1] * o1[1]) + (o1[2] * o1[2] + o1[3] * o1[3]));
                        const f32x4 y0 = o0 * gv[bj][0], y1 = o1 * gv[bj][1];
                        u32x4 wy; wy.x = cvt_pk_bf16(y0[0], y0[1]); wy.y = cvt_pk_bf16(y0[2], y0[3]); wy.z = cvt_pk_bf16(y1[0], y1[1]); wy.w = cvt_pk_bf16(y1[2], y1[3]);
                        *(u32x4*)(XR + (size_t)row * ldx + col0 + bj * HALF) = wy; } }
                if (gain) { ssq += __shfl_xor(ssq, 16); ssq += __shfl_xor(ssq, 32); if (fq == 0) SSP[(size_t)row * 32 + u.pn * 4 + wc] = ssq; }
            }
        }
    }
};
struct EpiStoreBf16 {
    static constexpr bool PERM = true, AFTER_DRAIN = false;
    bf16_t* O; int ldo; const float* rstd;
    __device__ __forceinline__ void operator()(const f32x4 (&acc)[2][2][4][2], const Unit& u, int wr, int wc, int fr, int fq) const {
        const int row0 = u.pm * BM + wr * 64 + fr, col0 = u.pn * BM + wc * 32 + 8 * fq;
        float rsv[2][4];
#pragma unroll
        for (int ai = 0; ai < 2; ++ai)
#pragma unroll
            for (int m = 0; m < 4; ++m) rsv[ai][m] = rstd[row0 + ai * HALF + m * 16];
#pragma unroll
        for (int ai = 0; ai < 2; ++ai)
#pragma unroll
            for (int m = 0; m < 4; ++m) {
                bf16_t* rowp = O + (size_t)(row0 + ai * HALF + m * 16) * ldo + col0; const float rs = rsv[ai][m];
#pragma unroll
                for (int bj = 0; bj < 2; ++bj) { const f32x4 v0 = acc[ai][bj][m][0] * rs, v1 = acc[ai][bj][m][1] * rs;
                    u32x4 w; w.x = cvt_pk_bf16(v0[0], v0[1]); w.y = cvt_pk_bf16(v0[2], v0[3]); w.z = cvt_pk_bf16(v1[0], v1[1]); w.w = cvt_pk_bf16(v1[2], v1[3]);
                    *(u32x4*)(rowp + bj * HALF) = w; }
            }
    }
};
struct EpiLora {
    static constexpr bool PERM = true, AFTER_DRAIN = false;
    bf16_t* O; const float* w0; const float* a0;
    __device__ __forceinline__ void operator()(const f32x4 (&acc)[2][2][4][2], const Unit& u, int wr, int wc, int fr, int fq) const {
        const int row0 = u.pm * BM + wr * 64 + fr, col0 = u.pn * BM + wc * 32 + 8 * fq, ty = u.pn >> 2;
        f32x4 bv[2][2];
#pragma unroll
        for (int bj = 0; bj < 2; ++bj)
#pragma unroll
            for (int n = 0; n < 2; ++n) { const int c = (col0 + bj * HALF + n * 4) & 1023; bv[bj][n] = ty == 0 ? *(const f32x4*)(w0 + c) : (ty == 1 ? *(const f32x4*)(a0 + c) : (f32x4){0.f, 0.f, 0.f, 0.f}); }
#pragma unroll
        for (int ai = 0; ai < 2; ++ai)
#pragma unroll
            for (int m = 0; m < 4; ++m) {
                bf16_t* rowp = O + (size_t)(row0 + ai * HALF + m * 16) * NLORA + col0;
#pragma unroll
                for (int bj = 0; bj < 2; ++bj)
#pragma unroll
                    for (int n = 0; n < 2; ++n) {
                        f32x4 v = acc[ai][bj][m][n] + bv[bj][n];
                        if (ty == 0) {
#pragma unroll
                            for (int i = 0; i < 4; ++i) v[i] = -0.60653065971f * sigm(v[i]);
                        } else if (ty == 1) {
#pragma unroll
                            for (int i = 0; i < 4; ++i) v[i] = sigm(v[i]);
                        }
                        u32x2 w2_; w2_.x = cvt_pk_bf16(v[0], v[1]); w2_.y = cvt_pk_bf16(v[2], v[3]); *(u32x2*)(rowp + bj * HALF + n * 4) = w2_;
                    }
            }
    }
};
struct EpiOddIn {
    static constexpr bool PERM = true, AFTER_DRAIN = false;
    bf16_t* GATE; bf16_t* XB; const float* rstd; bf16_t* SLAB;
    __device__ __forceinline__ void operator()(const f32x4 (&acc)[2][2][4][2], const Unit& u, int wr, int wc, int fr, int fq) const {
        if (u.slab >= 0) {
            bf16_t* base = SLAB + (size_t)u.slab * 65536 + (wr * 64 + fr) * 256 + wc * 32 + 8 * fq;
#pragma unroll
            for (int ai = 0; ai < 2; ++ai)
#pragma unroll
                for (int m = 0; m < 4; ++m)
#pragma unroll
                    for (int bj = 0; bj < 2; ++bj) { const f32x4 v0 = acc[ai][bj][m][0], v1 = acc[ai][bj][m][1];
                        u32x4 w; w.x = cvt_pk_bf16(v0[0], v0[1]); w.y = cvt_pk_bf16(v0[2], v0[3]); w.z = cvt_pk_bf16(v1[0], v1[1]); w.w = cvt_pk_bf16(v1[2], v1[3]);
                        *(u32x4*)(base + (ai * HALF + m * 16) * 256 + bj * HALF) = w; }
            return;
        }
        const int row0 = u.pm * BM + wr * 64 + fr, col0 = (u.pn & 7) * BM + wc * 32 + 8 * fq; const bool isg = u.pn < 8;
        bf16_t* dst = isg ? GATE : XB;
        float rsv[2][4];
#pragma unroll
        for (int ai = 0; ai < 2; ++ai)
#pragma unroll
            for (int m = 0; m < 4; ++m) rsv[ai][m] = rstd[row0 + ai * HALF + m * 16];
#pragma unroll
        for (int ai = 0; ai < 2; ++ai)
#pragma unroll
            for (int m = 0; m < 4; ++m) {
                const size_t ro = (size_t)(row0 + ai * HALF + m * 16) * 2048 + col0; const float rs = rsv[ai][m];
#pragma unroll
                for (int bj = 0; bj < 2; ++bj) {
                    f32x4 v0 = acc[ai][bj][m][0] * rs, v1 = acc[ai][bj][m][1] * rs;
                    if (isg) {
#pragma unroll
                        for (int q = 0; q < 4; ++q) { v0[q] = gelu_tanh(v0[q]); v1[q] = gelu_tanh(v1[q]); } }
                    u32x4 w; w.x = cvt_pk_bf16(v0[0], v0[1]); w.y = cvt_pk_bf16(v0[2], v0[3]); w.z = cvt_pk_bf16(v1[0], v1[1]); w.w = cvt_pk_bf16(v1[2], v1[3]);
                    *(u32x4*)(dst + ro + bj * HALF) = w;
                }
            }
    }
};
struct EpiLru {
    static constexpr bool PERM = true, AFTER_DRAIN = false;
    const bf16_t* XC; bf16_t* OA; bf16_t* OB; const float* ba; const float* bx; const float* lam;
    __device__ __forceinline__ void operator()(const f32x4 (&acc)[2][2][4][2], const Unit& u, int wr, int wc, int fr, int fq) const {
        const int row0 = u.pm * BM + wr * 64 + fr, ch0 = u.pn * HALF + wc * 32 + 8 * fq;
#pragma unroll
        for (int n = 0; n < 2; ++n) {
            const f32x4 vba = *(const f32x4*)(ba + ch0 + n * 4), vbx = *(const f32x4*)(bx + ch0 + n * 4), l = *(const f32x4*)(lam + ch0 + n * 4); f32x4 vsl;
#pragma unroll
            for (int i = 0; i < 4; ++i) vsl[i] = -8.0f * softplus_(-l[i]);
            u32x2 xw[2][4];
#pragma unroll
            for (int ai = 0; ai < 2; ++ai)
#pragma unroll
                for (int m = 0; m < 4; ++m) xw[ai][m] = *(const u32x2*)(XC + (size_t)(row0 + ai * HALF + m * 16) * 2048 + ch0 + n * 4);
#pragma unroll
            for (int ai = 0; ai < 2; ++ai)
#pragma unroll
                for (int m = 0; m < 4; ++m) {
                    const size_t ro = (size_t)(row0 + ai * HALF + m * 16) * 2048 + ch0 + n * 4;
                    const f32x4 ga = acc[ai][0][m][n] + vba, gx = acc[ai][1][m][n] + vbx; const u32x2 w2 = xw[ai][m];
                    const f32x4 xc = {__builtin_bit_cast(float, w2.x << 16), __builtin_bit_cast(float, w2.x & 0xffff0000u), __builtin_bit_cast(float, w2.y << 16), __builtin_bit_cast(float, w2.y & 0xffff0000u)};
                    f32x4 la, b;
#pragma unroll
                    for (int i = 0; i < 4; ++i) { la[i] = vsl[i] * sigm(ga[i]); b[i] = sqrtf(neg_expm1(2.0f * la[i])) * sigm(gx[i]) * xc[i]; }
                    u32x2 wa_, wb_; wa_.x = cvt_pk_bf16(la[0], la[1]); wa_.y = cvt_pk_bf16(la[2], la[3]); wb_.x = cvt_pk_bf16(b[0], b[1]); wb_.y = cvt_pk_bf16(b[2], b[3]);
                    *(u32x2*)(OA + ro) = wa_; *(u32x2*)(OB + ro) = wb_;
                }
        }
    }
};

template <class Epi, class Sched, bool ALIGN_EPI = false, bool SP2 = false>
__device__ __forceinline__ void gemm_phase(PG8_LAS unsigned char* lds, const Gemm g, const Sched& S, const Epi& E) {
    int tid_ = threadIdx.x; asm volatile("" : "+v"(tid_));
    const int tid = tid_, wid = __builtin_amdgcn_readfirstlane(tid >> 6), lane = tid & 63, wr = wid >> 2, wc = wid & 3, fr = lane & 15, fq = lane >> 4;
    const int lda = g.lda, ldb = g.ldb;
    unsigned voffA[2], voffB[2];
#pragma unroll
    for (int i = 0; i < 2; ++i) { int R, C; stage_rc(tid * 16 + i * 8192, R, C); const int Rb = Epi::PERM ? ((R & ~31) + perm32(R & 31)) : R;
        voffA[i] = (unsigned)(R * lda + C) * 2u; voffB[i] = (unsigned)(Rb * ldb + C) * 2u; }
    const size_t kstep = (size_t)(BK * 2);
    const size_t hstepA = (size_t)HALF * lda * 2, hstepB = (size_t)HALF * ldb * 2;
    const size_t tstepA = 2 * hstepA, tstepB = 2 * hstepB;
    const unsigned ldsw = (unsigned)wid * 1024u;
    const int aoff = lds_byte(wr * 64 + fr, fq * 8), boff = lds_byte(wc * 32 + fr, fq * 8);
#define PG8_SA(b, h) (((b) * 2 + (h)) * HTB)
#define PG8_SB(b, h) ((4 + (b) * 2 + (h)) * HTB)
#define PG8_STAGE(bufoff, gbase, voff) do { _Pragma("unroll") for (int _i = 0; _i < 2; ++_i) \
        __builtin_amdgcn_global_load_lds((const unsigned*)((const char*)(gbase) + (voff)[_i]), (PG8_LAS unsigned*)(lds + (bufoff) + ldsw + _i * 8192), 16, 0, 0); } while (0)
#define PG8_LDA(dst, b, h) do { _Pragma("unroll") for (int m = 0; m < 4; ++m) _Pragma("unroll") for (int k = 0; k < 2; ++k) dst[m][k] = *(const PG8_LAS bf16x8*)(lds + PG8_SA(b, h) + aoff + m * 2048 + k * 1024); } while (0)
#define PG8_LDB(dst, b, h) do { _Pragma("unroll") for (int n = 0; n < 2; ++n) _Pragma("unroll") for (int k = 0; k < 2; ++k) dst[n][k] = *(const PG8_LAS bf16x8*)(lds + PG8_SB(b, h) + boff + n * 2048 + k * 1024); } while (0)
#define PG8_MMA(ai, bj, At, Bt) do { __builtin_amdgcn_s_setprio(1); _Pragma("unroll") for (int m = 0; m < 4; ++m) _Pragma("unroll") for (int n = 0; n < 2; ++n) _Pragma("unroll") for (int k = 0; k < 2; ++k) \
        acc[ai][bj][m][n] = __builtin_amdgcn_mfma_f32_16x16x32_bf16(Bt[n][k], At[m][k], acc[ai][bj][m][n], 0, 0, 0); __builtin_amdgcn_s_setprio(0); } while (0)
#define PG8_WAIT_V(n) asm volatile("s_waitcnt vmcnt(" #n ")" ::: "memory")
#define PG8_WAIT_L(n) asm volatile("s_waitcnt lgkmcnt(" #n ")" ::: "memory")
#define PG8_BAR __builtin_amdgcn_s_barrier()
#define PG8_SCHED __builtin_amdgcn_sched_barrier(0)
    Unit cur, nxt; int ui = 0;
    if (!S.next(0, cur)) return;
    f32x4 acc[2][2][4][2];
#pragma unroll
    for (int a = 0; a < 2; ++a)
#pragma unroll
        for (int b = 0; b < 2; ++b)
#pragma unroll
            for (int m = 0; m < 4; ++m)
#pragma unroll
                for (int n = 0; n < 2; ++n) acc[a][b][m][n] = (f32x4){0.f, 0.f, 0.f, 0.f};
    bf16x8 At[4][2], B0[2][2], B1[2][2];
    const char* cA = (const char*)g.A + (size_t)cur.pm * tstepA + (size_t)cur.ka * 2; const char* cB = (const char*)g.Bt + (size_t)cur.pn * tstepB + (size_t)cur.kb * 2; int nt = cur.nt;
    S.a_ready(cur);
    if constexpr (SP2) {
        PG8_STAGE(PG8_SB(0, 0), cB, voffB); PG8_STAGE(PG8_SB(0, 1), cB + hstepB, voffB); PG8_STAGE(PG8_SA(0, 0), cA, voffA); PG8_STAGE(PG8_SA(0, 1), cA + hstepA, voffA);
        if (wr == 1) PG8_BAR;
        PG8_WAIT_V(2); PG8_BAR;
        PG8_STAGE(PG8_SB(1, 0), cB + kstep, voffB); PG8_STAGE(PG8_SA(1, 0), cA + kstep, voffA); PG8_STAGE(PG8_SB(1, 1), cB + hstepB + kstep, voffB);
        PG8_WAIT_V(6); PG8_BAR;
    } else {
        PG8_STAGE(PG8_SB(0, 0), cB, voffB); PG8_STAGE(PG8_SA(0, 0), cA, voffA); PG8_STAGE(PG8_SB(0, 1), cB + hstepB, voffB); PG8_STAGE(PG8_SA(0, 1), cA + hstepA, voffA);
        if (wr == 1) PG8_BAR;
        PG8_WAIT_V(4); PG8_BAR;
        PG8_STAGE(PG8_SB(1, 0), cB + kstep, voffB); PG8_STAGE(PG8_SA(1, 0), cA + kstep, voffA); PG8_STAGE(PG8_SB(1, 1), cB + hstepB + kstep, voffB);
        PG8_WAIT_V(6); PG8_BAR;
    }
    for (;;) {
        const bool has_next = S.next(ui + 1, nxt);
        const char* nA = has_next ? (const char*)g.A + (size_t)nxt.pm * tstepA + (size_t)nxt.ka * 2 : cA; const char* nB = has_next ? (const char*)g.Bt + (size_t)nxt.pn * tstepB + (size_t)nxt.kb * 2 : cB;
        for (int t = 0; t < nt; t += 2) {
            const bool last = (t == nt - 2);
            const char* a1 = cA + (size_t)(t + 1) * kstep;
            const char* a2 = last ? nA : cA + (size_t)(t + 2) * kstep; const char* b2 = last ? nB : cB + (size_t)(t + 2) * kstep;
            const char* a3 = a2 + kstep; const char* b3 = b2 + kstep;
            if (last && has_next) S.a_ready(nxt);
            if constexpr (SP2) {
            PG8_LDB(B0, 0, 0); PG8_LDB(B1, 0, 1); PG8_SCHED; PG8_LDA(At, 0, 0); PG8_STAGE(PG8_SA(1, 1), a1 + hstepA, voffA);
            PG8_WAIT_V(8); PG8_WAIT_L(0); PG8_BAR; PG8_MMA(0, 0, At, B0); PG8_MMA(0, 1, At, B1); PG8_BAR; PG8_SCHED;
            PG8_LDA(At, 0, 1); PG8_STAGE(PG8_SB(0, 0), b2, voffB); PG8_STAGE(PG8_SB(0, 1), b2 + hstepB, voffB); PG8_STAGE(PG8_SA(0, 0), a2, voffA);
            PG8_WAIT_V(8); PG8_WAIT_L(0); PG8_BAR; PG8_MMA(1, 0, At, B0); PG8_MMA(1, 1, At, B1); PG8_BAR; PG8_SCHED;
            PG8_LDB(B0, 1, 0); PG8_LDB(B1, 1, 1); PG8_SCHED; PG8_LDA(At, 1, 0); PG8_STAGE(PG8_SA(0, 1), a2 + hstepA, voffA);
            PG8_WAIT_V(8); PG8_WAIT_L(0); PG8_BAR; PG8_MMA(0, 0, At, B0); PG8_MMA(0, 1, At, B1); PG8_BAR; PG8_SCHED;
            PG8_LDA(At, 1, 1); PG8_STAGE(PG8_SB(1, 0), b3, voffB); PG8_STAGE(PG8_SB(1, 1), b3 + hstepB, voffB); PG8_STAGE(PG8_SA(1, 0), a3, voffA);
            PG8_WAIT_V(8); PG8_WAIT_L(0); PG8_BAR; PG8_MMA(1, 0, At, B0); PG8_MMA(1, 1, At, B1); PG8_BAR; PG8_SCHED;
            } else {
            PG8_LDB(B0, 0, 0); PG8_SCHED; PG8_LDA(At, 0, 0); PG8_STAGE(PG8_SA(1, 1), a1 + hstepA, voffA);
            PG8_WAIT_L(8); PG8_BAR; PG8_WAIT_L(0); PG8_MMA(0, 0, At, B0); PG8_BAR; PG8_SCHED;
            PG8_LDB(B1, 0, 1); PG8_STAGE(PG8_SB(0, 0), b2, voffB);
            PG8_BAR; PG8_WAIT_L(0); PG8_MMA(0, 1, At, B1); PG8_BAR;
            PG8_LDA(At, 0, 1); PG8_STAGE(PG8_SA(0, 0), a2, voffA);
            PG8_BAR; PG8_WAIT_L(0); PG8_MMA(1, 0, At, B0); PG8_BAR; PG8_SCHED;
            PG8_STAGE(PG8_SB(0, 1), b2 + hstepB, voffB);
            PG8_WAIT_V(6); PG8_BAR; PG8_MMA(1, 1, At, B1); PG8_BAR;
            PG8_LDB(B0, 1, 0); PG8_SCHED; PG8_LDA(At, 1, 0); PG8_STAGE(PG8_SA(0, 1), a2 + hstepA, voffA);
            PG8_WAIT_L(8); PG8_BAR; PG8_WAIT_L(0); PG8_MMA(0, 0, At, B0); PG8_BAR; PG8_SCHED;
            PG8_LDB(B1, 1, 1); PG8_STAGE(PG8_SB(1, 0), b3, voffB);
            PG8_BAR; PG8_WAIT_L(0); PG8_MMA(0, 1, At, B1); PG8_BAR;
            PG8_LDA(At, 1, 1); PG8_STAGE(PG8_SA(1, 0), a3, voffA);
            PG8_BAR; PG8_WAIT_L(0); PG8_MMA(1, 0, At, B0); PG8_BAR; PG8_SCHED;
            PG8_STAGE(PG8_SB(1, 1), b3 + hstepB, voffB);
            PG8_WAIT_V(6); PG8_BAR; PG8_MMA(1, 1, At, B1); PG8_BAR;
            }
        }
        if constexpr (ALIGN_EPI) { if (wr == 0) PG8_BAR; }
        if constexpr (!Epi::AFTER_DRAIN) { E(acc, cur, wr, wc, fr, fq); if (EPI_REP > 1) { asm volatile("" ::: "memory"); E(acc, cur, wr, wc, fr, fq); } S.done(cur); }
        if (!has_next) break;
#pragma unroll
        for (int a = 0; a < 2; ++a)
#pragma unroll
            for (int b = 0; b < 2; ++b)
#pragma unroll
                for (int m = 0; m < 4; ++m)
#pragma unroll
                    for (int n = 0; n < 2; ++n) acc[a][b][m][n] = (f32x4){0.f, 0.f, 0.f, 0.f};
        cur = nxt; cA = nA; cB = nB; nt = cur.nt; ++ui;
        if constexpr (ALIGN_EPI) { if (wr == 1) PG8_BAR; }
    }
    PG8_WAIT_V(0);
    if constexpr (!ALIGN_EPI) { if (wr == 0) PG8_BAR; }
    PG8_BAR;
    if constexpr (Epi::AFTER_DRAIN) { E.fused(acc, cur, wr, wc, fr, fq, lds, wid, lane); S.done(cur); }
#undef PG8_SA
#undef PG8_SB
#undef PG8_STAGE
#undef PG8_LDA
#undef PG8_LDB
#undef PG8_MMA
#undef PG8_WAIT_V
#undef PG8_WAIT_L
#undef PG8_BAR
#undef PG8_SCHED
}
}

constexpr size_t MiB = 1u << 20;
constexpr size_t WS_CTL = 0, CTL_ZERO_BYTES = 512 * 1024;
constexpr size_t SZ_WGU = (size_t)2 * FF * D * 2, SZ_WDN = (size_t)D * FF * 2;
constexpr size_t SZ_WEVIN = (size_t)NEV * D * 2, SZ_WSQ = (size_t)D * D * 2, SZ_WODIN = (size_t)2 * D * D * 2;
constexpr size_t SZ_WLORA = (size_t)NLORA * KLORA * 2, SZ_WLRU = (size_t)4096 * 256 * 2;
constexpr size_t WS_WGU = 1 * MiB;
constexpr size_t WS_WDN = WS_WGU + 8 * SZ_WGU;
constexpr size_t WS_WEVIN = WS_WDN + 8 * SZ_WDN;
constexpr size_t WS_WEVOUT = WS_WEVIN + 2 * SZ_WEVIN;
constexpr size_t WS_WODIN = WS_WEVOUT + 2 * SZ_WSQ;
constexpr size_t WS_WODOUT = WS_WODIN + 2 * SZ_WODIN;
constexpr size_t WS_WLORA = WS_WODOUT + 2 * SZ_WSQ;
constexpr size_t WS_WLRU = WS_WLORA + 2 * SZ_WLORA;
constexpr size_t WS_X = WS_WLRU + 2 * SZ_WLRU;
constexpr size_t WS_XN = WS_X + (size_t)M * D * 4;
constexpr size_t WS_H = WS_XN + (size_t)M * D * 2;
constexpr size_t WS_YIN = WS_H + (size_t)M * FF * 2;
constexpr size_t WS_MIX = WS_YIN + (size_t)M * D * 2;
constexpr size_t WS_PROJ = WS_MIX;
constexpr size_t WS_WAG = WS_PROJ + (size_t)M * NEV * 4;
constexpr size_t WS_LA = WS_WAG + (size_t)M * NLORA * 4;
constexpr size_t WS_HU = WS_LA + (size_t)M * KLORA * 2;
constexpr size_t WS_HD = WS_HU + (size_t)1024 * 16384 * 4;
constexpr size_t WS_PST = WS_HD + (size_t)1024 * 128 * 4;
constexpr size_t WS_QST = WS_PST + (size_t)8192 * 4096 * 2;
constexpr size_t WS_OB2 = WS_QST + (size_t)8192 * 4096 * 4;
constexpr size_t WS_SSP = WS_OB2 + (size_t)MP * 1024 * 4;
constexpr size_t WS_RSTD = WS_SSP + (size_t)M * 32 * 4;
constexpr size_t WS_EVEN_END = WS_RSTD + (size_t)M * 4;
constexpr size_t WS_OI = WS_H, WS_QT = WS_H + (size_t)MP * 1024 * 4;
constexpr size_t WS_RQ = WS_QT + (size_t)MP * 1024 * 4;
constexpr size_t WS_OB = WS_XN;
static_assert(WS_RQ + (size_t)8192 * 1024 * 2 <= WS_YIN, "OI/QT/RQ overlay fits in H");
constexpr size_t WS_SLAB = WS_MIX;
constexpr size_t WS_OSLAB = WS_PST;
constexpr size_t WS_XB = WS_MIX;
constexpr size_t WS_GATE = WS_XB + (size_t)M * 2048 * 4;
constexpr size_t WS_XC = WS_GATE + (size_t)M * 2048 * 2;
constexpr size_t WS_XCB = WS_XC + (size_t)M * 2048 * 4;
constexpr size_t WS_LRA = WS_XCB + (size_t)M * 2048 * 2;
constexpr size_t WS_LRB = WS_LRA + (size_t)M * 2048 * 4;
constexpr size_t WS_CP = WS_LRB + (size_t)M * 2048 * 4;
constexpr size_t WS_CH = WS_CP + (size_t)4 * 32 * 2048 * 4;
constexpr size_t WS_ODD_END = WS_CH + (size_t)4 * 32 * 2048 * 4;
constexpr size_t WS_END = WS_EVEN_END > WS_ODD_END ? WS_EVEN_END : WS_ODD_END;
constexpr int CW_BAR = 4096;
constexpr int PAR_FFN1N = 0, PAR_MIXN = 8192, PAR_FFN2N = 16384, PAR_FINN = 24576, PAR_MU = 26624, PAR_W0 = 33664, PAR_A0 = 35712, PAR_KK = 37760, PAR_KA = 39808,
              PAR_RK = 41856, PAR_LNW = 43904, PAR_LNB = 45952, PAR_HGLB = 48000, PAR_HGN = 50048, PAR_CONVW = 52096, PAR_CONVB = 68480, PAR_BA = 72576, PAR_BX = 76672,
              PAR_LAM = 80768, PAR_END = 84864;
constexpr size_t WS_PAR = 512 * 1024;

constexpr size_t O_Y = 0, O_PSHIFT = (size_t)M * D, O_PRWKV = O_PSHIFT + (size_t)BP * 2 * PRW, O_PHGRN = O_PRWKV + (size_t)BP * 2 * 16 * 4096,
                 O_PCONV = O_PHGRN + (size_t)BP * 2 * 8 * 16384, O_PLRU = O_PCONV + (size_t)BP * 2 * 3 * 2048, O_SSHIFT = O_PLRU + (size_t)BP * 2 * 2048,
                 O_SRWKV = O_SSHIFT + (size_t)BS * 2 * PRW, O_SHGRN = O_SRWKV + (size_t)BS * 2 * 16 * 4096, O_SCONV = O_SHGRN + (size_t)BS * 2 * 8 * 16384,
                 O_SLRU = O_SCONV + (size_t)BS * 2 * 3 * 2048, O_END = O_SLRU + (size_t)BS * 2 * 2048;

constexpr int LDS_BYTES = 155648;
constexpr int MISC_OFF = 153600;

#define GAS __attribute__((address_space(1)))
#define LAS __attribute__((address_space(3)))
typedef unsigned short bf16;
typedef unsigned v4u __attribute__((ext_vector_type(4)));
typedef unsigned v2u __attribute__((ext_vector_type(2)));
typedef float f32x4 __attribute__((ext_vector_type(4)));
typedef float f32x2 __attribute__((ext_vector_type(2)));
using pg8::sigm; using pg8::silu_; using pg8::softplus_; using pg8::cvt_pk_bf16;
#define LDS_WAIT() asm volatile("s_waitcnt lgkmcnt(0)" ::: "memory")
#define VM_WAIT() asm volatile("s_waitcnt vmcnt(0)" ::: "memory")
__device__ __forceinline__ unsigned f2bf(float f) { unsigned u = __builtin_bit_cast(unsigned, f); return (u + 0x7fffu + ((u >> 16) & 1u)) >> 16; }
__device__ __forceinline__ unsigned pk2(float lo, float hi) { return f2bf(lo) | (f2bf(hi) << 16); }
__device__ __forceinline__ float bf2f(unsigned h) { return __builtin_bit_cast(float, h << 16); }
template <int CTRL> __device__ __forceinline__ float dppf(float v) { return __builtin_bit_cast(float, __builtin_amdgcn_update_dpp(0, __builtin_bit_cast(int, v), CTRL, 0xf, 0xf, true)); }
__device__ __forceinline__ float red8(float x) { x += dppf<0xB1>(x); x += dppf<0x4E>(x); x += dppf<0x141>(x); return x; }
__device__ __forceinline__ float red16(float x) { x = red8(x); x += dppf<0x140>(x); return x; }
__device__ __forceinline__ float wave_sum(float v) {
#pragma unroll
    for (int o = 1; o < 64; o <<= 1) v += __shfl_xor(v, o);
    return v;
}
#define XB_TMO      128
#define XB_XCNT(j)  (256  + 64 * (j))
#define XB_XSUB(j)  (1280 + 64 * (j))
#define XB_XGEN(j)  (2304 + 64 * (j))
#define XB_TOP      3328
#define XB_TOPGEN   3392
#define XCD_BAR_WORDS 3456
#define XB_SPIN_CAP (1u << 18)

__device__ __forceinline__ unsigned xb_ld(unsigned* p)              { return __hip_atomic_load(p, __ATOMIC_RELAXED, __HIP_MEMORY_SCOPE_AGENT); }
__device__ __forceinline__ unsigned xb_add(unsigned* p, unsigned v) { return __hip_atomic_fetch_add(p, v, __ATOMIC_RELAXED, __HIP_MEMORY_SCOPE_AGENT); }
__device__ __forceinline__ unsigned xb_xcc_id() { return (unsigned)__builtin_amdgcn_s_getreg((3 << 11) | 20) & 0xFu; }
#define XB_SPIN(cond, bar) do { unsigned _sp = 0; while (cond) { __builtin_amdgcn_s_sleep(1); \
    if ((++_sp & 255u) == 0u) { if (xb_ld(&(bar)[XB_TMO])) break; if (_sp > XB_SPIN_CAP) { atomicAdd(&(bar)[XB_TMO], 1u); break; } } } } while (0)

struct XcdBarrier {
    unsigned* bar; unsigned x;
    volatile LAS unsigned* st;
};

__device__ __forceinline__ XcdBarrier xcd_barrier_post(unsigned* bar, volatile LAS unsigned* st) {
    XcdBarrier b; b.bar = bar; b.x = xb_xcc_id(); b.st = st;
    if (threadIdx.x == 0) (void)xb_add(&bar[XB_XCNT(b.x)], 1u);
    return b;
}
__device__ __forceinline__ void xcd_barrier_complete(unsigned* bar, unsigned x, unsigned& nloc, unsigned& nx) {
    const unsigned G = gridDim.x * gridDim.y * gridDim.z;
    unsigned sum, cnt, mine, sp = 0u;
    for (;;) {
        sum = 0u; cnt = 0u; mine = 0u;
#pragma unroll
        for (unsigned j = 0; j < 16; ++j) { const unsigned c = xb_ld(&bar[XB_XCNT(j)]); sum += c; cnt += (c > 0u) ? 1u : 0u; mine = (j == x) ? c : mine; }
        if (sum == G) break;
        __builtin_amdgcn_s_sleep(1);
        if ((++sp & 255u) == 0u) { if (xb_ld(&bar[XB_TMO])) break; if (sp > XB_SPIN_CAP) { atomicAdd(&bar[XB_TMO], 1u); break; } }
    }
    nloc = mine > 0u ? mine : 1u; nx = cnt > 0u ? cnt : 1u;
}

__device__ __forceinline__ void xcd_barrier(const XcdBarrier& b) {
    asm volatile("s_waitcnt vmcnt(0)" ::: "memory");
    __syncthreads();
    if (threadIdx.x == 0) {
        unsigned* bar = b.bar;
        __builtin_amdgcn_s_waitcnt(0);
        unsigned nloc = b.st[0], nx = b.st[1];
        if (nloc == 0u) { xcd_barrier_complete(bar, b.x, nloc, nx); b.st[0] = nloc; b.st[1] = nx; }
        const unsigned old = xb_add(&bar[XB_XSUB(b.x)], 1u);
        const unsigned gen = old / nloc;
        if (old + 1u == (gen + 1u) * nloc) {
            __builtin_amdgcn_fence(__ATOMIC_RELEASE, "agent");
            asm volatile("s_waitcnt vmcnt(0)" ::: "memory");
            const unsigned og = xb_add(&bar[XB_TOP], 1u);
            const unsigned tg = og / nx;
            if (og + 1u == (tg + 1u) * nx) xb_add(&bar[XB_TOPGEN], 1u);
            else XB_SPIN(xb_ld(&bar[XB_TOPGEN]) == tg, bar);
            __builtin_amdgcn_fence(__ATOMIC_ACQUIRE, "agent");
            xb_add(&bar[XB_XGEN(b.x)], 1u);
            asm volatile("s_waitcnt vmcnt(0)" ::: "memory");
        } else {
            XB_SPIN(xb_ld(&bar[XB_XGEN(b.x)]) == gen, bar);
            __builtin_amdgcn_fence(__ATOMIC_ACQUIRE, "agent");
            asm volatile("s_waitcnt vmcnt(0)" ::: "memory");
        }
    }
    __syncthreads();
}


#define GAS __attribute__((address_space(1)))
struct Args { const float* in[39]; GAS float* out; GAS unsigned char* ws; int ph_lo, ph_hi, li, pad; };
#define AOUT ((float*)A.out)
struct Frame { LAS unsigned char* lds; int tid, lane, wave, G, blk; };
#define PARP(off) ((const float*)(A.ws + WS_PAR) + (off))
__device__ __forceinline__ f32x4 ld4(const float* p) { return *(const f32x4*)p; }
__device__ __forceinline__ f32x4 ldp4(const bf16* p) { const v2u w = *(const v2u*)p; return (f32x4){bf2f(w.x & 0xffffu), bf2f(w.x >> 16), bf2f(w.y & 0xffffu), bf2f(w.y >> 16)}; }
__device__ __forceinline__ f32x4 cvq(const v2u w) { return (f32x4){bf2f(w.x & 0xffffu), bf2f(w.x >> 16), bf2f(w.y & 0xffffu), bf2f(w.y >> 16)}; }
__device__ __forceinline__ void st4bf(bf16* p, f32x4 v) { v2u w; w.x = cvt_pk_bf16(v[0], v[1]); w.y = cvt_pk_bf16(v[2], v[3]); *(v2u*)p = w; }

__device__ __forceinline__ void tr_item(const float* src, int Nsrc, int srcc0, int k0, bf16* dst, int ldd, int n0, LAS float* scr, int lane) {
    const int r4 = lane >> 4, q = lane & 15;
    if (srcc0 >= 0) {
        f32x4 v[16];
#pragma unroll
        for (int i = 0; i < 16; ++i) v[i] = ld4(src + (size_t)(k0 + 4 * i + r4) * Nsrc + srcc0 + 4 * q);
#pragma unroll
        for (int i = 0; i < 16; ++i) { LAS float* s = scr + (4 * i + r4) * 65 + 4 * q; s[0] = v[i][0]; s[1] = v[i][1]; s[2] = v[i][2]; s[3] = v[i][3]; }
    } else {
#pragma unroll 4
        for (int i = 0; i < 16; ++i) { const int k = 4 * i + r4; LAS float* s = scr + k * 65 + 4 * q; s[0] = 0.f; s[1] = 0.f; s[2] = 0.f; s[3] = 0.f; }
    }
    LDS_WAIT(); asm volatile("" ::: "memory");
    const int c = lane & 7;
#pragma unroll
    for (int j = 0; j < 8; ++j) { const int n = (lane >> 3) + 8 * j; const LAS float* s = scr + (8 * c) * 65 + n;
        v4u o; o.x = pk2(s[0 * 65], s[1 * 65]); o.y = pk2(s[2 * 65], s[3 * 65]); o.z = pk2(s[4 * 65], s[5 * 65]); o.w = pk2(s[6 * 65], s[7 * 65]);
        *(v4u*)(dst + (size_t)(n0 + n) * ldd + k0 + 8 * c) = o; }
    LDS_WAIT(); asm volatile("" ::: "memory");
}
constexpr int IT_GU = 32 * 176, IT_DN = 88 * 32, IT_EVIN = 32 * 120, IT_SQ = 32 * 32, IT_ODIN = 32 * 64;
constexpr int IT_TOTAL = 8 * IT_GU + 8 * IT_DN + 2 * IT_EVIN + 2 * IT_SQ + 2 * IT_ODIN + 2 * IT_SQ;

__device__ __forceinline__ void norm_row(const float* xrow, const bf16* xrow16, const float* gain, bf16* xn, float* y, bf16* xcopy, int lane, int sf = 0, float scale = 0.f, const float* slab = nullptr, int m = 0, bf16* xrow_w = nullptr, float* rstd_out = nullptr) {
    f32x4 v[8]; float s = 0.f;
#pragma unroll
    for (int j = 0; j < 8; ++j) v[j] = xrow16 ? ldp4(xrow16 + 4 * lane + 256 * j) : ld4(xrow + 4 * lane + 256 * j);
    if (sf > 0 && m >= MP) {
        const int r = m & 255, j0 = ((m >> 8) - 32) * 8;
#pragma unroll
        for (int jj = 0; jj < 8; ++jj) { f32x4 add = {0.f, 0.f, 0.f, 0.f};
            for (int p = 0; p < sf; ++p) { const v2u w2 = *(const v2u*)((const bf16*)slab + (size_t)((j0 + jj) * sf + p) * 65536 + r * 256 + 4 * lane); add += (f32x4){bf2f(w2.x & 0xffffu), bf2f(w2.x >> 16), bf2f(w2.y & 0xffffu), bf2f(w2.y >> 16)}; }
            v[jj] += add * scale; st4bf(xrow_w + 4 * lane + 256 * jj, v[jj]); }
    }
#pragma unroll
    for (int j = 0; j < 8; ++j) s += (v[j][0] * v[j][0] + v[j][1] * v[j][1]) + (v[j][2] * v[j][2] + v[j][3] * v[j][3]);
    const float rstd = 1.0f / sqrtf(wave_sum(s) * (1.0f / D) + 1e-6f);
#pragma unroll
    for (int j = 0; j < 8; ++j) {
        if (xcopy) st4bf(xcopy + 4 * lane + 256 * j, v[j]);
        const f32x4 gq = ld4(gain + 4 * lane + 256 * j), o = v[j] * rstd * gq;
        if (xn) st4bf(xn + 4 * lane + 256 * j, rstd_out ? v[j] * gq : o);
        if (y) *(f32x4*)(y + 4 * lane + 256 * j) = o;
    }
    if (rstd_out && lane == 0) *rstd_out = rstd;
}

#ifndef PRO_2X4
#define PRO_2X4 1
#endif
#if PRO_2X4
#define PRO_MAP(r, NB, kb, nb) do { const int g_ = (r) >> 3, w_ = (r) & 7; nb = (g_ % ((NB) / 4)) * 4 + (w_ & 3); kb = (g_ / ((NB) / 4)) * 2 + (w_ >> 2); } while (0)
#else
#define PRO_MAP(r, NB, kb, nb) do { kb = (r) / (NB); nb = (r) % (NB); } while (0)
#endif
__device__ __forceinline__ void p0_prologue(const Args& A, Frame& F) {
    LAS float* scr = (LAS float*)(F.lds + F.wave * 16640);
    const int gw = F.blk * NWAVES + F.wave, NGW = F.G * NWAVES;
    bf16* Wgu = (bf16*)(A.ws + WS_WGU); bf16* Wdn = (bf16*)(A.ws + WS_WDN); bf16* Wevin = (bf16*)(A.ws + WS_WEVIN); bf16* Wevout = (bf16*)(A.ws + WS_WEVOUT);
    bf16* Wodin = (bf16*)(A.ws + WS_WODIN); bf16* Wodout = (bf16*)(A.ws + WS_WODOUT);
    for (int it = gw; it < IT_TOTAL; it += NGW) {
        int r = it;
        if (r < 8 * IT_GU) { const int mat = r / IT_GU; r -= mat * IT_GU; int kb, nb; PRO_MAP(r, 176, kb, nb); const int n0 = nb * 64, pn = n0 >> 8, c = n0 & 255;
            const int srcc = c < 128 ? pn * 128 + c : FF + pn * 128 + (c - 128);
            tr_item(((mat & 1) ? A.in[12] : A.in[8]) + (size_t)(mat >> 1) * D * 2 * FF, 2 * FF, srcc, kb * 64, Wgu + (size_t)mat * (SZ_WGU / 2), D, n0, scr, F.lane); continue; }
        r -= 8 * IT_GU;
        if (r < 8 * IT_DN) { const int mat = r / IT_DN; r -= mat * IT_DN; int kb, nb; PRO_MAP(r, 32, kb, nb);
            tr_item(((mat & 1) ? A.in[13] : A.in[9]) + (size_t)(mat >> 1) * FF * D, D, nb * 64, kb * 64, Wdn + (size_t)mat * (SZ_WDN / 2), FF, nb * 64, scr, F.lane); continue; }
        r -= 8 * IT_DN;
        if (r < 2 * IT_EVIN) { const int mat = r / IT_EVIN; r -= mat * IT_EVIN; int kb, nb; PRO_MAP(r, 120, kb, nb);
            tr_item(A.in[14] + (size_t)mat * D * PEV, PEV, nb * 64 < PEV ? nb * 64 : -1, kb * 64, Wevin + (size_t)mat * (SZ_WEVIN / 2), D, nb * 64, scr, F.lane); continue; }
        r -= 2 * IT_EVIN;
        if (r < 2 * IT_SQ) { const int mat = r / IT_SQ; r -= mat * IT_SQ; int kb, nb; PRO_MAP(r, 32, kb, nb);
            tr_item(A.in[28] + (size_t)mat * D * D, D, nb * 64, kb * 64, Wevout + (size_t)mat * (SZ_WSQ / 2), D, nb * 64, scr, F.lane); continue; }
        r -= 2 * IT_SQ;
        if (r < 2 * IT_ODIN) { const int mat = r / IT_ODIN; r -= mat * IT_ODIN; int kb, nb; PRO_MAP(r, 64, kb, nb);
            tr_item(A.in[29] + (size_t)mat * D * 2 * D, 2 * D, nb * 64, kb * 64, Wodin + (size_t)mat * (SZ_WODIN / 2), D, nb * 64, scr, F.lane); continue; }
        r -= 2 * IT_ODIN;
        { const int mat = r / IT_SQ; r -= mat * IT_SQ; int kb, nb; PRO_MAP(r, 32, kb, nb);
            tr_item(A.in[37] + (size_t)mat * D * D, D, nb * 64, kb * 64, Wodout + (size_t)mat * (SZ_WSQ / 2), D, nb * 64, scr, F.lane); }
    }
    const int gt = F.blk * NTHR + F.tid, NGT = F.G * NTHR;
    for (int idx = gt; idx < 2 * NLORA * (KLORA / 8); idx += NGT) {
        const int e = idx / (NLORA * (KLORA / 8)); int r = idx - e * (NLORA * (KLORA / 8)); const int n = r % NLORA, k8 = r / NLORA;
        const int ty = n >> 10, nn = n & 1023; float v[8];
#pragma unroll
        for (int i = 0; i < 8; ++i) { const int k = 8 * k8 + i; float x = 0.f;
            if (ty == 0) { if (k < 96) x = A.in[17][((size_t)e * 96 + k) * 1024 + nn]; }
            else if (ty == 1) { if (k >= 96 && k < 192) x = A.in[19][((size_t)e * 96 + (k - 96)) * 1024 + nn]; }
            else { if (k >= 192 && k < 448) x = A.in[20][((size_t)e * 256 + (k - 192)) * 1024 + nn]; }
            v[i] = x; }
        v4u o; o.x = pk2(v[0], v[1]); o.y = pk2(v[2], v[3]); o.z = pk2(v[4], v[5]); o.w = pk2(v[6], v[7]);
        *(v4u*)((bf16*)(A.ws + WS_WLORA) + (size_t)e * NLORA * KLORA + (size_t)n * KLORA + 8 * k8) = o;
    }
    for (int idx = gt; idx < 2 * 4096 * 32; idx += NGT) {
        const int o_ = idx / (4096 * 32); int r = idx - o_ * (4096 * 32); const int rr = r % 4096, k8 = r / 4096;
        const int j = rr >> 8, c = rr & 255, n = j >> 1, cc = (j & 1) * 128 + (c & 127);
        const float* src = (c < 128 ? A.in[32] : A.in[34]) + ((size_t)(o_ * 8 + n) * 256) * 256 + cc; float v[8];
#pragma unroll
        for (int i = 0; i < 8; ++i) v[i] = src[(size_t)(8 * k8 + i) * 256];
        v4u o; o.x = pk2(v[0], v[1]); o.y = pk2(v[2], v[3]); o.z = pk2(v[4], v[5]); o.w = pk2(v[6], v[7]);
        *(v4u*)((bf16*)(A.ws + WS_WLRU) + (size_t)o_ * 4096 * 256 + (size_t)rr * 256 + 8 * k8) = o;
    }
    {
        float* P = (float*)(A.ws + WS_PAR);
#define CPPAR(off, src, n) for (int i_ = gt; i_ < (n); i_ += NGT) P[(off) + i_] = (src)[i_];
        CPPAR(PAR_FFN1N, A.in[7], 8192) CPPAR(PAR_MIXN, A.in[10], 8192) CPPAR(PAR_FFN2N, A.in[11], 8192) CPPAR(PAR_FINN, A.in[38], 2048)
        CPPAR(PAR_MU, A.in[15], 7040) CPPAR(PAR_W0, A.in[16], 2048) CPPAR(PAR_A0, A.in[18], 2048) CPPAR(PAR_KK, A.in[21], 2048) CPPAR(PAR_KA, A.in[22], 2048)
        CPPAR(PAR_RK, A.in[23], 2048) CPPAR(PAR_LNW, A.in[24], 2048) CPPAR(PAR_LNB, A.in[25], 2048) CPPAR(PAR_HGLB, A.in[26], 2048) CPPAR(PAR_HGN, A.in[27], 2048)
        CPPAR(PAR_CONVW, A.in[30], 16384) CPPAR(PAR_CONVB, A.in[31], 4096) CPPAR(PAR_BA, A.in[33], 4096) CPPAR(PAR_BX, A.in[35], 4096) CPPAR(PAR_LAM, A.in[36], 4096)
#undef CPPAR
    }
    bf16* X = (bf16*)(A.ws + WS_X); bf16* XN = (bf16*)(A.ws + WS_XN);
    for (int m = gw; m < M; m += NGW) {
        const float* src = m < MP ? A.in[0] + (size_t)m * D : A.in[1] + (size_t)(m - MP) * D;
        norm_row(src, nullptr, A.in[7], XN + (size_t)m * D, nullptr, X + (size_t)m * D, F.lane, 0, 0.f, nullptr, 0, nullptr, (float*)(A.ws + WS_RSTD) + m);
    }
}

__device__ __forceinline__ void norm_phase(const Args& A, Frame& F, const float* gain, bool final_, int sf, float scale) {
    const int gw = F.blk * NWAVES + F.wave, NGW = F.G * NWAVES;
    bf16* X = (bf16*)(A.ws + WS_X); bf16* XN = (bf16*)(A.ws + WS_XN);
    for (int m = gw; m < M; m += NGW)
        norm_row(nullptr, X + (size_t)m * D, gain, final_ ? nullptr : XN + (size_t)m * D, final_ ? AOUT + O_Y + (size_t)m * D : nullptr, nullptr, F.lane, sf, scale, (const float*)(A.ws + WS_SLAB), m, X + (size_t)m * D);
}

__device__ __forceinline__ void rstd_phase(const Args& A, Frame& F, const float* gain, int sf, float scale) {
    bf16* X = (bf16*)(A.ws + WS_X); bf16* XN = (bf16*)(A.ws + WS_XN); float* RSTD = (float*)(A.ws + WS_RSTD); const float* SSP = (const float*)(A.ws + WS_SSP);
    if (sf > 0) {
        LAS float* red = (LAS float*)F.lds; const bf16* slab = (const bf16*)(A.ws + WS_SLAB); const int jj = F.wave, lane = F.lane;
        for (int m0 = MP + F.blk; m0 < M; m0 += 2 * F.G) {
            f32x4 v[2], add[2]; const f32x4 gq = ld4(gain + 256 * jj + 4 * lane);
#pragma unroll
            for (int q = 0; q < 2; ++q) { const int m = m0 + q * F.G; add[q] = (f32x4){0.f, 0.f, 0.f, 0.f}; v[q] = add[q];
                if (m < M) { v[q] = ldp4(X + (size_t)m * D + 256 * jj + 4 * lane);
                    const bf16* sp = slab + (size_t)(((m >> 8) - 32) * 8 + jj) * sf * 65536 + (m & 255) * 256 + 4 * lane;
                    if (sf == 16) {
#pragma unroll
                        for (int p = 0; p < 16; ++p) add[q] += ldp4(sp + (size_t)p * 65536);
                    } else { for (int p = 0; p < sf; ++p) add[q] += ldp4(sp + (size_t)p * 65536); } } }
#pragma unroll
            for (int q = 0; q < 2; ++q) { const int m = m0 + q * F.G;
                if (m < M) { v[q] += add[q] * scale; st4bf(X + (size_t)m * D + 256 * jj + 4 * lane, v[q]); st4bf(XN + (size_t)m * D + 256 * jj + 4 * lane, v[q] * gq); }
                const float s = wave_sum((v[q][0] * v[q][0] + v[q][1] * v[q][1]) + (v[q][2] * v[q][2] + v[q][3] * v[q][3]));
                if (lane == 0) red[q * 8 + jj] = s; }
            __syncthreads();
            if (F.tid < 2) { const int m = m0 + F.tid * F.G; const LAS float* rr = red + F.tid * 8;
                if (m < M) RSTD[m] = 1.0f / sqrtf(((rr[0] + rr[1]) + (rr[2] + rr[3]) + (rr[4] + rr[5]) + (rr[6] + rr[7])) * (1.0f / D) + 1e-6f); }
            __syncthreads();
        }
    }
    const int r1 = sf > 0 ? MP : M;
    for (int m = F.blk * NTHR + F.tid; m < r1; m += F.G * NTHR) { float s = 0.f;
#pragma unroll
        for (int q = 0; q < 8; ++q) { const f32x4 t = ld4(SSP + (size_t)m * 32 + 4 * q); s += (t[0] + t[1]) + (t[2] + t[3]); }
        RSTD[m] = 1.0f / sqrtf(s * (1.0f / D) + 1e-6f); }
}

__device__ __forceinline__ void e2_prep(const Args& A, Frame& F, int e) {
    const bf16* PROJ = (const bf16*)(A.ws + WS_PROJ); bf16* LA = (bf16*)(A.ws + WS_LA);
    const int gt = F.blk * NTHR + F.tid, NGT = F.G * NTHR;
    for (int idx = gt; idx < (M / 8) * 128; idx += NGT) {
        const int c4 = (idx & 127) * 4, m0 = (idx >> 7) * 8;
        if (c4 >= 448) {
#pragma unroll
            for (int r = 0; r < 8; ++r) st4bf(LA + (size_t)(m0 + r) * KLORA + c4, (f32x4){0.f, 0.f, 0.f, 0.f});
            continue; }
        const int col = 3072 + c4; f32x4 x[9];
#pragma unroll
        for (int r = 0; r < 8; ++r) x[r + 1] = ldp4(PROJ + (size_t)(m0 + r) * NEV + col);
        const bool prompt = m0 < MP;
        if (prompt) x[0] = (m0 & (TP - 1)) ? ldp4(PROJ + (size_t)(m0 - 1) * NEV + col) : (f32x4){0.f, 0.f, 0.f, 0.f};
        else x[0] = ld4(A.in[2] + (size_t)(((m0 - MP) >> 2) * 2 + e) * PRW + col);
        f32x4 xs4 = {0.f, 0.f, 0.f, 0.f}; if (!prompt) xs4 = ld4(A.in[2] + (size_t)((((m0 - MP) >> 2) + 1) * 2 + e) * PRW + col);
        const f32x4 mu = ld4(PARP(PAR_MU) + (size_t)e * PRW + col);
#pragma unroll
        for (int r = 0; r < 8; ++r) {
            const f32x4 pv = (!prompt && r == 4) ? xs4 : x[r], p = x[r + 1], z = p + (pv - p) * mu; f32x4 o;
#pragma unroll
            for (int i = 0; i < 4; ++i) o[i] = c4 < 96 ? 2.0f * sigm(2.0f * z[i]) - 1.0f : (c4 < 192 ? z[i] : sigm(z[i]));
            st4bf(LA + (size_t)(m0 + r) * KLORA + c4, o);
        }
    }
    for (int idx = gt; idx < NSEQ * (PRW / 4); idx += NGT) {
        const int q = idx / (PRW / 4), c4 = (idx % (PRW / 4)) * 4;
        const int m = q < BP ? q * TP + TP - 1 : MP + (q - BP) * TS + TS - 1;
        float* o = AOUT + (q < BP ? O_PSHIFT + (size_t)(q * 2 + e) * PRW : O_SSHIFT + (size_t)((q - BP) * 2 + e) * PRW) + c4;
        *(f32x4*)o = ldp4(PROJ + (size_t)m * NEV + c4);
    }
}

struct RwRaw { f32x4 pr, pk, pv, qr, qk, qv, wd, wa; };
__device__ __forceinline__ void rwkv_unit(const Args& A, Frame& F, int e, int q, int h) {
    const int tid = F.tid, hi = tid >> 4, lo = tid & 15;
    const bool prompt = q < BP; const int T = prompt ? TP : TS, row0 = prompt ? q * TP : MP + (q - BP) * TS, bs = q - BP;
    const bf16* PROJ = (const bf16*)(A.ws + WS_PROJ); const float* WAG = (const float*)(A.ws + WS_WAG); bf16* YIN = (bf16*)(A.ws + WS_YIN);
    LAS float* cb = (LAS float*)F.lds; LAS float* ob = cb + 2 * 32 * 384;
    const int hc = h * 64 + 4 * lo;
    const float* mu = PARP(PAR_MU) + (size_t)e * PRW;
    const f32x4 mu_r = ld4(mu + hc), mu_k = ld4(mu + 1024 + hc), mu_v = ld4(mu + 2048 + hc);
    const f32x4 k_k = ld4(PARP(PAR_KK) + e * 1024 + hc), k_a = ld4(PARP(PAR_KA) + e * 1024 + hc);
    const int hs = (tid >> 3) & 31, ls = tid & 7; const bool stepper = tid < 256;
    f32x4 S[2][2];
#pragma unroll
    for (int i = 0; i < 2; ++i)
#pragma unroll
        for (int c = 0; c < 2; ++c) {
            S[i][c] = (f32x4){0.f, 0.f, 0.f, 0.f};
            if (!prompt && stepper) S[i][c] = ld4(A.in[3] + ((size_t)(bs * 2 + e) * 16 + h) * 4096 + (2 * hs + i) * 64 + 8 * ls + 4 * c);
        }
    const int nch = (T + 31) / 32;
    RwRaw raw = {};
#define RW_LOAD_RAW(ci_) do { const int t_ = (ci_) * 32 + hi; \
        if (t_ < T) { const size_t m_ = (size_t)(row0 + t_); \
            raw.pr = ldp4(PROJ + m_ * NEV + hc); raw.pk = ldp4(PROJ + m_ * NEV + 1024 + hc); raw.pv = ldp4(PROJ + m_ * NEV + 2048 + hc); \
            raw.wd = ld4(WAG + m_ * NLORA + hc); raw.wa = ld4(WAG + m_ * NLORA + 1024 + hc); \
            if (t_ > 0) { raw.qr = ldp4(PROJ + (m_ - 1) * NEV + hc); raw.qk = ldp4(PROJ + (m_ - 1) * NEV + 1024 + hc); raw.qv = ldp4(PROJ + (m_ - 1) * NEV + 2048 + hc); } \
            else if (!prompt) { const float* sh_ = A.in[2] + (size_t)(bs * 2 + e) * PRW; raw.qr = ld4(sh_ + hc); raw.qk = ld4(sh_ + 1024 + hc); raw.qv = ld4(sh_ + 2048 + hc); } \
            else { raw.qr = (f32x4){0.f, 0.f, 0.f, 0.f}; raw.qk = raw.qr; raw.qv = raw.qr; } } } while (0)
    RW_LOAD_RAW(0);
    for (int ci = 0; ci < nch; ++ci) {
        const int t0 = ci * 32, t = t0 + hi; const bool valid = t < T;
        LAS float* cbb = cb + (ci & 1) * (32 * 384); LAS float* obb = ob + (ci & 1) * (32 * 64);
        if (valid) {
            const f32x4 zr = raw.pr + (raw.qr - raw.pr) * mu_r, zk = raw.pk + (raw.qk - raw.pk) * mu_k, zv = raw.pv + (raw.qv - raw.pv) * mu_v;
            f32x4 kk = zk * k_k;
            const float ss = red16((kk[0] * kk[0] + kk[1] * kk[1]) + (kk[2] * kk[2] + kk[3] * kk[3]));
            kk = kk * (1.0f / fmaxf(sqrtf(ss), 1e-12f));
            const f32x4 kp = zk * (1.0f + (raw.wa - 1.0f) * k_a), bb = kk * raw.wa;
            LAS float* p = cbb + hi * 384 + 4 * lo;
            *(LAS f32x4*)(p) = zr; *(LAS f32x4*)(p + 64) = raw.wd; *(LAS f32x4*)(p + 128) = kp; *(LAS f32x4*)(p + 192) = kk; *(LAS f32x4*)(p + 256) = bb; *(LAS f32x4*)(p + 320) = zv;
        }
        __syncthreads();
        if (ci + 1 < nch) RW_LOAD_RAW(ci + 1);
        const int ns = (T - t0) < 32 ? (T - t0) : 32;
        if (stepper) {
            f32x4 r4[2], w4[2], kp4[2], kk4[2], bb4[2]; f32x2 v2;
#define RW_LD(s_) do { const LAS float* p_ = cbb + (s_) * 384 + 8 * ls; \
            r4[0] = *(const LAS f32x4*)(p_); r4[1] = *(const LAS f32x4*)(p_ + 4); w4[0] = *(const LAS f32x4*)(p_ + 64); w4[1] = *(const LAS f32x4*)(p_ + 68); \
            kp4[0] = *(const LAS f32x4*)(p_ + 128); kp4[1] = *(const LAS f32x4*)(p_ + 132); kk4[0] = *(const LAS f32x4*)(p_ + 192); kk4[1] = *(const LAS f32x4*)(p_ + 196); \
            bb4[0] = *(const LAS f32x4*)(p_ + 256); bb4[1] = *(const LAS f32x4*)(p_ + 260); v2 = *(const LAS f32x2*)(cbb + (s_) * 384 + 320 + 2 * hs); } while (0)
            RW_LD(0);
            for (int s = 0; s < ns; ++s) {
                const f32x4 cr0 = r4[0], cr1 = r4[1], cw0 = w4[0], cw1 = w4[1], ck0 = kp4[0], ck1 = kp4[1], cq0 = kk4[0], cq1 = kk4[1], cb0 = bb4[0], cb1 = bb4[1]; const f32x2 cv = v2;
                if (s + 1 < ns) RW_LD(s + 1);
                float sa[2], o[2];
#pragma unroll
                for (int i = 0; i < 2; ++i) { const f32x4 t = S[i][0] * cq0 + S[i][1] * cq1; sa[i] = -red8((t[0] + t[1]) + (t[2] + t[3])); }
#pragma unroll
                for (int i = 0; i < 2; ++i) { S[i][0] = S[i][0] * cw0 + cb0 * sa[i] + ck0 * cv[i]; S[i][1] = S[i][1] * cw1 + cb1 * sa[i] + ck1 * cv[i]; }
#pragma unroll
                for (int i = 0; i < 2; ++i) { const f32x4 t = S[i][0] * cr0 + S[i][1] * cr1; o[i] = red8((t[0] + t[1]) + (t[2] + t[3])); }
                if (ls == 0) *(LAS f32x2*)(obb + s * 64 + 2 * hs) = (f32x2){o[0], o[1]};
            }
#undef RW_LD
        }
        __syncthreads();
        if (valid) {
            const size_t m = (size_t)(row0 + t);
            const f32x4 o4 = *(const LAS f32x4*)(obb + hi * 64 + 4 * lo);
            const float mean = red16((o4[0] + o4[1]) + (o4[2] + o4[3])) * (1.0f / 64.0f);
            const f32x4 d = o4 - mean;
            const float var = red16((d[0] * d[0] + d[1] * d[1]) + (d[2] * d[2] + d[3] * d[3])) * (1.0f / 64.0f);
            const float rs = 1.0f / sqrtf(var + 64e-5f);
            const LAS float* p = cbb + hi * 384 + 4 * lo;
            const f32x4 r4 = *(const LAS f32x4*)(p), kp4 = *(const LAS f32x4*)(p + 128), v4 = *(const LAS f32x4*)(p + 320);
            const f32x4 rk = ld4(PARP(PAR_RK) + e * 1024 + hc);
            const float bonus = red16((r4[0] * kp4[0] * rk[0] + r4[1] * kp4[1] * rk[1]) + (r4[2] * kp4[2] * rk[2] + r4[3] * kp4[3] * rk[3]));
            const f32x4 on = d * rs * ld4(PARP(PAR_LNW) + e * 1024 + hc) + ld4(PARP(PAR_LNB) + e * 1024 + hc) + v4 * bonus;
            st4bf(YIN + m * D + hc, on * ld4(WAG + m * NLORA + 2048 + hc));
        }
    }
    float* so = AOUT + (prompt ? O_PRWKV + ((size_t)(q * 2 + e) * 16 + h) * 4096 : O_SRWKV + ((size_t)(bs * 2 + e) * 16 + h) * 4096);
    if (stepper) {
#pragma unroll
        for (int i = 0; i < 2; ++i)
#pragma unroll
            for (int c = 0; c < 2; ++c) *(f32x4*)(so + (2 * hs + i) * 64 + 8 * ls + 4 * c) = S[i][c];
    }
    __syncthreads();
}

__device__ __forceinline__ float hg_lb(const Args& A, int e, int ch) {
    if (e == 0) return 0.f;
    const float l0 = PARP(PAR_HGLB)[ch], l1 = PARP(PAR_HGLB)[1024 + ch]; return sigm(l1 - l0);
}
constexpr int HG_S = 130, HG_VS = 132;
typedef short hbf16x8 __attribute__((ext_vector_type(8)));
__device__ __forceinline__ hbf16x8 pack8_strided(const LAS float* p, int st) {
    v4u o; o.x = cvt_pk_bf16(p[0], p[st]); o.y = cvt_pk_bf16(p[2 * st], p[3 * st]); o.z = cvt_pk_bf16(p[4 * st], p[5 * st]); o.w = cvt_pk_bf16(p[6 * st], p[7 * st]); return __builtin_bit_cast(hbf16x8, o); }
__device__ __forceinline__ void hgrn_chunk_unit(const Args& A, Frame& F, int e, int b, int h, int c) {
    const int tid = F.tid, lane = F.lane, w = F.wave, g = lane >> 4, i = lane & 15;
    const bf16* PROJ = (const bf16*)(A.ws + WS_PROJ);
    float* OI = (float*)(A.ws + WS_OI); float* QT = (float*)(A.ws + WS_QT); float* HU = (float*)(A.ws + WS_HU); float* HD = (float*)(A.ws + WS_HD);
    LAS float* Qs = (LAS float*)F.lds; LAS float* Ks = Qs + 64 * HG_S; LAS float* Vs = Ks + 64 * HG_S; LAS float* Gs = Vs + 64 * HG_VS; LAS float* As = Gs;
    LAS float* GB = Gs + 64 * HG_S; LAS float* EJ = GB + 5 * 128;
    const int m0 = b * TP + c * 64, unit = (b * 8 + h) * 32 + c;
    f32x4 lbv;
#pragma unroll
    for (int j = 0; j < 4; ++j) lbv[j] = hg_lb(A, e, h * 128 + (tid & 31) * 4 + j);
    f32x4 qv4[4], fv4[4], iv4[4];
#pragma unroll
    for (int it = 0; it < 4; ++it) { const int idx = tid + 512 * it, row = idx >> 5, c4 = (idx & 31) * 4;
        const bf16* pr = PROJ + (size_t)(m0 + row) * NEV + PRW + h * 128 + c4; qv4[it] = ldp4(pr); fv4[it] = ldp4(pr + 1024); iv4[it] = ldp4(pr + 2048); }
#pragma unroll
    for (int it = 0; it < 4; ++it) {
        const int idx = tid + 512 * it, row = idx >> 5, c4 = (idx & 31) * 4;
        const f32x4 qv = qv4[it], fv = fv4[it], iv = iv4[it];
#pragma unroll
        for (int j = 0; j < 4; ++j) {
            const float lb = lbv[j], sg = fmaxf(sigm(fv[j]), 1e-37f);
            Qs[row * HG_S + c4 + j] = silu_(qv[j]);
            Gs[row * HG_S + c4 + j] = __logf(lb + (1.0f - lb) * sg);
            Ks[row * HG_S + c4 + j] = (1.0f - lb) * (1.0f - sg);
        }
        *(LAS f32x4*)(Vs + row * HG_VS + c4) = iv;
    }
    __syncthreads();
    LAS float* TQ = EJ + 512;
    { const int k = tid & 127, I = tid >> 7; float run = 0.f;
#pragma unroll
        for (int t = 0; t < 16; ++t) { run += Gs[(16 * I + t) * HG_S + k]; Gs[(16 * I + t) * HG_S + k] = run; }
        TQ[tid] = run; }
    __syncthreads();
    { const int J = tid >> 7, k = tid & 127; const float t0 = TQ[k], t1 = TQ[128 + k], t2 = TQ[256 + k], t3 = TQ[384 + k];
      const float gbJ = J == 0 ? 0.f : (J == 1 ? t0 : (J == 2 ? t0 + t1 : (t0 + t1) + t2)), gl = ((t0 + t1) + t2) + t3;
      GB[J * 128 + k] = gbJ; if (J == 3) GB[4 * 128 + k] = gl; EJ[tid] = __expf(gl - gbJ); if (J == 0) HD[unit * 128 + k] = __expf(gl); }
#pragma unroll
    for (int it = 0; it < 4; ++it) {
        const int idx = tid + 512 * it, row = idx >> 5, c4 = (idx & 31) * 4, I = row >> 4; f32x4 o;
#pragma unroll
        for (int j = 0; j < 4; ++j) { const int kc = c4 + j; const float q = Qs[row * HG_S + kc], G = Gs[row * HG_S + kc];
            const float gb = I == 0 ? 0.f : (I == 1 ? TQ[kc] : (I == 2 ? TQ[kc] + TQ[128 + kc] : (TQ[kc] + TQ[128 + kc]) + TQ[256 + kc]));
            o[j] = q * __expf(G + gb); Qs[row * HG_S + kc] = q * __expf(G); Ks[row * HG_S + kc] *= __expf(fminf(-G, 80.0f)); }
        *(f32x4*)(QT + (size_t)(m0 + row) * 1024 + h * 128 + c4) = o;
    }
    __syncthreads();
    for (int pi = w; pi < 10; pi += 8) {
        const int I = pi < 1 ? 0 : (pi < 3 ? 1 : (pi < 6 ? 2 : 3)), J = pi - (I * (I + 1)) / 2;
        f32x4 acc = {0.f, 0.f, 0.f, 0.f};
#pragma unroll 8
        for (int s = 0; s < 32; ++s) { const int k = 4 * s + g;
            float av = Qs[(16 * I + i) * HG_S + k]; if (I != J) av *= __expf(GB[I * 128 + k] - GB[J * 128 + k]);
            acc = __builtin_amdgcn_mfma_f32_16x16x4f32(av, Ks[(16 * J + i) * HG_S + k], acc, 0, 0, 0); }
#pragma unroll
        for (int r = 0; r < 4; ++r) As[(16 * I + 4 * g + r) * 66 + 16 * J + i] = (I != J || i <= 4 * g + r) ? acc[r] : 0.f;
    }
    __syncthreads();
    {
        hbf16x8 vB[2];
#pragma unroll
        for (int ks = 0; ks < 2; ++ks) vB[ks] = pack8_strided(Vs + (32 * ks + 8 * g) * HG_VS + 16 * w + i, HG_VS);
#pragma unroll
        for (int I = 0; I < 4; ++I) {
            f32x4 acc = {0.f, 0.f, 0.f, 0.f};
#pragma unroll
            for (int ks = 0; ks < 2; ++ks) if (32 * ks < 16 * (I + 1)) {
                hbf16x8 aA = pack8_strided(As + (16 * I + i) * 66 + 32 * ks + 8 * g, 1);
                if (32 * ks + 8 * g >= 16 * (I + 1)) aA = (hbf16x8){0, 0, 0, 0, 0, 0, 0, 0};
                acc = __builtin_amdgcn_mfma_f32_16x16x32_bf16(aA, vB[ks], acc, 0, 0, 0); }
#pragma unroll
            for (int r = 0; r < 4; ++r) OI[(size_t)(m0 + 16 * I + 4 * g + r) * 1024 + h * 128 + 16 * w + i] = acc[r];
        }
        hbf16x8 kA[2];
#pragma unroll
        for (int ks = 0; ks < 2; ++ks) { const LAS float* p = Ks + (32 * ks + 8 * g) * HG_S + 16 * w + i; const int J = (32 * ks + 8 * g) >> 4; const float ej = EJ[J * 128 + 16 * w + i];
            v4u o; o.x = cvt_pk_bf16(p[0] * ej, p[HG_S] * ej); o.y = cvt_pk_bf16(p[2 * HG_S] * ej, p[3 * HG_S] * ej); o.z = cvt_pk_bf16(p[4 * HG_S] * ej, p[5 * HG_S] * ej); o.w = cvt_pk_bf16(p[6 * HG_S] * ej, p[7 * HG_S] * ej);
            kA[ks] = __builtin_bit_cast(hbf16x8, o); }
#pragma unroll 2
        for (int vb = 0; vb < 8; ++vb) {
            f32x4 acc = {0.f, 0.f, 0.f, 0.f};
#pragma unroll
            for (int ks = 0; ks < 2; ++ks) acc = __builtin_amdgcn_mfma_f32_16x16x32_bf16(kA[ks], pack8_strided(Vs + (32 * ks + 8 * g) * HG_VS + 16 * vb + i, HG_VS), acc, 0, 0, 0);
#pragma unroll
            for (int r = 0; r < 4; ++r) HU[(size_t)unit * 16384 + (16 * w + 4 * g + r) * 128 + 16 * vb + i] = acc[r];
        }
    }
    __syncthreads();
}
constexpr int HC_S = 132, HC_T = 72;
#define HC_SW(rc_, t_) ((rc_) * HC_T + ((((t_) >> 3) ^ (((rc_) >> 2) & 7)) << 3) + ((t_) & 7))
__device__ __forceinline__ hbf16x8 pk8f(const f32x4& a, const f32x4& b) { v4u o; o.x = cvt_pk_bf16(a[0], a[1]); o.y = cvt_pk_bf16(a[2], a[3]); o.z = cvt_pk_bf16(b[0], b[1]); o.w = cvt_pk_bf16(b[2], b[3]); return __builtin_bit_cast(hbf16x8, o); }
__device__ __forceinline__ void hgrn_chunk_unit2(const Args& A, Frame& F, int e, int b, int h, int c) {
    const int tid = F.tid, lane = F.lane, w = F.wave, g = lane >> 4, i = lane & 15;
    const bf16* PROJ = (const bf16*)(A.ws + WS_PROJ);
    float* OI = (float*)(A.ws + WS_OI); float* QT = (float*)(A.ws + WS_QT); float* HU = (float*)(A.ws + WS_HU); float* HD = (float*)(A.ws + WS_HD);
    LAS float* Qs = (LAS float*)F.lds; LAS float* Ks = Qs + 64 * HC_S; LAS float* Gs = Ks + 64 * HC_S;
    LAS unsigned short* AsB = (LAS unsigned short*)Gs;
    LAS unsigned short* VT = (LAS unsigned short*)(Gs + 64 * HC_S);
    LAS unsigned short* KT = VT + 128 * HC_T;
    LAS float* GB = (LAS float*)(KT + 128 * HC_T); LAS float* TQ = GB + 5 * 128;
    const int m0 = b * TP + c * 64, unit = (b * 8 + h) * 32 + c;
    f32x4 lbv;
#pragma unroll
    for (int j = 0; j < 4; ++j) lbv[j] = hg_lb(A, e, h * 128 + (tid & 31) * 4 + j);
    v2u qr4[4], fr4[4], ir4[4];
#pragma unroll
    for (int it = 0; it < 4; ++it) { const int idx = tid + 512 * it, row = idx >> 5, c4 = (idx & 31) * 4;
        const bf16* pr = PROJ + (size_t)(m0 + row) * NEV + PRW + h * 128 + c4; qr4[it] = *(const v2u*)pr; fr4[it] = *(const v2u*)(pr + 1024); ir4[it] = *(const v2u*)(pr + 2048); }
#pragma unroll
    for (int it = 0; it < 4; ++it) {
        const int idx = tid + 512 * it, row = idx >> 5, c4 = (idx & 31) * 4;
        const f32x4 qv = {bf2f(qr4[it].x & 0xffffu), bf2f(qr4[it].x >> 16), bf2f(qr4[it].y & 0xffffu), bf2f(qr4[it].y >> 16)};
        const f32x4 fv = {bf2f(fr4[it].x & 0xffffu), bf2f(fr4[it].x >> 16), bf2f(fr4[it].y & 0xffffu), bf2f(fr4[it].y >> 16)};
        f32x4 Q4, G4, K4;
#pragma unroll
        for (int j = 0; j < 4; ++j) { const float lb = lbv[j], sg = fmaxf(sigm(fv[j]), 1e-37f);
            Q4[j] = silu_(qv[j]); G4[j] = __logf(lb + (1.0f - lb) * sg); K4[j] = (1.0f - lb) * (1.0f - sg); }
        *(LAS f32x4*)(Qs + row * HC_S + c4) = Q4; *(LAS f32x4*)(Gs + row * HC_S + c4) = G4; *(LAS f32x4*)(Ks + row * HC_S + c4) = K4;
        VT[HC_SW(c4 + 0, row)] = (unsigned short)(ir4[it].x & 0xffffu); VT[HC_SW(c4 + 1, row)] = (unsigned short)(ir4[it].x >> 16);
        VT[HC_SW(c4 + 2, row)] = (unsigned short)(ir4[it].y & 0xffffu); VT[HC_SW(c4 + 3, row)] = (unsigned short)(ir4[it].y >> 16);
    }
    __syncthreads();
    { const int k = tid & 127, I = tid >> 7; float run = 0.f;
#pragma unroll
        for (int t = 0; t < 16; ++t) { run += Gs[(16 * I + t) * HC_S + k]; Gs[(16 * I + t) * HC_S + k] = run; }
        TQ[tid] = run; }
    __syncthreads();
    { const int J = tid >> 7, k = tid & 127; const float t0 = TQ[k], t1 = TQ[128 + k], t2 = TQ[256 + k], t3 = TQ[384 + k];
      const float gbJ = J == 0 ? 0.f : (J == 1 ? t0 : (J == 2 ? t0 + t1 : (t0 + t1) + t2)), gl = ((t0 + t1) + t2) + t3;
      GB[J * 128 + k] = gbJ; if (J == 3) GB[4 * 128 + k] = gl; if (J == 0) HD[unit * 128 + k] = __expf(gl); }
#pragma unroll
    for (int it = 0; it < 4; ++it) {
        const int idx = tid + 512 * it, row = idx >> 5, c4 = (idx & 31) * 4, I = row >> 4;
        const f32x4 q4 = *(const LAS f32x4*)(Qs + row * HC_S + c4), G4 = *(const LAS f32x4*)(Gs + row * HC_S + c4), K4 = *(const LAS f32x4*)(Ks + row * HC_S + c4);
        const f32x4 t0 = *(const LAS f32x4*)(TQ + c4), t1 = *(const LAS f32x4*)(TQ + 128 + c4), t2 = *(const LAS f32x4*)(TQ + 256 + c4), t3 = *(const LAS f32x4*)(TQ + 384 + c4);
        const f32x4 z4 = {0.f, 0.f, 0.f, 0.f};
        const f32x4 gb = I == 0 ? z4 : (I == 1 ? t0 : (I == 2 ? t0 + t1 : (t0 + t1) + t2)), gl = ((t0 + t1) + t2) + t3;
        f32x4 o, Qn, Kn, ke;
#pragma unroll
        for (int j = 0; j < 4; ++j) { o[j] = q4[j] * __expf(G4[j] + gb[j]); Qn[j] = q4[j] * __expf(G4[j]); Kn[j] = K4[j] * __expf(fminf(-G4[j], 80.0f)); ke[j] = Kn[j] * __expf(gl[j] - gb[j]); }
        st4bf((bf16*)QT + (size_t)(m0 + row) * 1024 + h * 128 + c4, o);
        *(LAS f32x4*)(Qs + row * HC_S + c4) = Qn; *(LAS f32x4*)(Ks + row * HC_S + c4) = Kn;
        const unsigned k01 = cvt_pk_bf16(ke[0], ke[1]), k23 = cvt_pk_bf16(ke[2], ke[3]);
        KT[HC_SW(c4 + 0, row)] = (unsigned short)(k01 & 0xffffu); KT[HC_SW(c4 + 1, row)] = (unsigned short)(k01 >> 16);
        KT[HC_SW(c4 + 2, row)] = (unsigned short)(k23 & 0xffffu); KT[HC_SW(c4 + 3, row)] = (unsigned short)(k23 >> 16);
    }
    __syncthreads();
    for (int pi = w; pi < 10; pi += 8) {
        const int I = pi < 1 ? 0 : (pi < 3 ? 1 : (pi < 6 ? 2 : 3)), J = pi - (I * (I + 1)) / 2;
        f32x4 acc = {0.f, 0.f, 0.f, 0.f};
#pragma unroll
        for (int ks = 0; ks < 4; ++ks) { const int kb = 32 * ks + 8 * g;
            f32x4 a0 = *(const LAS f32x4*)(Qs + (16 * I + i) * HC_S + kb), a1 = *(const LAS f32x4*)(Qs + (16 * I + i) * HC_S + kb + 4);
            if (I != J) { const f32x4 d0 = *(const LAS f32x4*)(GB + I * 128 + kb) - *(const LAS f32x4*)(GB + J * 128 + kb), d1 = *(const LAS f32x4*)(GB + I * 128 + kb + 4) - *(const LAS f32x4*)(GB + J * 128 + kb + 4);
#pragma unroll
                for (int j = 0; j < 4; ++j) { a0[j] *= __expf(d0[j]); a1[j] *= __expf(d1[j]); } }
            const f32x4 b0 = *(const LAS f32x4*)(Ks + (16 * J + i) * HC_S + kb), b1 = *(const LAS f32x4*)(Ks + (16 * J + i) * HC_S + kb + 4);
            acc = __builtin_amdgcn_mfma_f32_16x16x32_bf16(pk8f(a0, a1), pk8f(b0, b1), acc, 0, 0, 0); }
#pragma unroll
        for (int r = 0; r < 4; ++r) { const int t = 4 * g + r; const float v = (I != J || i <= t) ? acc[r] : 0.f;
            AsB[(16 * I + t) * HC_T + 16 * J + i] = (unsigned short)(cvt_pk_bf16(v, 0.f) & 0xffffu); }
    }
    __syncthreads();
    {
        hbf16x8 vB[2];
#pragma unroll
        for (int ks = 0; ks < 2; ++ks) vB[ks] = *(const LAS hbf16x8*)(VT + HC_SW(16 * w + i, 32 * ks + 8 * g));
#pragma unroll
        for (int I = 0; I < 4; ++I) {
            f32x4 acc = {0.f, 0.f, 0.f, 0.f};
#pragma unroll
            for (int ks = 0; ks < 2; ++ks) if (32 * ks < 16 * (I + 1)) {
                hbf16x8 aA = *(const LAS hbf16x8*)(AsB + (16 * I + i) * HC_T + 32 * ks + 8 * g);
                if (32 * ks + 8 * g >= 16 * (I + 1)) aA = (hbf16x8){0, 0, 0, 0, 0, 0, 0, 0};
                acc = __builtin_amdgcn_mfma_f32_16x16x32_bf16(vB[ks], aA, acc, 0, 0, 0); }
            st4bf((bf16*)OI + (size_t)(m0 + 16 * I + i) * 1024 + h * 128 + 16 * w + 4 * g, acc);
        }
        hbf16x8 kA[2];
#pragma unroll
        for (int ks = 0; ks < 2; ++ks) kA[ks] = *(const LAS hbf16x8*)(KT + HC_SW(16 * w + i, 32 * ks + 8 * g));
#pragma unroll
        for (int vb = 0; vb < 8; ++vb) {
            f32x4 acc = {0.f, 0.f, 0.f, 0.f};
#pragma unroll
            for (int ks = 0; ks < 2; ++ks) acc = __builtin_amdgcn_mfma_f32_16x16x32_bf16(*(const LAS hbf16x8*)(VT + HC_SW(16 * vb + i, 32 * ks + 8 * g)), kA[ks], acc, 0, 0, 0);
            st4bf((bf16*)HU + (size_t)unit * 16384 + (16 * w + i) * 128 + 16 * vb + 4 * g, acc);
        }
    }
    __syncthreads();
}
__device__ __forceinline__ void hgrn_sample_unit(const Args& A, Frame& F, int e, int bs, int h) {
    const int tid = F.tid;
    const bf16* PROJ = (const bf16*)(A.ws + WS_PROJ); bf16* YIN = (bf16*)(A.ws + WS_YIN);
    LAS float* sq = (LAS float*)F.lds; LAS float* sf = sq + 512; LAS float* sk = sf + 512; LAS float* po = sk + 512; LAS float* pn = po + 2048;
    const int mrow = MP + bs * TS;
    { const int t = tid >> 7, k = tid & 127; const bf16* pr = PROJ + (size_t)(mrow + t) * NEV + PRW + h * 128 + k;
      const float qv = bf2f(pr[0]), fv = bf2f(pr[1024]), lb = hg_lb(A, e, h * 128 + k);
      sq[tid] = silu_(qv); sf[tid] = lb + (1.0f - lb) * sigm(fv); sk[tid] = (1.0f - lb) * sigm(-fv); }
    const int v = tid & 127, kq = tid >> 7;
    const size_t sbase = (((size_t)(bs * 2 + e) * 8 + h) * 128) * 128;
    float S[32];
#pragma unroll
    for (int j = 0; j < 32; ++j) S[j] = A.in[4][sbase + (size_t)(32 * kq + j) * 128 + v];
    float vt[4];
#pragma unroll
    for (int t = 0; t < 4; ++t) vt[t] = bf2f(PROJ[(size_t)(mrow + t) * NEV + PRW + 2048 + h * 128 + v]);
    __syncthreads();
#pragma unroll
    for (int t = 0; t < 4; ++t) { float o = 0.f;
#pragma unroll
        for (int j = 0; j < 32; ++j) { const int k = t * 128 + 32 * kq + j; S[j] = sf[k] * S[j] + sk[k] * vt[t]; o += S[j] * sq[k]; }
        po[(t * 4 + kq) * 128 + v] = o; }
    __syncthreads();
    { const int t = tid >> 7; const float o = (po[(t * 4 + 0) * 128 + v] + po[(t * 4 + 1) * 128 + v]) + (po[(t * 4 + 2) * 128 + v] + po[(t * 4 + 3) * 128 + v]);
      const float ss = wave_sum(o * o); if (F.lane == 0) pn[F.wave] = ss;
      __syncthreads();
      const float tot = pn[(F.wave & ~1)] + pn[(F.wave | 1)];
      const size_t m = (size_t)(mrow + t);
      const float og = bf2f(PROJ[m * NEV + PRW + 3072 + h * 128 + v]);
      const float y = o * (1.0f / sqrtf(tot * (1.0f / 128.0f) + 1e-5f)) * PARP(PAR_HGN)[e * 1024 + h * 128 + v] * silu_(og);
      YIN[m * D + 1024 + h * 128 + v] = (bf16)f2bf(y); }
    float* so = AOUT + O_SHGRN + sbase;
#pragma unroll
    for (int j = 0; j < 32; ++j) so[(size_t)(32 * kq + j) * 128 + v] = S[j];
    __syncthreads();
}
__device__ __forceinline__ void hgrn_state_scan(const Args& A, Frame& F, int e) {
    float* HU = (float*)(A.ws + WS_HU); const float* HD = (const float*)(A.ws + WS_HD);
    const int gt = F.blk * NTHR + F.tid, NGT = F.G * NTHR;
    for (int idx = gt; idx < BP * 8 * 128 * 32; idx += NGT) {
        const int v4 = (idx & 31) * 4, k = (idx >> 5) & 127, bh = idx >> 12;
        f32x4 S = {0.f, 0.f, 0.f, 0.f};
#pragma unroll 1
        for (int c0 = 0; c0 < 32; c0 += 8) {
            f32x4 u[8]; float dcy[8];
#pragma unroll
            for (int q = 0; q < 8; ++q) { const int unit = bh * 32 + c0 + q; u[q] = ldp4((const bf16*)HU + (size_t)unit * 16384 + k * 128 + v4); dcy[q] = HD[unit * 128 + k]; }
#pragma unroll
            for (int q = 0; q < 8; ++q) { const int unit = bh * 32 + c0 + q; st4bf((bf16*)HU + (size_t)unit * 16384 + k * 128 + v4, S); S = S * dcy[q] + u[q]; }
        }
        const int b = bh >> 3, h = bh & 7;
        *(f32x4*)(AOUT + O_PHGRN + (((size_t)(b * 2 + e) * 8 + h) * 128 + k) * 128 + v4) = S;
    }
}
struct HfRaw { v2u qt[4], hu[8]; };
__device__ __forceinline__ void hgrn_finish_load(const Args& A, Frame& F, int b, int h, int c, HfRaw& r) {
    const float* QT = (const float*)(A.ws + WS_QT); const float* HU = (const float*)(A.ws + WS_HU);
    const int tid = F.tid, m0 = b * TP + c * 64, unit = (b * 8 + h) * 32 + c;
#pragma unroll
    for (int it = 0; it < 4; ++it) { const int idx = tid + 512 * it, row = idx >> 5, c4 = (idx & 31) * 4; r.qt[it] = *(const v2u*)((const bf16*)QT + (size_t)(m0 + row) * 1024 + h * 128 + c4); }
#pragma unroll
    for (int it = 0; it < 8; ++it) { const int idx = tid + 512 * it, row = idx >> 5, c4 = (idx & 31) * 4; r.hu[it] = *(const v2u*)((const bf16*)HU + (size_t)unit * 16384 + row * 128 + c4); }
}
__device__ __forceinline__ void hgrn_finish_unit(const Args& A, Frame& F, int e, int b, int h, int c, const HfRaw& raw, bool has_next, int nb, int nh, int nc, HfRaw& nraw) {
    const int tid = F.tid, lane = F.lane, w = F.wave, g = lane >> 4, i = lane & 15;
    const bf16* PROJ = (const bf16*)(A.ws + WS_PROJ); const float* OI = (const float*)(A.ws + WS_OI); bf16* YIN = (bf16*)(A.ws + WS_YIN);
    LAS float* Qt = (LAS float*)F.lds; LAS float* Ss = Qt + 64 * HG_S; LAS float* Os = Ss + 128 * HG_VS;
    LAS unsigned short* QtB = (LAS unsigned short*)Qt;
    const int m0 = b * TP + c * 64;
#pragma unroll
    for (int it = 0; it < 4; ++it) { const int idx = tid + 512 * it, row = idx >> 5, c4 = (idx & 31) * 4; *(LAS v2u*)(QtB + row * 136 + c4) = raw.qt[it]; }
#pragma unroll
    for (int it = 0; it < 8; ++it) { const int idx = tid + 512 * it, row = idx >> 5, c4 = (idx & 31) * 4; *(LAS f32x4*)(Ss + row * HG_VS + c4) = cvq(raw.hu[it]); }
    __syncthreads();
    v2u oi[4];
#pragma unroll
    for (int tb = 0; tb < 4; ++tb) oi[tb] = *(const v2u*)((const bf16*)OI + (size_t)(m0 + 16 * tb + i) * 1024 + h * 128 + 16 * w + 4 * g);
    const int t = tid >> 3, vg = tid & 7; const size_t m = (size_t)(m0 + t);
    f32x4 og[4], gn[4];
#pragma unroll
    for (int jj = 0; jj < 4; ++jj) { const int ch = h * 128 + 4 * vg + 32 * jj; og[jj] = ldp4(PROJ + m * NEV + PRW + 3072 + ch); gn[jj] = ld4(PARP(PAR_HGN) + e * 1024 + ch); }
    if (has_next) hgrn_finish_load(A, F, nb, nh, nc, nraw);
    {
        hbf16x8 sB[4];
#pragma unroll
        for (int ks = 0; ks < 4; ++ks) sB[ks] = pack8_strided(Ss + (32 * ks + 8 * g) * HG_VS + 16 * w + i, HG_VS);
#pragma unroll
        for (int tb = 0; tb < 4; ++tb) {
            f32x4 acc = cvq(oi[tb]);
#pragma unroll
            for (int ks = 0; ks < 4; ++ks) acc = __builtin_amdgcn_mfma_f32_16x16x32_bf16(sB[ks], *(const LAS hbf16x8*)(QtB + (16 * tb + i) * 136 + 32 * ks + 8 * g), acc, 0, 0, 0);
            *(LAS f32x4*)(Os + (16 * tb + i) * HG_VS + 16 * w + 4 * g) = acc;
        }
    }
    __syncthreads();
    f32x4 acc[4]; float ss = 0.f;
#pragma unroll
    for (int jj = 0; jj < 4; ++jj) {
#pragma unroll
        for (int q = 0; q < 4; ++q) acc[jj][q] = Os[t * HG_VS + 4 * vg + 32 * jj + q];
        ss += (acc[jj][0] * acc[jj][0] + acc[jj][1] * acc[jj][1]) + (acc[jj][2] * acc[jj][2] + acc[jj][3] * acc[jj][3]); }
    const float rs = 1.0f / sqrtf(red8(ss) * (1.0f / 128.0f) + 1e-5f);
#pragma unroll
    for (int jj = 0; jj < 4; ++jj) { const int ch = h * 128 + 4 * vg + 32 * jj; f32x4 y;
#pragma unroll
        for (int q = 0; q < 4; ++q) y[q] = acc[jj][q] * rs * gn[jj][q] * silu_(og[jj][q]);
        st4bf(YIN + m * D + 1024 + ch, y); }
    __syncthreads();
}

__device__ __forceinline__ f32x4 oddin_sample4(const Args& A, int m, int col) {
    const bf16* sl = (const bf16*)(A.ws + WS_OSLAB) + (size_t)((((m - MP) >> 8) * 16 + (col >> 8)) * 8) * 65536 + ((m - MP) & 255) * 256 + (col & 255);
    f32x4 s = {0.f, 0.f, 0.f, 0.f};
#pragma unroll
    for (int p = 0; p < 8; ++p) s += ldp4(sl + (size_t)p * 65536);
    return s * ((const float*)(A.ws + WS_RSTD))[m];
}
__device__ __forceinline__ void o2_conv(const Args& A, Frame& F, int o_) {
    const bf16* XB = (const bf16*)(A.ws + WS_XB); bf16* XCB = (bf16*)(A.ws + WS_XCB); const bool split = F.G == 256;
    const int gt = F.blk * NTHR + F.tid, NGT = F.G * NTHR;
    if (split) for (int idx = gt; idx < (MP / 32) * 512; idx += NGT) {
        const int ch = (idx & 511) * 4, m0 = (idx >> 9) * 32, t0 = m0 & (TP - 1);
        const f32x4 cb = ld4(PARP(PAR_CONVB) + o_ * 2048 + ch); f32x4 cw[4];
#pragma unroll
        for (int j = 0; j < 4; ++j) cw[j] = ld4(PARP(PAR_CONVW) + (size_t)(o_ * 4 + j) * 2048 + ch);
        f32x4 w0 = {0.f, 0.f, 0.f, 0.f}, w1 = w0, w2 = w0;
        if (t0 > 0) { w0 = ldp4(XB + (size_t)(m0 - 3) * 2048 + ch); w1 = ldp4(XB + (size_t)(m0 - 2) * 2048 + ch); w2 = ldp4(XB + (size_t)(m0 - 1) * 2048 + ch); }
#pragma unroll
        for (int r0 = 0; r0 < 32; r0 += 16) {
            f32x4 x[16];
#pragma unroll
            for (int q = 0; q < 16; ++q) x[q] = ldp4(XB + (size_t)(m0 + r0 + q) * 2048 + ch);
#pragma unroll
            for (int q = 0; q < 16; ++q) { st4bf(XCB + (size_t)(m0 + r0 + q) * 2048 + ch, cb + w0 * cw[0] + w1 * cw[1] + w2 * cw[2] + x[q] * cw[3]); w0 = w1; w1 = w2; w2 = x[q]; }
        }
    }
    else for (int idx = gt; idx < M * 512; idx += NGT) {
        const int ch = (idx & 511) * 4, m = idx >> 9;
        int t, bs; if (m < MP) { t = m & (TP - 1); bs = -1; } else { t = (m - MP) & 3; bs = (m - MP) >> 2; }
        f32x4 acc = ld4(PARP(PAR_CONVB) + o_ * 2048 + ch);
#pragma unroll
        for (int j = 0; j < 4; ++j) { const int ti = t + j - 3; f32x4 x;
            if (ti >= 0) x = (split && m >= MP) ? oddin_sample4(A, m + j - 3, 2048 + ch) : ldp4(XB + (size_t)(m + j - 3) * 2048 + ch);
            else if (bs >= 0) x = ld4(A.in[5] + ((size_t)(bs * 2 + o_) * 3 + (ti + 3)) * 2048 + ch);
            else x = (f32x4){0.f, 0.f, 0.f, 0.f};
            acc += x * ld4(PARP(PAR_CONVW) + (size_t)(o_ * 4 + j) * 2048 + ch); }
        st4bf(XCB + (size_t)m * 2048 + ch, acc);
    }
    if (split) for (int idx = gt; idx < BS * 512; idx += NGT) {
        const int ch = (idx & 511) * 4, bs = idx >> 9, m0 = MP + bs * TS;
        f32x4 xr[7];
#pragma unroll
        for (int i = 0; i < 3; ++i) xr[i] = ld4(A.in[5] + ((size_t)(bs * 2 + o_) * 3 + i) * 2048 + ch);
#pragma unroll
        for (int t = 0; t < 4; ++t) xr[3 + t] = oddin_sample4(A, m0 + t, 2048 + ch);
        const f32x4 cb = ld4(PARP(PAR_CONVB) + o_ * 2048 + ch); f32x4 cw[4];
#pragma unroll
        for (int j = 0; j < 4; ++j) cw[j] = ld4(PARP(PAR_CONVW) + (size_t)(o_ * 4 + j) * 2048 + ch);
#pragma unroll
        for (int t = 0; t < 4; ++t) st4bf(XCB + (size_t)(m0 + t) * 2048 + ch, cb + xr[t] * cw[0] + xr[t + 1] * cw[1] + xr[t + 2] * cw[2] + xr[t + 3] * cw[3]);
#pragma unroll
        for (int i = 0; i < 3; ++i) *(f32x4*)(AOUT + O_SCONV + ((size_t)(bs * 2 + o_) * 3 + i) * 2048 + ch) = xr[4 + i];
    }
    for (int idx = gt; idx < (split ? BP : NSEQ) * 3 * 512; idx += NGT) {
        const int ch = (idx & 511) * 4, r = idx >> 9, i = r % 3, q = r / 3;
        const int T = q < BP ? TP : TS, row0 = q < BP ? q * TP : MP + (q - BP) * TS;
        float* o = AOUT + (q < BP ? O_PCONV + ((size_t)(q * 2 + o_) * 3 + i) * 2048 : O_SCONV + ((size_t)((q - BP) * 2 + o_) * 3 + i) * 2048) + ch;
        *(f32x4*)o = (split && q >= BP) ? oddin_sample4(A, row0 + T - 3 + i, 2048 + ch) : ldp4(XB + (size_t)(row0 + T - 3 + i) * 2048 + ch);
    }
}
__device__ __forceinline__ f32x2 lru_a(const float* LA_, size_t o) { const unsigned w = *(const unsigned*)((const bf16*)LA_ + o); return (f32x2){__expf(bf2f(w & 0xffffu)), __expf(bf2f(w >> 16))}; }
__device__ __forceinline__ f32x2 lru_b(const float* LB_, size_t o) { const unsigned w = *(const unsigned*)((const bf16*)LB_ + o); return (f32x2){bf2f(w & 0xffffu), bf2f(w >> 16)}; }
__device__ __forceinline__ void o4_tail(const Args& A, Frame& F) {
    const float* LA_ = (const float*)(A.ws + WS_LRA); const float* LB_ = (const float*)(A.ws + WS_LRB); float* CP = (float*)(A.ws + WS_CP); float* CHh = (float*)(A.ws + WS_CH);
    __syncthreads();
    const int half = F.tid & 1, cp = (F.tid >> 1) & 63, chunk = F.tid >> 7;
#pragma unroll 1
    for (int L = F.blk; L < 32 * 16; L += F.G) {
        const int pm = L >> 4, pn = L & 15; const int ch = pn * 128 + cp * 2; const int b = pm >> 3, c = (pm & 7) * 4 + chunk;
        f32x2 P = {1.f, 1.f}, H = {0.f, 0.f}; const size_t r0 = (size_t)(pm * 256 + chunk * 64 + half * 32) * 2048 + ch;
#pragma unroll 1
        for (int t0 = 0; t0 < 32; t0 += 8) {
            f32x2 a8[8], b8[8];
#pragma unroll
            for (int q = 0; q < 8; ++q) { a8[q] = lru_a(LA_, r0 + (size_t)(t0 + q) * 2048); b8[q] = lru_b(LB_, r0 + (size_t)(t0 + q) * 2048); }
#pragma unroll
            for (int q = 0; q < 8; ++q) { H = a8[q] * H + b8[q]; P = P * a8[q]; }
        }
        f32x2 Po, Ho; Po.x = __shfl_xor(P.x, 1); Po.y = __shfl_xor(P.y, 1); Ho.x = __shfl_xor(H.x, 1); Ho.y = __shfl_xor(H.y, 1);
        if (half == 0) { *(f32x2*)(CP + (size_t)(b * 32 + c) * 2048 + ch) = P * Po; *(f32x2*)(CHh + (size_t)(b * 32 + c) * 2048 + ch) = Po * H + Ho; }
    }
}
__device__ __forceinline__ void o4_lru_chunks(const Args& A, Frame& F) {
    const float* LA_ = (const float*)(A.ws + WS_LRA); const float* LB_ = (const float*)(A.ws + WS_LRB); float* CP = (float*)(A.ws + WS_CP); float* CHh = (float*)(A.ws + WS_CH);
    const int gt = F.blk * NTHR + F.tid, NGT = F.G * NTHR;
    for (int idx = gt; idx < BP * 32 * 1024; idx += NGT) {
        const int ch = (idx & 1023) * 2, c = (idx >> 10) & 31, b = idx >> 15;
        f32x2 P = {1.f, 1.f}, H = {0.f, 0.f}; const size_t r0 = (size_t)(b * TP + c * 64) * 2048 + ch;
#pragma unroll 1
        for (int t0 = 0; t0 < 64; t0 += 8) {
            f32x2 a8[8], b8[8];
#pragma unroll
            for (int q = 0; q < 8; ++q) { a8[q] = lru_a(LA_, r0 + (size_t)(t0 + q) * 2048); b8[q] = lru_b(LB_, r0 + (size_t)(t0 + q) * 2048); }
#pragma unroll
            for (int q = 0; q < 8; ++q) { H = a8[q] * H + b8[q]; P = P * a8[q]; }
        }
        *(f32x2*)(CP + (size_t)(b * 32 + c) * 2048 + ch) = P; *(f32x2*)(CHh + (size_t)(b * 32 + c) * 2048 + ch) = H;
    }
}
__device__ __forceinline__ void o5_lru_scan(const Args& A, Frame& F, int o_) {
    const float* LA_ = (const float*)(A.ws + WS_LRA); const float* LB_ = (const float*)(A.ws + WS_LRB); const float* CP = (const float*)(A.ws + WS_CP); const float* CHh = (const float*)(A.ws + WS_CH);
    const bf16* GATE = (const bf16*)(A.ws + WS_GATE); bf16* YIN = (bf16*)(A.ws + WS_YIN);
    const int gt = F.blk * NTHR + F.tid, NGT = F.G * NTHR;
    for (int idx = gt; idx < BP * 32 * 1024 + BS * 1024; idx += NGT) {
        int ch, nt_; size_t r0; f32x2 H; float* so = nullptr;
        if (idx < BP * 32 * 1024) {
            ch = (idx & 1023) * 2; const int c = (idx >> 10) & 31, b = idx >> 15; H = (f32x2){0.f, 0.f};
#pragma unroll 1
            for (int cb = 0; cb < c; cb += 8) {
                f32x2 p8[8], h8[8];
#pragma unroll
                for (int q = 0; q < 8; ++q) { const int cc = (cb + q < c) ? cb + q : c - 1; const size_t o = (size_t)(b * 32 + cc) * 2048 + ch; p8[q] = *(const f32x2*)(CP + o); h8[q] = *(const f32x2*)(CHh + o); }
#pragma unroll
                for (int q = 0; q < 8; ++q) if (cb + q < c) H = p8[q] * H + h8[q];
            }
            r0 = (size_t)(b * TP + c * 64) * 2048 + ch; nt_ = 64; if (c == 31) so = AOUT + O_PLRU + (size_t)(b * 2 + o_) * 2048 + ch;
        } else {
            const int r = idx - BP * 32 * 1024; ch = (r & 1023) * 2; const int bs = r >> 10;
            H = *(const f32x2*)(A.in[6] + (size_t)(bs * 2 + o_) * 2048 + ch); r0 = (size_t)(MP + bs * TS) * 2048 + ch; nt_ = TS; so = AOUT + O_SLRU + (size_t)(bs * 2 + o_) * 2048 + ch;
        }
#pragma unroll 1
        for (int t0 = 0; t0 < nt_; t0 += 4) {
            f32x2 a4[4], b4[4]; unsigned g4[4];
#pragma unroll
            for (int q = 0; q < 4; ++q) { const size_t o = r0 + (size_t)(t0 + q) * 2048; a4[q] = lru_a(LA_, o); b4[q] = lru_b(LB_, o);
                if (F.G == 256 && idx >= BP * 32 * 1024) {
                    const int m = (int)(o >> 11); const bf16* sl = (const bf16*)(A.ws + WS_OSLAB) + (size_t)((((m - MP) >> 8) * 16 + (ch >> 8)) * 8) * 65536 + ((m - MP) & 255) * 256 + (ch & 255);
                    unsigned w8[8];
#pragma unroll
                    for (int p = 0; p < 8; ++p) w8[p] = *(const unsigned*)(sl + (size_t)p * 65536);
                    float s0 = 0.f, s1 = 0.f;
#pragma unroll
                    for (int p = 0; p < 8; ++p) { s0 += bf2f(w8[p] & 0xffffu); s1 += bf2f(w8[p] >> 16); }
                    const float rs = ((const float*)(A.ws + WS_RSTD))[m];
                    g4[q] = cvt_pk_bf16(pg8::gelu_tanh(s0 * rs), pg8::gelu_tanh(s1 * rs));
                } else g4[q] = *(const unsigned*)(GATE + o); }
#pragma unroll
            for (int q = 0; q < 4; ++q) { const size_t o = r0 + (size_t)(t0 + q) * 2048; H = a4[q] * H + b4[q];
                *(unsigned*)(YIN + o) = cvt_pk_bf16(H[0] * bf2f(g4[q] & 0xffffu), H[1] * bf2f(g4[q] >> 16)); }
        }
        if (so) *(f32x2*)so = H;
    }
}
#ifndef R1W_SHFL_SCAN
#define R1W_SHFL_SCAN 0
#endif
#ifndef R1W_LDS_TINV
#define R1W_LDS_TINV 1
#endif
#ifndef R1W_MASK
#define R1W_MASK 31
#endif
#define R1O_MASK (31 & ~R1W_MASK)

__device__ __forceinline__ f32x4 mm16(const LAS float* a, int sai, int sak, const LAS float* b, int sbk, int sbj, int K, f32x4 acc, int lane) {
    const int i = lane & 15, g = lane >> 4;
#pragma unroll
    for (int s = 0; s < K / 4; ++s) acc = __builtin_amdgcn_mfma_f32_16x16x4f32(a[i * sai + (4 * s + g) * sak], b[(4 * s + g) * sbk + i * sbj], acc, 0, 0, 0);
    return acc;
}
constexpr int R1_RS = 68, R1_TS = 20, R1_HSZ = 16064;
constexpr int R1_RT = 0, R1_KAP = 1088, R1_BT = 2176, R1_KT = 3264,
              R1_KAPT = 4352, R1_BTT = 5632, R1_KTT = 6912, R1_VVT = 8192, R1_TKT = 9472, R1_W1T = 10752, R1_LKVT = 12032,
              R1_LB = 13312, R1_LK = 13632, R1_MRK = 13952, R1_MRB = 14272, R1_TM = 14592, R1_GAM = 14912, R1_GC = 16000;
__device__ __forceinline__ f32x4 mm4(const LAS float* a, const LAS float* b, f32x4 acc) {
    const f32x4 av = *(const LAS f32x4*)a, bv = *(const LAS f32x4*)b;
#pragma unroll
    for (int s = 0; s < 4; ++s) acc = __builtin_amdgcn_mfma_f32_16x16x4f32(av[s], bv[s], acc, 0, 0, 0);
    return acc;
}
__device__ __forceinline__ v4u pack8(const f32x4& a, const f32x4& b) { v4u o; o.x = cvt_pk_bf16(a[0], a[1]); o.y = cvt_pk_bf16(a[2], a[3]); o.z = cvt_pk_bf16(b[0], b[1]); o.w = cvt_pk_bf16(b[2], b[3]); return o; }

struct R1Raw { f32x4 pr, pk, pv, qr, qk, qv, wd, wa; };
__device__ __forceinline__ void rwkv_r1_load(const Args& A, Frame& F, int b, int h, int cp, R1Raw& r) {
    const bf16* PROJ = (const bf16*)(A.ws + WS_PROJ); const float* WAG = (const float*)(A.ws + WS_WAG);
    const int tt = F.tid >> 4, cg = F.tid & 15, hc = h * 64 + 4 * cg, tabs = cp * 32 + tt; const size_t m = (size_t)b * TP + tabs;
    r.pr = ldp4(PROJ + m * NEV + hc); r.pk = ldp4(PROJ + m * NEV + 1024 + hc); r.pv = ldp4(PROJ + m * NEV + 2048 + hc);
    r.qr = (f32x4){0.f, 0.f, 0.f, 0.f}; r.qk = r.qr; r.qv = r.qr;
    if (tabs > 0) { r.qr = ldp4(PROJ + (m - 1) * NEV + hc); r.qk = ldp4(PROJ + (m - 1) * NEV + 1024 + hc); r.qv = ldp4(PROJ + (m - 1) * NEV + 2048 + hc); }
    r.wd = ld4(WAG + m * NLORA + hc); r.wa = ld4(WAG + m * NLORA + 1024 + hc);
}
__device__ __forceinline__ void rwkv_r1_unit(const Args& A, Frame& F, int e, int b, int h, int cp, const R1Raw& raw) {
    const int tid = F.tid, tt = tid >> 4, cg = tid & 15, ts = tt & 15;
    const int hf = F.wave >> 2, wl = F.wave & 3, lane = F.lane, g = lane >> 4, i = lane & 15;
    LAS float* HS = (LAS float*)F.lds + (tt >> 4) * R1_HSZ;
    LAS float* HM = (LAS float*)F.lds + hf * R1_HSZ;
    const int hc = h * 64 + 4 * cg;
#ifndef R1_REP12
#define R1_REP12 1
#endif
    for (int rp12 = 0; rp12 < R1_REP12; ++rp12) {
    const float* mu = PARP(PAR_MU) + (size_t)e * PRW;
    const f32x4 zr = raw.pr + (raw.qr - raw.pr) * ld4(mu + hc), zk = raw.pk + (raw.qk - raw.pk) * ld4(mu + 1024 + hc), zv = raw.pv + (raw.qv - raw.pv) * ld4(mu + 2048 + hc);
    f32x4 kk = zk * ld4(PARP(PAR_KK) + e * 1024 + hc);
    const float ss = red16((kk[0] * kk[0] + kk[1] * kk[1]) + (kk[2] * kk[2] + kk[3] * kk[3]));
    kk = kk * (1.0f / fmaxf(sqrtf(ss), 1e-12f));
    const f32x4 kp = zk * (1.0f + (raw.wa - 1.0f) * ld4(PARP(PAR_KA) + e * 1024 + hc)), bb = kk * raw.wa;
    *(LAS f32x4*)(HS + R1_GAM + ts * 68 + 4 * cg) = raw.wd;
    {
        const f32x4 rk = ld4(PARP(PAR_RK) + e * 1024 + hc);
        const float bonus = red16((zr[0] * kp[0] * rk[0] + zr[1] * kp[1] * rk[1]) + (zr[2] * kp[2] * rk[2] + zr[3] * kp[3] * rk[3]));
        if (R1O_MASK & 16) *(f32x4*)((float*)(A.ws + WS_WAG) + ((size_t)b * TP + cp * 32 + tt) * NLORA + hc) = zv * bonus;
    }
    __syncthreads();
    {
        f32x4 gm = {1.f, 1.f, 1.f, 1.f}, gp = gm;
#pragma unroll
        for (int j = 0; j < 16; ++j) { const f32x4 wv = *(const LAS f32x4*)(HS + R1_GAM + j * 68 + 4 * cg); if (j <= ts) gm *= wv; if (j < ts) gp *= wv; }
        f32x4 inv;
#pragma unroll
        for (int j = 0; j < 4; ++j) inv[j] = 1.0f / gm[j];
        const f32x4 rt = zr * gm, kap = kk * gp, bt = bb * inv, kt = kp * inv;
        LAS float* pn = HS + ts * R1_RS + 4 * cg;
        *(LAS f32x4*)(pn + R1_RT) = rt; *(LAS f32x4*)(pn + R1_KAP) = kap; *(LAS f32x4*)(pn + R1_BT) = bt; *(LAS f32x4*)(pn + R1_KT) = kt;
        LAS float* pt = HS + (4 * cg) * R1_TS + ts;
#pragma unroll
        for (int j = 0; j < 4; ++j) { pt[R1_KAPT + j * R1_TS] = kap[j]; pt[R1_BTT + j * R1_TS] = bt[j]; pt[R1_KTT + j * R1_TS] = kt[j]; pt[R1_VVT + j * R1_TS] = zv[j]; }
        if (ts == 15) *(LAS f32x4*)(HS + R1_GC + 4 * cg) = gm;
    }
    __syncthreads();
    }
    const f32x4 z4 = {0.f, 0.f, 0.f, 0.f};
#define R1_ROWN(arr_, r_) (HM + (arr_) + (r_) * R1_RS + 16 * g)
#define R1_COLT(arr_, c_) (HM + (arr_) + (c_) * R1_TS + 4 * g)
#define R1_ROWM(arr_, r_) (HM + (arr_) + (r_) * R1_TS + 4 * g)
    {
        const LAS float* a = R1_ROWN((wl < 2) ? R1_KAP : R1_RT, i); const LAS float* bm = R1_ROWN((wl & 1) ? R1_KT : R1_BT, i);
        f32x4 d = z4;
#pragma unroll
        for (int q = 0; q < 4; ++q) d = mm4(a + 4 * q, bm + 4 * q, d);
        LAS float* o = HM + (wl == 0 ? R1_LB : (wl == 1 ? R1_LK : (wl == 2 ? R1_MRB : R1_MRK)));
#pragma unroll
        for (int r = 0; r < 4; ++r) { const int t = 4 * g + r; const bool keep = (wl < 2) ? (i < t) : (i <= t); o[t * R1_TS + i] = keep ? d[r] : 0.f; }
    }
    __syncthreads();
    {
        const f32x4 d = mm4(R1_ROWM(R1_LK, i), R1_COLT(R1_VVT, 16 * wl + i), z4);
        *(LAS f32x4*)(HM + R1_LKVT + (16 * wl + i) * R1_TS + 4 * g) = d;
        if (wl == 0) { float tr[16];
#pragma unroll
            for (int t = 0; t < 16; ++t) { float v = (t == i) ? 1.0f : 0.0f;
#pragma unroll
                for (int j = 0; j < t; ++j) v -= HM[R1_LB + t * R1_TS + j] * tr[j];
                tr[t] = v; HM[R1_TM + t * R1_TS + i] = v; } }
    }
    __syncthreads();
    {
        const f32x4 d1 = mm4(R1_ROWM(R1_TM, i), R1_COLT(R1_KAPT, 16 * wl + i), z4), d2 = mm4(R1_ROWM(R1_TM, i), R1_COLT(R1_LKVT, 16 * wl + i), z4);
        *(LAS f32x4*)(HM + R1_TKT + (16 * wl + i) * R1_TS + 4 * g) = d1; *(LAS f32x4*)(HM + R1_W1T + (16 * wl + i) * R1_TS + 4 * g) = d2;
    }
    __syncthreads();
    {
        const size_t cid = ((size_t)(b * 16 + h) * 128 + cp * 2 + hf);
        const size_t mrow = (size_t)b * TP + cp * 32 + hf * 16;
        {
            const f32x4 d1 = mm4(R1_COLT(R1_VVT, 16 * wl + i), R1_ROWM(R1_MRK, i), z4), d2 = mm4(R1_COLT(R1_W1T, 16 * wl + i), R1_ROWM(R1_MRB, i), z4);
            if (R1O_MASK & 1) *(f32x4*)((float*)(A.ws + WS_OB) + (mrow + i) * 1024 + h * 64 + 16 * wl + 4 * g) = d1 - d2;
        }
        if (wl < 2) {
            f32x4 q[2];
#pragma unroll
            for (int c2 = 0; c2 < 2; ++c2) { const int a = 2 * wl + c2; const f32x4 d = mm4(R1_COLT(R1_TKT, 16 * a + i), R1_ROWM(R1_MRB, i), z4);
                q[c2] = *(const LAS f32x4*)(HM + R1_RT + i * R1_RS + 16 * a + 4 * g) - d; }
            if (R1O_MASK & 2) *(v4u*)((bf16*)(A.ws + WS_RQ) + ((cid * 2 + wl) * 64 + lane) * 8) = pack8(q[0], q[1]);
        }
        const float gci = HM[R1_GC + 16 * wl + i];
#pragma unroll
        for (int kp2 = 0; kp2 < 2; ++kp2) {
            f32x4 q[2];
#pragma unroll
            for (int c2 = 0; c2 < 2; ++c2) { const int a = 2 * kp2 + c2; const f32x4 d = mm4(R1_COLT(R1_TKT, 16 * a + i), R1_COLT(R1_BTT, 16 * wl + i), z4);
#pragma unroll
                for (int r = 0; r < 4; ++r) q[c2][r] = (((a == wl && 4 * g + r == i) ? 1.0f : 0.0f) - d[r]) * gci; }
            if (R1O_MASK & 4) *(v4u*)((bf16*)(A.ws + WS_PST) + (((cid * 4 + wl) * 2 + kp2) * 64 + lane) * 8) = pack8(q[0], q[1]);
        }
        const f32x4 gcr = *(const LAS f32x4*)(HM + R1_GC + 16 * wl + 4 * g);
#pragma unroll
        for (int a = 0; a < 4; ++a) {
            const f32x4 d1 = mm4(R1_COLT(R1_KTT, 16 * wl + i), R1_COLT(R1_VVT, 16 * a + i), z4), d2 = mm4(R1_COLT(R1_BTT, 16 * wl + i), R1_COLT(R1_W1T, 16 * a + i), z4);
            if (R1O_MASK & 8) *(f32x4*)((float*)(A.ws + WS_QST) + (((cid * 4 + a) * 4 + wl) * 64 + lane) * 4) = (d1 - d2) * gcr;
        }
    }
#undef R1_ROWN
#undef R1_COLT
#undef R1_ROWM
    __syncthreads();
}

template <int CTRL> __device__ __forceinline__ float dpp1(float v) {
    return __builtin_bit_cast(float, __builtin_amdgcn_update_dpp(0x3f800000, __builtin_bit_cast(int, v), CTRL, 0xf, 0xf, false)); }
__device__ __forceinline__ f32x4 mmr(const f32x4& av, const f32x4& bv, f32x4 acc) {
#pragma unroll
    for (int s = 0; s < 4; ++s) acc = __builtin_amdgcn_mfma_f32_16x16x4f32(av[s], bv[s], acc, 0, 0, 0);
    return acc;
}
typedef short bf16x4_ __attribute__((ext_vector_type(4)));
__device__ __forceinline__ bf16x4_ tobf4(const f32x4& v) { v2u w; w.x = cvt_pk_bf16(v[0], v[1]); w.y = cvt_pk_bf16(v[2], v[3]); return __builtin_bit_cast(bf16x4_, w); }
constexpr int R1W_LDS = 19200;
constexpr int R1W_GC = 4352, R1W_PARS = 4416;
struct R1WRaw { v2u pr[4], pk[4], pv[4], qr[4], qk[4], qv[4], wd[4], wa[4]; };
__device__ __forceinline__ f32x4 cv4(const v2u w) { return (f32x4){bf2f(w.x & 0xffffu), bf2f(w.x >> 16), bf2f(w.y & 0xffffu), bf2f(w.y >> 16)}; }
__device__ __forceinline__ void rwkv_r1w_load(const Args& A, int lane, int b, int h, int c, R1WRaw& r) {
    const bf16* PROJ = (const bf16*)(A.ws + WS_PROJ); const float* WAG = (const float*)(A.ws + WS_WAG);
    const int g = lane >> 4, i = lane & 15, tabs = c * 16 + i, hc = h * 64 + 4 * g; const size_t m = (size_t)b * TP + tabs, mq = tabs > 0 ? m - 1 : m;
#pragma unroll
    for (int a = 0; a < 4; ++a) { r.pr[a] = *(const v2u*)(PROJ + m * NEV + hc + 16 * a); r.pk[a] = *(const v2u*)(PROJ + m * NEV + 1024 + hc + 16 * a); r.pv[a] = *(const v2u*)(PROJ + m * NEV + 2048 + hc + 16 * a);
        r.qr[a] = *(const v2u*)(PROJ + mq * NEV + hc + 16 * a); r.qk[a] = *(const v2u*)(PROJ + mq * NEV + 1024 + hc + 16 * a); r.qv[a] = *(const v2u*)(PROJ + mq * NEV + 2048 + hc + 16 * a);
        r.wd[a] = *(const v2u*)((const bf16*)WAG + m * NLORA + hc + 16 * a); r.wa[a] = *(const v2u*)((const bf16*)WAG + m * NLORA + 1024 + hc + 16 * a); }
}
__device__ __forceinline__ void rwkv_r1w_unit(const Args& A, Frame& F, int e, int b, int h, int c, const R1WRaw& raw, bool has_next, int nb, int nc, R1WRaw& nraw) {
    const int lane = F.lane, g = lane >> 4, i = lane & 15;
    LAS float* WL = (LAS float*)(F.lds + __builtin_amdgcn_readfirstlane(F.wave) * R1W_LDS);
    float* WAG = (float*)(A.ws + WS_WAG);
    const int tabs = c * 16 + i, hc = h * 64 + 4 * g; const size_t m = (size_t)b * TP + tabs;
    const f32x4 z4 = {0.f, 0.f, 0.f, 0.f};
    const LAS float* PS = WL + R1W_PARS + 4 * g;
    f32x4 zr[4], zk[4], zv[4], wd[4], wa[4];
#pragma unroll
    for (int a = 0; a < 4; ++a) {
        const f32x4 pr = cv4(raw.pr[a]), pk = cv4(raw.pk[a]), pv = cv4(raw.pv[a]);
        f32x4 qr = cv4(raw.qr[a]), qk = cv4(raw.qk[a]), qv = cv4(raw.qv[a]);
        if (tabs == 0) { qr = z4; qk = z4; qv = z4; }
        zr[a] = pr + (qr - pr) * *(const LAS f32x4*)(PS + 16 * a); zk[a] = pk + (qk - pk) * *(const LAS f32x4*)(PS + 64 + 16 * a); zv[a] = pv + (qv - pv) * *(const LAS f32x4*)(PS + 128 + 16 * a);
        { const f32x4 lw = cv4(raw.wd[a]); wd[a] = (f32x4){__expf(lw[0]), __expf(lw[1]), __expf(lw[2]), __expf(lw[3])}; } wa[a] = cv4(raw.wa[a]);
    }
    f32x4 rt[4], kap[4], bt[4], kt[4], gcr[4];
    {
        f32x4 kk[4], kp[4]; float ss = 0.f, bon = 0.f;
#pragma unroll
        for (int a = 0; a < 4; ++a) { kk[a] = zk[a] * *(const LAS f32x4*)(PS + 192 + 16 * a); ss += (kk[a][0] * kk[a][0] + kk[a][1] * kk[a][1]) + (kk[a][2] * kk[a][2] + kk[a][3] * kk[a][3]); }
        ss += __shfl_xor(ss, 16); ss += __shfl_xor(ss, 32);
        const float rn = 1.0f / fmaxf(sqrtf(ss), 1e-12f);
#pragma unroll
        for (int a = 0; a < 4; ++a) { kk[a] = kk[a] * rn; kp[a] = zk[a] * (1.0f + (wa[a] - 1.0f) * *(const LAS f32x4*)(PS + 256 + 16 * a));
            const f32x4 rk = *(const LAS f32x4*)(PS + 320 + 16 * a); const f32x4 t3 = zr[a] * kp[a] * rk; bon += (t3[0] + t3[1]) + (t3[2] + t3[3]); }
        bon += __shfl_xor(bon, 16); bon += __shfl_xor(bon, 32);
        if (R1W_MASK & 16)
#pragma unroll
        for (int a = 0; a < 4; ++a) st4bf((bf16*)WAG + m * NLORA + hc + 16 * a, zv[a] * bon);
#pragma unroll
        for (int a = 0; a < 4; ++a) {
            f32x4 gm, gp;
#if R1W_SHFL_SCAN
            gm = (f32x4){1.f, 1.f, 1.f, 1.f}; gp = gm;
            *(LAS f32x4*)(WL + i * 68 + 16 * a + 4 * g) = wd[a];
#pragma unroll
            for (int j = 0; j < 16; ++j) { const f32x4 wv = *(const LAS f32x4*)(WL + j * 68 + 16 * a + 4 * g); if (j <= i) gm *= wv; if (j < i) gp *= wv; }
#else
#pragma unroll
            for (int r = 0; r < 4; ++r) { float x = wd[a][r]; x *= dpp1<0x111>(x); x *= dpp1<0x112>(x); x *= dpp1<0x114>(x); x *= dpp1<0x118>(x); gm[r] = x; gp[r] = dpp1<0x111>(x); }
#endif
            f32x4 inv;
#pragma unroll
            for (int r = 0; r < 4; ++r) inv[r] = __builtin_amdgcn_rcpf(gm[r]);
            rt[a] = zr[a] * gm; kap[a] = kk[a] * gp; bt[a] = kk[a] * wa[a] * inv; kt[a] = kp[a] * inv;
            if (i == 15) *(LAS f32x4*)(WL + R1W_GC + 16 * a + 4 * g) = gm;
        }
    }
#pragma unroll
    for (int a = 0; a < 4; ++a) { LAS float* pw = WL + i * 68 + 16 * a + 4 * g;
        *(LAS f32x4*)(pw) = zv[a]; *(LAS f32x4*)(pw + 1088) = kap[a]; *(LAS f32x4*)(pw + 2176) = bt[a]; *(LAS f32x4*)(pw + 3264) = kt[a]; }
    f32x4 Lb = z4, Lk = z4, Mrb = z4, Mrk = z4, LbD = z4;
#pragma unroll
    for (int a = 0; a < 4; ++a) { LbD = mmr(kap[a], bt[a], LbD); Lb = mmr(bt[a], kap[a], Lb); Lk = mmr(kt[a], kap[a], Lk); Mrb = mmr(bt[a], rt[a], Mrb); Mrk = mmr(kt[a], rt[a], Mrk); }
#pragma unroll
    for (int r = 0; r < 4; ++r) { const int sc = 4 * g + r; if (!(sc < i)) { Lb[r] = 0.f; Lk[r] = 0.f; } if (!(sc <= i)) { Mrb[r] = 0.f; Mrk[r] = 0.f; } if (!(i < sc)) LbD[r] = 0.f; }
    f32x4 VT[4], KAPT[4], BTT[4], KTT[4]; float gci[4];
#pragma unroll
    for (int a = 0; a < 4; ++a) {
#pragma unroll
        for (int s = 0; s < 4; ++s) { const LAS float* pr_ = WL + (4 * g + s) * 68 + 16 * a + i; VT[a][s] = pr_[0]; KAPT[a][s] = pr_[1088]; BTT[a][s] = pr_[2176]; KTT[a][s] = pr_[3264]; }
        gci[a] = WL[R1W_GC + 16 * a + i]; gcr[a] = *(const LAS f32x4*)(WL + R1W_GC + 16 * a + 4 * g);
    }
    f32x4 LKVT[4];
#pragma unroll
    for (int a = 0; a < 4; ++a) LKVT[a] = mmr(Lk, VT[a], z4);
    f32x4 Trow;
    {
        f32x4 idm;
#pragma unroll
        for (int r = 0; r < 4; ++r) idm[r] = (4 * g + r == i) ? 1.0f : 0.0f;
        const f32x4 L2D = mmr(Lb, LbD, z4), L2r = mmr(LbD, Lb, z4);
        const f32x4 L4D = mmr(L2r, L2D, z4), L4r = mmr(L2D, L2r, z4);
        const f32x4 L8D = mmr(L4r, L4D, z4);
        const f32x4 X1 = mmr(L2D + idm, idm - Lb, z4), X2 = mmr(L4D + idm, X1, z4);
        Trow = mmr(L8D + idm, X2, z4);
    }
    f32x4 TKT[4], W1T[4];
#pragma unroll
    for (int a = 0; a < 4; ++a) { TKT[a] = mmr(Trow, KAPT[a], z4); W1T[a] = mmr(Trow, LKVT[a], z4); }
    __builtin_amdgcn_sched_barrier(0);
    if (has_next) rwkv_r1w_load(A, lane, nb, h, nc, nraw);
    __builtin_amdgcn_sched_barrier(0);
    const size_t cid = (size_t)(b * 16 + h) * 128 + c; const size_t mrow = (size_t)b * TP + c * 16;
#pragma unroll
    for (int wl = 0; wl < 4; ++wl) {
        const f32x4 d1 = mmr(VT[wl], Mrk, z4), d2 = mmr(W1T[wl], Mrb, z4);
        if (R1W_MASK & 1) st4bf((bf16*)(A.ws + WS_OB) + (mrow + i) * 1024 + h * 64 + 16 * wl + 4 * g, d1 - d2);
    }
#pragma unroll
    for (int w2 = 0; w2 < 2; ++w2) {
        const f32x4 q0 = rt[2 * w2] - mmr(TKT[2 * w2], Mrb, z4), q1 = rt[2 * w2 + 1] - mmr(TKT[2 * w2 + 1], Mrb, z4);
        if (R1W_MASK & 2) *(v4u*)((bf16*)(A.ws + WS_RQ) + ((cid * 2 + w2) * 64 + lane) * 8) = pack8(q0, q1);
    }
    bf16x4_ TKb[4], BTb[4], nBTb[4], KTb[4], VTb[4], W1b[4];
#pragma unroll
    for (int a = 0; a < 4; ++a) { TKb[a] = tobf4(TKT[a]); BTb[a] = tobf4(BTT[a]); nBTb[a] = tobf4(z4 - BTT[a]); KTb[a] = tobf4(KTT[a]); VTb[a] = tobf4(VT[a]); W1b[a] = tobf4(W1T[a]); }
#pragma unroll
    for (int wl = 0; wl < 4; ++wl) {
#pragma unroll
        for (int kp2 = 0; kp2 < 2; ++kp2) {
            f32x4 q[2];
#pragma unroll
            for (int c2 = 0; c2 < 2; ++c2) { const int a = 2 * kp2 + c2; const f32x4 d = __builtin_amdgcn_mfma_f32_16x16x16bf16_1k(TKb[a], BTb[wl], z4, 0, 0, 0);
#pragma unroll
                for (int r = 0; r < 4; ++r) q[c2][r] = (((a == wl && 4 * g + r == i) ? 1.0f : 0.0f) - d[r]) * gci[wl]; }
            if (R1W_MASK & 4) *(v4u*)((bf16*)(A.ws + WS_PST) + (((cid * 4 + wl) * 2 + kp2) * 64 + lane) * 8) = pack8(q[0], q[1]);
        }
#pragma unroll
        for (int a = 0; a < 4; ++a) {
            f32x4 d = __builtin_amdgcn_mfma_f32_16x16x16bf16_1k(KTb[wl], VTb[a], z4, 0, 0, 0);
            d = __builtin_amdgcn_mfma_f32_16x16x16bf16_1k(nBTb[wl], W1b[a], d, 0, 0, 0);
            if (R1W_MASK & 8) { const f32x4 qv_ = d * gcr[wl]; v2u qp_; qp_.x = cvt_pk_bf16(qv_[0], qv_[1]); qp_.y = cvt_pk_bf16(qv_[2], qv_[3]);
                *(v2u*)((bf16*)(A.ws + WS_QST) + (((cid * 4 + a) * 4 + wl) * 64 + lane) * 4) = qp_; }
        }
    }
}
__device__ __forceinline__ void rwkv_r1w_phase(const Args& A, Frame& F, int e) {
    const int NGW = F.G * NWAVES, gw = F.blk * NWAVES + F.wave, NU = BP * 16 * 128;
    if (gw >= NU) return;
    const int h = (gw >> 7) & 15;
    {
        LAS float* WL = (LAS float*)(F.lds + __builtin_amdgcn_readfirstlane(F.wave) * R1W_LDS);
        const float* mu = PARP(PAR_MU) + (size_t)e * PRW; const int hl = h * 64 + F.lane;
        const float p0 = mu[hl], p1 = mu[1024 + hl], p2 = mu[2048 + hl], p3 = PARP(PAR_KK)[e * 1024 + hl], p4 = PARP(PAR_KA)[e * 1024 + hl], p5 = PARP(PAR_RK)[e * 1024 + hl];
        __builtin_amdgcn_sched_barrier(0);
        WL[R1W_PARS + F.lane] = p0; WL[R1W_PARS + 64 + F.lane] = p1; WL[R1W_PARS + 128 + F.lane] = p2; WL[R1W_PARS + 192 + F.lane] = p3; WL[R1W_PARS + 256 + F.lane] = p4; WL[R1W_PARS + 320 + F.lane] = p5;
    }
    R1WRaw raw = {}, nraw = {};
    rwkv_r1w_load(A, F.lane, gw >> 11, h, gw & 127, raw);
#pragma unroll 1
    for (int u = gw; u < NU; u += NGW) { asm volatile("" : "+v"(F.lane)); const int un = u + NGW;
        rwkv_r1w_unit(A, F, e, u >> 11, h, u & 127, raw, un < NU, un >> 11, un & 127, nraw); raw = nraw; }
}

#ifndef R2_PF
#define R2_PF 0
#define R2_PF_AHEAD 6
#endif
#if R2_PF
#define R2_PROG(c_) do { if (F.tid == 0) prog[0] = (c_); } while (0)
#else
#define R2_PROG(c_) do { } while (0)
#endif
__device__ __forceinline__ void rwkv_r2_head(const Args& A, Frame& F, int e, int b, int h) {
    typedef short bf16x8 __attribute__((ext_vector_type(8)));
    const int w = F.wave, lane = F.lane, g = lane >> 4, i = lane & 15;
    const size_t cid0 = (size_t)(b * 16 + h) * 128;
    const bf16* PST = (const bf16*)(A.ws + WS_PST); const float* QST = (const float*)(A.ws + WS_QST); const bf16* RQS = (const bf16*)(A.ws + WS_RQ); float* OB = (float*)(A.ws + WS_OB);
#if R2_PF
    LAS volatile int* prog = (LAS volatile int*)(F.lds + 4096);
    if (F.tid == 0) prog[0] = 0;
    __syncthreads();
    if (F.wave >= 4) {
        const int pl = (F.wave - 4) * 64 + lane; unsigned sink = 0;
        const char* base; size_t stride;
        if (pl < 64) { base = (const char*)PST + cid0 * 8192 + pl * 128; stride = 8192; }
        else if (pl < 80) { base = (const char*)RQS + cid0 * 2048 + (pl - 64) * 128; stride = 2048; }
        else if (pl < 208) { base = (const char*)QST + cid0 * 16384 + (pl - 80) * 128; stride = 16384; }
        else { const int r = ((pl - 208) >> 1) & 15, hf = (pl - 208) & 1; base = (const char*)OB + (((size_t)b * TP + r) * 1024 + h * 64) * 4 + hf * 128; stride = 65536; }
#pragma unroll 1
        for (int c0 = 0; c0 < 128; c0 += 8) {
            while (prog[0] + R2_PF_AHEAD < c0) __builtin_amdgcn_s_sleep(8);
            if (pl < 240) { unsigned v[8];
#pragma unroll
                for (int q = 0; q < 8; ++q) v[q] = *(const unsigned*)(base + (size_t)(c0 + q) * stride);
#pragma unroll
                for (int q = 0; q < 8; ++q) sink += v[q]; }
        }
        if (sink == 0x9e3779b9u) prog[1] = (int)sink;
        return;
    }
#else
    if (F.wave >= 4) return;
#endif
    f32x4 S[4];
#pragma unroll
    for (int k = 0; k < 4; ++k) S[k] = (f32x4){0.f, 0.f, 0.f, 0.f};
    struct R2Set { v4u P[4][2], RQ[2]; v2u Q[4], O; };
    R2Set s0 = {}, s1 = {}, s2 = {};
    float* OB2 = (float*)(A.ws + WS_OB2);
#define R2_LOAD(S_, c_) do { const size_t cid_ = cid0 + (c_); \
        _Pragma("unroll") for (int kb_ = 0; kb_ < 4; ++kb_) { _Pragma("unroll") for (int kp_ = 0; kp_ < 2; ++kp_) S_.P[kb_][kp_] = *(const v4u*)(PST + (((cid_ * 4 + kb_) * 2 + kp_) * 64 + lane) * 8); \
            S_.Q[kb_] = *(const v2u*)((const bf16*)QST + (((cid_ * 4 + w) * 4 + kb_) * 64 + lane) * 4); } \
        _Pragma("unroll") for (int kp_ = 0; kp_ < 2; ++kp_) S_.RQ[kp_] = *(const v4u*)(RQS + ((cid_ * 2 + kp_) * 64 + lane) * 8); \
        S_.O = *(const v2u*)((const bf16*)OB + ((size_t)b * TP + (c_) * 16 + i) * 1024 + h * 64 + 16 * w + 4 * g); } while (0)
#define R2_BODY(c_, CUR, NX2) do { R2_PROG(c_); if ((c_) + 2 < 128) R2_LOAD(NX2, (c_) + 2); \
        const v4u s0_ = pack8(S[0], S[1]), s1_ = pack8(S[2], S[3]); \
        const bf16x8 sp0 = __builtin_bit_cast(bf16x8, s0_), sp1 = __builtin_bit_cast(bf16x8, s1_); \
        f32x4 Oc = __builtin_amdgcn_mfma_f32_16x16x32_bf16(sp0, __builtin_bit_cast(bf16x8, CUR.RQ[0]), cv4(CUR.O), 0, 0, 0); \
        Oc = __builtin_amdgcn_mfma_f32_16x16x32_bf16(sp1, __builtin_bit_cast(bf16x8, CUR.RQ[1]), Oc, 0, 0, 0); \
        st4bf((bf16*)OB2 + ((size_t)b * TP + (c_) * 16 + i) * 1024 + h * 64 + 16 * w + 4 * g, Oc); \
        _Pragma("unroll") for (int kb = 0; kb < 4; ++kb) { f32x4 n = cv4(CUR.Q[kb]); \
            n = __builtin_amdgcn_mfma_f32_16x16x32_bf16(__builtin_bit_cast(bf16x8, CUR.P[kb][0]), sp0, n, 0, 0, 0); \
            n = __builtin_amdgcn_mfma_f32_16x16x32_bf16(__builtin_bit_cast(bf16x8, CUR.P[kb][1]), sp1, n, 0, 0, 0); S[kb] = n; } } while (0)
    R2_LOAD(s0, 0); R2_LOAD(s1, 1);
#pragma unroll 1
    for (int c = 0; c < 126; c += 3) { R2_BODY(c, s0, s2); R2_BODY(c + 1, s1, s0); R2_BODY(c + 2, s2, s1); }
    R2_BODY(126, s0, s2); R2_BODY(127, s1, s0);
#undef R2_BODY
#undef R2_LOAD
    float* so = AOUT + O_PRWKV + ((size_t)(b * 2 + e) * 16 + h) * 4096;
#pragma unroll
    for (int kb = 0; kb < 4; ++kb) *(f32x4*)(so + (16 * w + i) * 64 + 16 * kb + 4 * g) = S[kb];
}

__device__ __forceinline__ void rwkv_r2_head_ring(const Args& A, Frame& F, int e, int b, int h) {
    if (F.wave >= 4) return;
    typedef short bf16x8 __attribute__((ext_vector_type(8)));
    const int w = F.wave, lane = F.lane, g = lane >> 4, i = lane & 15;
    const size_t cid0 = (size_t)(b * 16 + h) * 128;
    const bf16* PST = (const bf16*)(A.ws + WS_PST); const bf16* QSTB = (const bf16*)(A.ws + WS_QST); const bf16* RQS = (const bf16*)(A.ws + WS_RQ); const bf16* OB = (const bf16*)(A.ws + WS_OB); bf16* OB2 = (bf16*)(A.ws + WS_OB2);
    LAS unsigned char* ring = F.lds + __builtin_amdgcn_readfirstlane(w) * 32768;
    f32x4 S[4];
#pragma unroll
    for (int k = 0; k < 4; ++k) S[k] = (f32x4){0.f, 0.f, 0.f, 0.f};
    struct R2Reg { v4u RQ[2]; v2u Q[4], O; };
    R2Reg r0 = {}, r1 = {}, r2 = {}, r3 = {};
#define R2R_ISSUE(R_, c_, slot_) do { const size_t cid_ = cid0 + (c_); \
        _Pragma("unroll") for (int j_ = 0; j_ < 8; ++j_) __builtin_amdgcn_global_load_lds((const unsigned*)((const char*)PST + cid_ * 8192 + j_ * 1024 + lane * 16), (LAS unsigned*)(ring + (slot_) * 8192 + j_ * 1024), 16, 0, 0); \
        _Pragma("unroll") for (int kp_ = 0; kp_ < 2; ++kp_) R_.RQ[kp_] = *(const v4u*)(RQS + ((cid_ * 2 + kp_) * 64 + lane) * 8); \
        _Pragma("unroll") for (int kb_ = 0; kb_ < 4; ++kb_) R_.Q[kb_] = *(const v2u*)(QSTB + (((cid_ * 4 + w) * 4 + kb_) * 64 + lane) * 4); \
        R_.O = *(const v2u*)(OB + ((size_t)b * TP + (c_) * 16 + i) * 1024 + h * 64 + 16 * w + 4 * g); } while (0)
#define R2R_BODY(c_, CUR, slot_, NXT, nslot_) do { \
        if ((c_) + 3 < 128) { R2R_ISSUE(NXT, (c_) + 3, nslot_); asm volatile("s_waitcnt vmcnt(45)" ::: "memory"); } else asm volatile("s_waitcnt vmcnt(0)" ::: "memory"); \
        v4u P_[4][2]; \
        _Pragma("unroll") for (int kb = 0; kb < 4; ++kb) { _Pragma("unroll") for (int kp = 0; kp < 2; ++kp) P_[kb][kp] = *(const LAS v4u*)(ring + (slot_) * 8192 + (kb * 2 + kp) * 1024 + lane * 16); } \
        const v4u s0_ = pack8(S[0], S[1]), s1_ = pack8(S[2], S[3]); \
        const bf16x8 sp0 = __builtin_bit_cast(bf16x8, s0_), sp1 = __builtin_bit_cast(bf16x8, s1_); \
        f32x4 Oc = __builtin_amdgcn_mfma_f32_16x16x32_bf16(sp0, __builtin_bit_cast(bf16x8, CUR.RQ[0]), cv4(CUR.O), 0, 0, 0); \
        Oc = __builtin_amdgcn_mfma_f32_16x16x32_bf16(sp1, __builtin_bit_cast(bf16x8, CUR.RQ[1]), Oc, 0, 0, 0); \
        st4bf(OB2 + ((size_t)b * TP + (c_) * 16 + i) * 1024 + h * 64 + 16 * w + 4 * g, Oc); \
        _Pragma("unroll") for (int kb = 0; kb < 4; ++kb) { f32x4 n = cv4(CUR.Q[kb]); \
            n = __builtin_amdgcn_mfma_f32_16x16x32_bf16(__builtin_bit_cast(bf16x8, P_[kb][0]), sp0, n, 0, 0, 0); \
            n = __builtin_amdgcn_mfma_f32_16x16x32_bf16(__builtin_bit_cast(bf16x8, P_[kb][1]), sp1, n, 0, 0, 0); S[kb] = n; } \
        asm volatile("s_waitcnt lgkmcnt(0)" ::: "memory"); } while (0)
    R2R_ISSUE(r0, 0, 0); R2R_ISSUE(r1, 1, 1); R2R_ISSUE(r2, 2, 2);
#pragma unroll 1
    for (int c = 0; c < 128; c += 4) { R2R_BODY(c, r0, 0, r3, 3); R2R_BODY(c + 1, r1, 1, r0, 0); R2R_BODY(c + 2, r2, 2, r1, 1); R2R_BODY(c + 3, r3, 3, r2, 2); }
#undef R2R_BODY
#undef R2R_ISSUE
    float* so = AOUT + O_PRWKV + ((size_t)(b * 2 + e) * 16 + h) * 4096;
#pragma unroll
    for (int kb = 0; kb < 4; ++kb) *(f32x4*)(so + (16 * w + i) * 64 + 16 * kb + 4 * g) = S[kb];
}

struct R3Raw { v2u o4, bv, g4; };
__device__ __forceinline__ void rwkv_r3_load(const Args& A, Frame& F, int b, int h, int cp, R3Raw& r) {
    const float* WAG = (const float*)(A.ws + WS_WAG);
    const int tt = F.tid >> 4, cg = F.tid & 15, hc = h * 64 + 4 * cg; const size_t m = (size_t)b * TP + cp * 32 + tt;
    r.o4 = *(const v2u*)((const bf16*)(A.ws + WS_OB2) + m * 1024 + hc); r.bv = *(const v2u*)((const bf16*)WAG + m * NLORA + hc); r.g4 = *(const v2u*)((const bf16*)WAG + m * NLORA + 2048 + hc);
}
__device__ __forceinline__ void rwkv_r3_finish(const Args& A, Frame& F, int e, int b, int h, int cp, const R3Raw& r) {
    bf16* YIN = (bf16*)(A.ws + WS_YIN);
    const int tt = F.tid >> 4, cg = F.tid & 15, hc = h * 64 + 4 * cg; const size_t m = (size_t)b * TP + cp * 32 + tt;
    const f32x4 o4 = cv4(r.o4);
    const float mean = red16((o4[0] + o4[1]) + (o4[2] + o4[3])) * (1.0f / 64.0f);
    const f32x4 d = o4 - mean;
    const float var = red16((d[0] * d[0] + d[1] * d[1]) + (d[2] * d[2] + d[3] * d[3])) * (1.0f / 64.0f);
    const float rs = 1.0f / sqrtf(var + 64e-5f);
    const f32x4 on = d * rs * ld4(PARP(PAR_LNW) + e * 1024 + hc) + ld4(PARP(PAR_LNB) + e * 1024 + hc) + cv4(r.bv);
    st4bf(YIN + m * D + hc, on * cv4(r.g4));
}

__device__ __forceinline__ void rwkv_sample8(const Args& A, Frame& F, int e, int u8) {
    const int tid = F.tid, hi = tid >> 4, lo = tid & 15, lane = F.lane, wv = F.wave;
    const bf16* PROJ = (const bf16*)(A.ws + WS_PROJ); const float* WAG = (const float*)(A.ws + WS_WAG); bf16* YIN = (bf16*)(A.ws + WS_YIN);
    LAS float* cb = (LAS float*)F.lds; LAS float* ob = cb + 32 * 384;
    const int bs = u8 >> 1, hbase = (u8 & 1) * 8;
    const int hw = hbase + wv; const size_t sidx = ((size_t)(bs * 2 + e) * 16 + hw) * 4096 + lane * 64;
    f32x4 S[16];
#pragma unroll
    for (int q = 0; q < 16; ++q) S[q] = ld4(A.in[3] + sidx + 4 * q);
    {
        const int j = hi >> 2, t = hi & 3, h = hbase + j, hc = h * 64 + 4 * lo; const size_t m = (size_t)(MP + bs * TS + t);
        const float* mu = PARP(PAR_MU) + (size_t)e * PRW;
        const f32x4 pr = ldp4(PROJ + m * NEV + hc), pk = ldp4(PROJ + m * NEV + 1024 + hc), pv = ldp4(PROJ + m * NEV + 2048 + hc);
        f32x4 qr, qk, qv;
        if (t > 0) { qr = ldp4(PROJ + (m - 1) * NEV + hc); qk = ldp4(PROJ + (m - 1) * NEV + 1024 + hc); qv = ldp4(PROJ + (m - 1) * NEV + 2048 + hc); }
        else { const float* sh = A.in[2] + (size_t)(bs * 2 + e) * PRW; qr = ld4(sh + hc); qk = ld4(sh + 1024 + hc); qv = ld4(sh + 2048 + hc); }
        const f32x4 lw_ = ldp4((const bf16*)WAG + m * NLORA + hc), wd = {__expf(lw_[0]), __expf(lw_[1]), __expf(lw_[2]), __expf(lw_[3])}, wa = ldp4((const bf16*)WAG + m * NLORA + 1024 + hc);
        const f32x4 zr = pr + (qr - pr) * ld4(mu + hc), zk = pk + (qk - pk) * ld4(mu + 1024 + hc), zv = pv + (qv - pv) * ld4(mu + 2048 + hc);
        f32x4 kk = zk * ld4(PARP(PAR_KK) + e * 1024 + hc);
        const float ss = red16((kk[0] * kk[0] + kk[1] * kk[1]) + (kk[2] * kk[2] + kk[3] * kk[3]));
        kk = kk * (1.0f / fmaxf(sqrtf(ss), 1e-12f));
        const f32x4 kp = zk * (1.0f + (wa - 1.0f) * ld4(PARP(PAR_KA) + e * 1024 + hc)), bb = kk * wa;
        LAS float* p = cb + hi * 384 + 4 * lo;
        *(LAS f32x4*)(p) = zr; *(LAS f32x4*)(p + 64) = wd; *(LAS f32x4*)(p + 128) = kp; *(LAS f32x4*)(p + 192) = kk; *(LAS f32x4*)(p + 256) = bb; *(LAS f32x4*)(p + 320) = zv;
    }
    __syncthreads();
#pragma unroll 1
    for (int t = 0; t < 4; ++t) {
        const LAS float* p = cb + (wv * 4 + t) * 384; const float vv = p[320 + lane];
        f32x4 a4 = {0.f, 0.f, 0.f, 0.f};
#pragma unroll
        for (int q = 0; q < 16; ++q) a4 += S[q] * *(const LAS f32x4*)(p + 192 + 4 * q);
        const float sa = -((a4[0] + a4[1]) + (a4[2] + a4[3]));
        f32x4 o4 = {0.f, 0.f, 0.f, 0.f};
#pragma unroll
        for (int q = 0; q < 16; ++q) { S[q] = S[q] * *(const LAS f32x4*)(p + 64 + 4 * q) + *(const LAS f32x4*)(p + 256 + 4 * q) * sa + *(const LAS f32x4*)(p + 128 + 4 * q) * vv; o4 += S[q] * *(const LAS f32x4*)(p + 4 * q); }
        ob[(wv * 4 + t) * 64 + lane] = (o4[0] + o4[1]) + (o4[2] + o4[3]);
    }
    {
        float* so = AOUT + O_SRWKV + sidx;
#pragma unroll
        for (int q = 0; q < 16; ++q) *(f32x4*)(so + 4 * q) = S[q];
    }
    __syncthreads();
    {
        const int j = hi >> 2, t = hi & 3, h = hbase + j, hc = h * 64 + 4 * lo; const size_t m = (size_t)(MP + bs * TS + t);
        const f32x4 o4 = *(const LAS f32x4*)(ob + hi * 64 + 4 * lo);
        const float mean = red16((o4[0] + o4[1]) + (o4[2] + o4[3])) * (1.0f / 64.0f);
        const f32x4 d = o4 - mean;
        const float var = red16((d[0] * d[0] + d[1] * d[1]) + (d[2] * d[2] + d[3] * d[3])) * (1.0f / 64.0f);
        const float rs = 1.0f / sqrtf(var + 64e-5f);
        const LAS float* p = cb + hi * 384 + 4 * lo;
        const f32x4 r4 = *(const LAS f32x4*)(p), kp4 = *(const LAS f32x4*)(p + 128), v4 = *(const LAS f32x4*)(p + 320);
        const f32x4 rk = ld4(PARP(PAR_RK) + e * 1024 + hc);
        const float bonus = red16((r4[0] * kp4[0] * rk[0] + r4[1] * kp4[1] * rk[1]) + (r4[2] * kp4[2] * rk[2] + r4[3] * kp4[3] * rk[3]));
        const f32x4 on = d * rs * ld4(PARP(PAR_LNW) + e * 1024 + hc) + ld4(PARP(PAR_LNB) + e * 1024 + hc) + v4 * bonus;
        st4bf(YIN + m * D + hc, on * ldp4((const bf16*)WAG + m * NLORA + 2048 + hc));
    }
    __syncthreads();
}

constexpr int NPH = 61;
#ifndef MK_FUSED
#define MK_FUSED 1
#endif

__global__ void __launch_bounds__(NTHR, 2) mega(Args A) {
    extern __shared__ __attribute__((aligned(16))) unsigned char lds_raw[];
    Frame F; F.lds = (LAS unsigned char*)lds_raw; F.tid = threadIdx.x; F.lane = F.tid & 63; F.wave = __builtin_amdgcn_readfirstlane(F.tid >> 6); F.G = gridDim.x; F.blk = blockIdx.x;
    volatile LAS unsigned* MISC = (volatile LAS unsigned*)(F.lds + MISC_OFF);
    if (F.tid < 32) MISC[F.tid] = 0u;
    __syncthreads();
    const int lo = A.ph_lo, hi = A.ph_hi;
    XcdBarrier bar; bar.bar = (unsigned*)(A.ws + WS_CTL) + CW_BAR + A.li * XCD_BAR_WORDS; bar.x = 0; bar.st = nullptr;
    if (hi - lo > 1) bar = xcd_barrier_post(bar.bar, MISC + 8);
#ifndef SEL_MASK
#define SEL_MASK 0xFFFFFFFFu
#endif
#ifndef REP_MASK
#define REP_MASK 0u
#endif
#ifndef REP_N
#define REP_N 2
#endif
#ifndef FOLD_O4
#define FOLD_O4 1
#endif
#define SITE(n) ((SEL_MASK >> (n)) & 1u)
#define NREP(n) (((REP_MASK >> (n)) & 1u) ? REP_N : 1)
#define PH_BEGIN(n) if (ph >= lo && ph < hi) { asm volatile("" : "+v"(F.tid), "+v"(F.lane), "+s"(F.wave), "+s"(F.blk), "+s"(F.G), "+s"(A.ws), "+s"(A.out)); \
    if (SITE(n)) for (int rep_ = 0; rep_ < NREP(n); ++rep_) { if (rep_) xcd_barrier(bar);
#ifndef BAR_REP
#define BAR_REP 1
#endif
#define PH_END } if (ph + 1 < hi) for (int br_ = 0; br_ < BAR_REP; ++br_) xcd_barrier(bar); } ++ph;
    int ph = 0;
    PH_BEGIN(1) p0_prologue(A, F); PH_END
#pragma nounroll
    for (int l = 0; l < 4; ++l) {
        const int e = l >> 1; const bool even = !(l & 1);
#pragma nounroll
        for (int s = 0; s < 3; ++s) {
            if (s != 1) {
                const int mat = l * 2 + (s >> 1);
                PH_BEGIN(2) {
                    pg8::Gemm g{(const bf16*)(A.ws + WS_XN), (const bf16*)(A.ws + WS_WGU) + (size_t)mat * (SZ_WGU / 2), D, D}; pg8::StaticOrder S; S.init(M, 2 * FF, D, F.G, F.blk);
                    pg8::EpiSwiGLU E{(bf16*)(A.ws + WS_H), FF, (const float*)(A.ws + WS_RSTD)};
                    pg8::gemm_phase<pg8::EpiSwiGLU, pg8::StaticOrder, true, true>(F.lds, g, S, E);
                } PH_END
            } else if (even) {
                PH_BEGIN(3) {
                    pg8::Gemm g{(const bf16*)(A.ws + WS_XN), (const bf16*)(A.ws + WS_WEVIN) + (size_t)e * (SZ_WEVIN / 2), D, D}; pg8::StaticOrder S; S.init(M, NEV, D, F.G, F.blk);
                    pg8::EpiStoreBf16 E{(bf16*)(A.ws + WS_PROJ), NEV, (const float*)(A.ws + WS_RSTD)};
                    pg8::gemm_phase<pg8::EpiStoreBf16, pg8::StaticOrder, true, true>(F.lds, g, S, E);
                } PH_END
                PH_BEGIN(4) e2_prep(A, F, e); PH_END
                PH_BEGIN(5) {
                    pg8::Gemm g{(const bf16*)(A.ws + WS_LA), (const bf16*)(A.ws + WS_WLORA) + (size_t)e * NLORA * KLORA, KLORA, KLORA}; pg8::LoraOrder S; S.so.init(M, NLORA, KLORA, F.G, F.blk); { int nt4 = 4; asm volatile("" : "+s"(nt4)); S.nt = nt4; }
                    pg8::EpiLora E{(bf16*)(A.ws + WS_WAG), PARP(PAR_W0) + e * 1024, PARP(PAR_A0) + e * 1024};
                    pg8::gemm_phase<pg8::EpiLora, pg8::LoraOrder, true, true>(F.lds, g, S, E);
                } PH_END
#ifndef R1W
#define R1W 1
#endif
#if R1W
                PH_BEGIN(16) {
#if !R1O_MASK
                    rwkv_r1w_phase(A, F, e);
#endif
#if R1O_MASK
                    { R1Raw raw = {}, nraw = {}; if (F.blk < 4096) rwkv_r1_load(A, F, F.blk >> 10, (F.blk >> 6) & 15, F.blk & 63, raw);
                    for (int u = F.blk; u < 4096; u += F.G) { asm volatile("" : "+v"(F.tid), "+v"(F.lane), "+s"(F.wave), "+s"(A.ws)); const int un = u + F.G; if (un < 4096) rwkv_r1_load(A, F, un >> 10, (un >> 6) & 15, un & 63, nraw);
                        rwkv_r1_unit(A, F, e, u >> 10, (u >> 6) & 15, u & 63, raw); raw = nraw; } }
                    xcd_barrier(bar);
                    rwkv_r1w_phase(A, F, e);
#endif
                } PH_END
#else
                PH_BEGIN(16) { R1Raw raw = {}, nraw = {}; if (F.blk < 4096) rwkv_r1_load(A, F, F.blk >> 10, (F.blk >> 6) & 15, F.blk & 63, raw);
                    for (int u = F.blk; u < 4096; u += F.G) { asm volatile("" : "+v"(F.tid), "+v"(F.lane), "+s"(F.wave), "+s"(A.ws)); const int un = u + F.G; if (un < 4096) rwkv_r1_load(A, F, un >> 10, (un >> 6) & 15, un & 63, nraw);
                        rwkv_r1_unit(A, F, e, u >> 10, (u >> 6) & 15, u & 63, raw); raw = nraw; } } PH_END
#endif
                PH_BEGIN(6) {
#ifndef REP_E4A
#define REP_E4A 1
#define REP_E4B 1
#define REP_E4C 1
#define REP_E4D 1
#endif
#ifndef R2_TWICE
#define R2_TWICE 0
#endif
#ifndef R2_ONLY_FIRST_REP
#define R2_ONLY_FIRST_REP 0
#endif
                    if (F.blk < 64 && !(R2_ONLY_FIRST_REP && rep_ > 0)) { rwkv_r2_head(A, F, e, F.blk >> 4, F.blk & 15);
#if R2_TWICE
                        asm volatile("" : "+v"(F.tid), "+v"(F.lane), "+s"(F.wave)); rwkv_r2_head(A, F, e, F.blk >> 4, F.blk & 15);
#endif
                    }
                    {
                        unsigned* ctr = (unsigned*)(A.ws + WS_CTL) + 2048 + 64 * e + 16 * rep_;
                        unsigned nxt = 0;
                        if (F.tid == 0) nxt = __hip_atomic_fetch_add(ctr, 1u, __ATOMIC_RELAXED, __HIP_MEMORY_SCOPE_AGENT);
                        for (;;) {
                            asm volatile("" : "+v"(F.tid), "+v"(F.lane), "+s"(F.wave), "+s"(A.ws));
                            if (F.tid == 0) MISC[16] = nxt;
                            __syncthreads(); const int w = (int)MISC[16]; __syncthreads();
                            if (w >= 2304) break;
                            if (F.tid == 0) nxt = __hip_atomic_fetch_add(ctr, 1u, __ATOMIC_RELAXED, __HIP_MEMORY_SCOPE_AGENT);
                            if (w < 1024) { for (int rq = 0; rq < REP_E4B; ++rq) hgrn_chunk_unit2(A, F, e, w >> 8, (w >> 5) & 7, w & 31); }
                            else if (w < 2048) { for (int rq = 0; rq < REP_E4C; ++rq) hgrn_sample_unit(A, F, e, (w - 1024) >> 3, w & 7); }
                            else rwkv_sample8(A, F, e, w - 2048);
                        }
                    }
                } PH_END
                PH_BEGIN(7) hgrn_state_scan(A, F, e); PH_END
                PH_BEGIN(8) { { HfRaw hr = {}, hn = {}; if (F.blk < 1024) hgrn_finish_load(A, F, F.blk >> 8, (F.blk >> 5) & 7, F.blk & 31, hr);
                    for (int w = F.blk; w < 1024; w += F.G) { asm volatile("" : "+v"(F.tid), "+v"(F.lane), "+s"(F.wave), "+s"(A.ws)); const int wn = w + F.G;
                        hgrn_finish_unit(A, F, e, w >> 8, (w >> 5) & 7, w & 31, hr, wn < 1024, wn >> 8, (wn >> 5) & 7, wn & 31, hn); hr = hn; } }
                    for (int u = F.blk; u < 4096; u += 4 * F.G) {
                        R3Raw r3[4] = {};
#pragma unroll
                        for (int q = 0; q < 4; ++q) { const int uq = u + q * F.G; if (uq < 4096) rwkv_r3_load(A, F, uq >> 10, (uq >> 6) & 15, uq & 63, r3[q]); }
#pragma unroll
                        for (int q = 0; q < 4; ++q) { const int uq = u + q * F.G; if (uq < 4096) rwkv_r3_finish(A, F, e, uq >> 10, (uq >> 6) & 15, uq & 63, r3[q]); }
                    } } PH_END
            } else {
                PH_BEGIN(9) {
                    pg8::Gemm g{(const bf16*)(A.ws + WS_XN), (const bf16*)(A.ws + WS_WODIN) + (size_t)e * (SZ_WODIN / 2), D, D}; pg8::OddInOrder S; S.init(F.G, F.blk);
                    pg8::EpiOddIn E{(bf16*)(A.ws + WS_GATE), (bf16*)(A.ws + WS_XB), (const float*)(A.ws + WS_RSTD), (bf16*)(A.ws + WS_OSLAB)};
                    pg8::gemm_phase<pg8::EpiOddIn, pg8::OddInOrder, true, true>(F.lds, g, S, E);
                } PH_END
                PH_BEGIN(10) o2_conv(A, F, e); PH_END
                PH_BEGIN(11) {
                    pg8::Gemm g{(const bf16*)(A.ws + WS_XCB), (const bf16*)(A.ws + WS_WLRU) + (size_t)e * 4096 * 256, 2048, 256}; int nt4 = 4; asm volatile("" : "+s"(nt4)); pg8::LruOrder S{F.G, F.blk, nt4};
                    pg8::EpiLru E{(const bf16*)(A.ws + WS_XCB), (bf16*)(A.ws + WS_LRA), (bf16*)(A.ws + WS_LRB), PARP(PAR_BA) + e * 2048, PARP(PAR_BX) + e * 2048, PARP(PAR_LAM) + e * 2048};
                    pg8::gemm_phase<pg8::EpiLru, pg8::LruOrder, true, true>(F.lds, g, S, E);
#if FOLD_O4
                    o4_tail(A, F);
#endif
                } PH_END
#if FOLD_O4
                PH_BEGIN(13) o5_lru_scan(A, F, e); PH_END
                ph += 3;
#else
                PH_BEGIN(12) o4_lru_chunks(A, F); PH_END
                PH_BEGIN(13) o5_lru_scan(A, F, e); PH_END
                ph += 2;
#endif
            }
            PH_BEGIN(14) {
                const bf16* Ap; const bf16* Bp; int K; float scale;
                if (s != 1) { Ap = (const bf16*)(A.ws + WS_H); K = FF; scale = 0.5f; Bp = (const bf16*)(A.ws + WS_WDN) + (size_t)(l * 2 + (s >> 1)) * (SZ_WDN / 2); }
                else { Ap = (const bf16*)(A.ws + WS_YIN); K = D; scale = 1.0f; Bp = (const bf16*)(A.ws + (even ? WS_WEVOUT : WS_WODOUT)) + (size_t)e * (SZ_WSQ / 2); }
                pg8::Gemm g{Ap, Bp, K, K}; pg8::ResidOrder S; S.init(K, F.G, F.blk);
                const bool fin = (s == 2 && l == 3);
                const float* gnext = s == 0 ? PARP(PAR_MIXN) + l * D : (s == 1 ? PARP(PAR_FFN2N) + l * D : PARP(PAR_FFN1N) + ((l + 1) & 3) * D);
                pg8::EpiResid E{(bf16*)(A.ws + WS_X), D, scale / (float)(NREP(14) * EPI_REP), (float*)(A.ws + WS_SLAB), (bf16*)(A.ws + WS_XN), fin ? nullptr : gnext, (float*)(A.ws + WS_SSP)};
                pg8::gemm_phase<pg8::EpiResid, pg8::ResidOrder, true, true>(F.lds, g, S, E);
            } PH_END
            PH_BEGIN(15) {
                const float* gain = s == 0 ? PARP(PAR_MIXN) + l * D : (s == 1 ? PARP(PAR_FFN2N) + l * D : (l < 3 ? PARP(PAR_FFN1N) + (l + 1) * D : PARP(PAR_FINN)));
                const int K = s != 1 ? FF : D, PU = K / 128; const int sf = F.G == 256 ? ((PU / 2) < 16 ? (PU / 2) : 16) : 0;
                if (s == 2 && l == 3) norm_phase(A, F, gain, true, sf, (s != 1 ? 0.5f : 1.0f) / (float)NREP(15)); else rstd_phase(A, F, gain, sf, (s != 1 ? 0.5f : 1.0f) / (float)NREP(15));
            } PH_END
        }
    }
}

extern "C" void kernel_launch(void* const* d_in, const int* in_sizes, int n_in, void* d_out, int out_size, void* d_ws, size_t ws_size, hipStream_t stream) {
    static int grid = 0;
    if (grid == 0) {
        if (n_in != 39 || (size_t)out_size != O_END || ws_size < WS_END) { fprintf(stderr, "kernel_launch: unexpected shapes (n_in %d out %d ws %zu need %zu)\n", n_in, out_size, ws_size, (size_t)WS_END); grid = -1; return; }
        int dev = 0, cus = 0;
        if (hipGetDevice(&dev) != hipSuccess || hipDeviceGetAttribute(&cus, hipDeviceAttributeMultiprocessorCount, dev) != hipSuccess) { grid = -1; return; }
        if (hipFuncSetAttribute((const void*)mega, hipFuncAttributeMaxDynamicSharedMemorySize, LDS_BYTES) != hipSuccess) { fprintf(stderr, "kernel_launch: hipFuncSetAttribute failed\n"); grid = -1; return; }
        int per_cu = 0;
        if (hipOccupancyMaxActiveBlocksPerMultiprocessor(&per_cu, (const void*)mega, NTHR, LDS_BYTES) != hipSuccess || per_cu < 1) fprintf(stderr, "kernel_launch: occupancy query reports %d blocks per CU\n", per_cu);
        (void)hipGetLastError();
        grid = cus;
    }
    if (grid < 0) return;
    (void)hipMemsetAsync((char*)d_ws + WS_CTL, 0, CTL_ZERO_BYTES, stream);
    Args a{};
    for (int i = 0; i < 39; ++i) a.in[i] = (const float*)d_in[i];
    a.out = (GAS float*)d_out; a.ws = (GAS unsigned char*)d_ws; a.li = 0; a.pad = 0;
#if MK_FUSED
    a.ph_lo = 0; a.ph_hi = NPH;
    hipLaunchKernelGGL(mega, dim3(grid), dim3(NTHR), LDS_BYTES, stream, a);
#else
    for (int p = 0; p < NPH; ++p) {
        if (p >= 1 && (((p - 1) % 15) == 8 || ((p - 1) % 15) == 9) && (((p - 1) / 15) & 1)) continue;
        a.ph_lo = p; a.ph_hi = p + 1;
        hipLaunchKernelGGL(mega, dim3(grid), dim3(NTHR), LDS_BYTES, stream, a);
    }
#endif
}
```

```cpp
#include <hip/hip_runtime.h>
#include <cstdio>
#include <cstdint>

#ifndef EPI_REP
#define EPI_REP 1
#endif
constexpr int D = 2048, MP = 8192, MS = 512, M = MP + MS, FF = 5632;
constexpr int TP = 2048, BP = 4, TS = 4, BS = 128, NSEQ = BP + BS;
constexpr int RW = 1024, RH = 16, PRW = 3520, PEV = 7616, NEV = 7680;
constexpr int HGH = 8;
constexpr int NLORA = 3072, KLORA = 512;
constexpr int NWAVES = 8, NTHR = 512;

namespace pg8 {
#define PG8_LAS __attribute__((address_space(3)))
typedef unsigned short bf16_t;
typedef short bf16x8 __attribute__((ext_vector_type(8)));
typedef float f32x4 __attribute__((ext_vector_type(4)));
typedef float f32x2 __attribute__((ext_vector_type(2)));
typedef unsigned u32x4 __attribute__((ext_vector_type(4)));
typedef unsigned u32x2 __attribute__((ext_vector_type(2)));
constexpr int BM = 256, BK = 64, HALF = 128, HTB = HALF * BK * 2  , STAGE_BYTES = 8 * HTB, NXCD = 8, WGM = 8;

__host__ __device__ __forceinline__ int lds_byte(int r, int c) { const int st = (r >> 4) * 2 + (c >> 5), rr = r & 15, cc = c & 31, ob = rr * 64 + cc * 2; return st * 1024 + (ob ^ (((ob >> 9) & 1) << 5)); }
__host__ __device__ __forceinline__ void stage_rc(int b, int& R, int& C) { const int st = b / 1024, sb = b % 1024, swz = sb ^ (((sb >> 9) & 1) << 5); R = (st >> 1) * 16 + swz / 64; C = (st & 1) * 32 + (swz % 64) / 2; }
__host__ __device__ __forceinline__ int perm32(int rho) { const int n = rho >> 4, i = rho & 15; return 8 * (i >> 2) + 4 * n + (i & 3); }

struct Unit { int pm, pn, ka, kb, nt, slab; };
struct Gemm { const bf16_t* A; const bf16_t* Bt; int lda, ldb; };

struct StaticOrder {
    int nM, nN, nwg, G, c, nt;
    __device__ void init(int Mr, int N, int K, int G_, int c_) { nM = Mr / BM; nN = N / BM; nwg = nM * nN; G = G_; c = c_; nt = K / BK; }
    __device__ bool next(int i, Unit& u) const {
        const long L = (long)i * G + c; if (L >= nwg) return false;
        int wgid = (int)L; { const int q = nwg / NXCD, r = nwg % NXCD, xcd = wgid % NXCD, off = wgid / NXCD; wgid = (xcd < r ? xcd * (q + 1) : r * (q + 1) + (xcd - r) * q) + off; }
        const int nig = WGM * nN, gid = wgid / nig, fm = gid * WGM, gsz = (nM - fm) < WGM ? (nM - fm) : WGM;
        u.pm = fm + ((wgid % nig) % gsz); u.pn = (wgid % nig) / gsz; u.ka = 0; u.kb = 0; u.nt = nt; u.slab = -1; return true;
    }
    __device__ __forceinline__ void a_ready(const Unit&) const {}
    __device__ __forceinline__ void done(const Unit&) const {}
};
struct LoraOrder {
    StaticOrder so; int nt;
    __device__ bool next(int i, Unit& u) const { if (!so.next(i, u)) return false; const int off = ((u.pn >> 2) == 2) ? 192 : 0; u.ka = off; u.kb = off; u.nt = nt; return true; }
    __device__ __forceinline__ void a_ready(const Unit&) const {}
    __device__ __forceinline__ void done(const Unit&) const {}
};
__device__ __forceinline__ void resid_tile(int L, int& pm, int& pn) {
    if (L >= 256) { pm = 32 + ((L - 256) >> 3); pn = (L - 256) & 7; return; }
    const int wgid = (L % NXCD) * 32 + L / NXCD; pm = 8 * (wgid / 64) + ((wgid % 64) % 8); pn = (wgid % 64) / 8;
}
struct ResidOrder {
    StaticOrder so; int SF, PU; bool split;
    __device__ void init(int K, int G_, int c_) { so.init(M, 2048, K, G_, c_); PU = K / 128; SF = (PU / 2) < 16 ? (PU / 2) : 16; split = (G_ == 256); }
    __device__ bool next(int i, Unit& u) const {
        if (!split) return so.next(i, u);
        const int j = so.c / SF, p = so.c % SF; const bool piece = j < 16;
        if ((i == 0 && !piece) || (i == 1 && piece)) { resid_tile(so.c, u.pm, u.pn); u.ka = 0; u.kb = 0; u.nt = so.nt; u.slab = -1; return true; }
        if (i == 0) { resid_tile(256 + j, u.pm, u.pn); const int p0 = (p * PU) / SF, p1 = ((p + 1) * PU) / SF; u.ka = p0 * 128; u.kb = p0 * 128; u.nt = (p1 - p0) * 2; u.slab = j * SF + p; return true; }
        return false;
    }
    __device__ __forceinline__ void a_ready(const Unit&) const {}
    __device__ __forceinline__ void done(const Unit&) const {}
};
struct OddInOrder {
    StaticOrder so; bool split;
    __device__ void init(int G_, int c_) { so.init(M, 4096, 2048, G_, c_); split = (G_ == 256); }
    __device__ bool next(int i, Unit& u) const {
        if (!split) return so.next(i, u);
        if (i == 0) { const int j = so.c >> 3, p = so.c & 7; u.pm = 32 + (j >> 4); u.pn = j & 15; u.ka = p * 256; u.kb = p * 256; u.nt = 4; u.slab = so.c; return true; }
        if (i > 2) return false;
        const int L = (i - 1) * 256 + so.c, wgid = (L % NXCD) * 64 + L / NXCD;
        u.pm = 8 * (wgid / 128) + ((wgid % 128) % 8); u.pn = (wgid % 128) / 8; u.ka = 0; u.kb = 0; u.nt = so.nt; u.slab = -1; return true;
    }
    __device__ __forceinline__ void a_ready(const Unit&) const {}
    __device__ __forceinline__ void done(const Unit&) const {}
};
struct LruOrder {
    int G, c, nt;
    __device__ bool next(int i, Unit& u) const {
        const int L = i * G + c; if (L >= (M / BM) * 16) return false;
        u.pm = L >> 4; u.pn = L & 15; u.ka = 256 * (u.pn >> 1); u.kb = 0; u.nt = nt; u.slab = -1; return true;
    }
    __device__ __forceinline__ void a_ready(const Unit&) const {}
    __device__ __forceinline__ void done(const Unit&) const {}
};

__device__ __forceinline__ unsigned cvt_pk_bf16(float lo, float hi) {
    typedef float f2_ __attribute__((ext_vector_type(2))); typedef __bf16 b2_ __attribute__((ext_vector_type(2)));
    return __builtin_bit_cast(unsigned, __builtin_convertvector((f2_){lo, hi}, b2_));
}
__device__ __forceinline__ float sigm(float x) { return __builtin_amdgcn_rcpf(1.0f + __expf(-x)); }
__device__ __forceinline__ float log1p_pos(float t) { return t < 0.01f ? t * (1.0f - t * (0.5f - t * 0.33333333f)) : __logf(1.0f + t); }
__device__ __forceinline__ float softplus_(float y) { return fmaxf(y, 0.0f) + log1p_pos(__expf(-fabsf(y))); }
__device__ __forceinline__ float silu_(float x) { return x * sigm(x); }
__device__ __forceinline__ float gelu_tanh(float x) { return x * sigm(1.5957691216057308f * (x + 0.044715f * x * x * x)); }
__device__ __forceinline__ float neg_expm1(float x) {
    if (x > -0.25f) { return -x * (1.0f + x * (0.5f + x * (0.16666667f + x * (0.041666668f + x * (0.0083333338f + x * 0.0013888889f))))); }
    return 1.0f - __expf(x);
}

struct EpiSwiGLU {
    static constexpr bool PERM = true, AFTER_DRAIN = false;
    bf16_t* H; int ldh; const float* rstd;
    __device__ __forceinline__ void operator()(const f32x4 (&acc)[2][2][4][2], const Unit& u, int wr, int wc, int fr, int fq) const {
        const int row0 = u.pm * BM + wr * 64 + fr, col0 = u.pn * HALF + wc * 32 + 8 * fq;
        float rsv[2][4];
#pragma unroll
        for (int ai = 0; ai < 2; ++ai)
#pragma unroll
            for (int m = 0; m < 4; ++m) rsv[ai][m] = rstd[row0 + ai * HALF + m * 16];
#pragma unroll
        for (int ai = 0; ai < 2; ++ai)
#pragma unroll
            for (int m = 0; m < 4; ++m) {
                bf16_t* rowp = H + (size_t)(row0 + ai * HALF + m * 16) * ldh + col0;
                const float rs = rsv[ai][m];
                const f32x4 g0 = acc[ai][0][m][0] * rs, g1 = acc[ai][0][m][1] * rs, u0 = acc[ai][1][m][0] * rs, u1 = acc[ai][1][m][1] * rs;
                u32x4 w;
                w.x = cvt_pk_bf16(silu_(g0[0]) * u0[0], silu_(g0[1]) * u0[1]); w.y = cvt_pk_bf16(silu_(g0[2]) * u0[2], silu_(g0[3]) * u0[3]);
                w.z = cvt_pk_bf16(silu_(g1[0]) * u1[0], silu_(g1[1]) * u1[1]); w.w = cvt_pk_bf16(silu_(g1[2]) * u1[2], silu_(g1[3]) * u1[3]);
                *(u32x4*)rowp = w;
            }
    }
};
struct EpiResid {
    static constexpr bool PERM = true, AFTER_DRAIN = false;
    bf16_t* X; int ldx; float scale; float* SLAB; bf16_t* XR; const float* gain; float* SSP;
    __device__ __forceinline__ void operator()(const f32x4 (&acc)[2][2][4][2], const Unit& u, int wr, int wc, int fr, int fq) const {
        if (u.slab >= 0) {
            bf16_t* base = (bf16_t*)SLAB + (size_t)u.slab * 65536 + (wr * 64 + fr) * 256 + wc * 32 + 8 * fq;
#pragma unroll
            for (int ai = 0; ai < 2; ++ai)
#pragma unroll
                for (int m = 0; m < 4; ++m)
#pragma unroll
                    for (int bj = 0; bj < 2; ++bj)
#pragma unroll
                        for (int n = 0; n < 2; ++n) { const f32x4 v = acc[ai][bj][m][n]; u32x2 w2; w2.x = cvt_pk_bf16(v[0], v[1]); w2.y = cvt_pk_bf16(v[2], v[3]); *(u32x2*)(base + (ai * HALF + m * 16) * 256 + bj * HALF + n * 4) = w2; }
            return;
        }
        const int row0 = u.pm * BM + wr * 64 + fr, col0 = u.pn * BM + wc * 32 + 8 * fq;
        f32x4 gv[2][2];
#pragma unroll
        for (int bj = 0; bj < 2; ++bj)
#pragma unroll
            for (int n = 0; n < 2; ++n) gv[bj][n] = (gain && XR) ? *(const f32x4*)(gain + col0 + bj * HALF + n * 4) : (f32x4){0.f, 0.f, 0.f, 0.f};
#pragma unroll
        for (int aim = 0; aim < 4; ++aim) { const int ai = aim >> 1, mb = (aim & 1) * 2;
            u32x4 xv[4][2];
#pragma unroll
            for (int m = mb; m < mb + 2; ++m)
#pragma unroll
                for (int bj = 0; bj < 2; ++bj) xv[m][bj] = *(const u32x4*)(X + (size_t)(row0 + ai * HALF + m * 16) * ldx + col0 + bj * HALF);
#pragma unroll
            for (int m = mb; m < mb + 2; ++m) {
                const int row = row0 + ai * HALF + m * 16;
                bf16_t* rowp = X + (size_t)row * ldx + col0; float ssq = 0.f;
#pragma unroll
                for (int bj = 0; bj < 2; ++bj) {
                    const u32x4 w = xv[m][bj];
                    const f32x4 x0 = {__builtin_bit_cast(float, w.x << 16), __builtin_bit_cast(float, w.x & 0xffff0000u), __builtin_bit_cast(float, w.y << 16), __builtin_bit_cast(float, w.y & 0xffff0000u)};
                    const f32x4 x1 = {__builtin_bit_cast(float, w.z << 16), __builtin_bit_cast(float, w.z & 0xffff0000u), __builtin_bit_cast(float, w.w << 16), __builtin_bit_cast(float, w.w & 0xffff0000u)};
                    const f32x4 o0 = x0 + acc[ai][bj][m][0] * scale, o1 = x1 + acc[ai][bj][m][1] * scale;
                    u32x4 wo; wo.x = cvt_pk_bf16(o0[0], o0[1]); wo.y = cvt_pk_bf16(o0[2], o0[3]); wo.z = cvt_pk_bf16(o1[0], o1[1]); wo.w = cvt_pk_bf16(o1[2], o1[3]);
                    *(u32x4*)(rowp + bj * HALF) = wo;
                    if (gain) { ssq += ((o0[0] * o0[0] + o0[1] * o0[1]) + (o0[2] * o0[2] + o0[3] * o0[3])) + ((o1[0] * o1[0] + o1[1] * o1[1]) + (o1[2] * o1[2] + o1[3] * o1[3]));
                        if (XR) { const f32x4 y0 = o0 * gv[bj][0], y1 = o1 * gv[bj][1];
                        u32x4 wy; wy.x = cvt_pk_bf16(y0[0], y0[1]); wy.y = cvt_pk_bf16(y0[2], y0[3]); wy.z = cvt_pk_bf16(y1[0], y1[1]); wy.w = cvt_pk_bf16(y1[2], y1[3]);
                        *(u32x4*)(XR + (size_t)row * ldx + col0 + bj * HALF) = wy; } } }
                if (gain) { ssq += __shfl_xor(ssq, 16); ssq += __shfl_xor(ssq, 32); if (fq == 0) SSP[(size_t)row * 32 + u.pn * 4 + wc] = ssq; }
            }
        }
    }
};
struct EpiStoreBf16 {
    static constexpr bool PERM = true, AFTER_DRAIN = false;
    bf16_t* O; int ldo; const float* rstd;
    __device__ __forceinline__ void operator()(const f32x4 (&acc)[2][2][4][2], const Unit& u, int wr, int wc, int fr, int fq) const {
        const int row0 = u.pm * BM + wr * 64 + fr, col0 = u.pn * BM + wc * 32 + 8 * fq;
        float rsv[2][4];
#pragma unroll
        for (int ai = 0; ai < 2; ++ai)
#pragma unroll
            for (int m = 0; m < 4; ++m) rsv[ai][m] = rstd[row0 + ai * HALF + m * 16];
#pragma unroll
        for (int ai = 0; ai < 2; ++ai)
#pragma unroll
            for (int m = 0; m < 4; ++m) {
                bf16_t* rowp = O + (size_t)(row0 + ai * HALF + m * 16) * ldo + col0; const float rs = rsv[ai][m];
#pragma unroll
                for (int bj = 0; bj < 2; ++bj) { const f32x4 v0 = acc[ai][bj][m][0] * rs, v1 = acc[ai][bj][m][1] * rs;
                    u32x4 w; w.x = cvt_pk_bf16(v0[0], v0[1]); w.y = cvt_pk_bf16(v0[2], v0[3]); w.z = cvt_pk_bf16(v1[0], v1[1]); w.w = cvt_pk_bf16(v1[2], v1[3]);
                    *(u32x4*)(rowp + bj * HALF) = w; }
            }
    }
};
struct EpiLora {
    static constexpr bool PERM = true, AFTER_DRAIN = false;
    bf16_t* O; const float* w0; const float* a0;
    __device__ __forceinline__ void operator()(const f32x4 (&acc)[2][2][4][2], const Unit& u, int wr, int wc, int fr, int fq) const {
        const int row0 = u.pm * BM + wr * 64 + fr, col0 = u.pn * BM + wc * 32 + 8 * fq, ty = u.pn >> 2;
        f32x4 bv[2][2];
#pragma unroll
        for (int bj = 0; bj < 2; ++bj)
#pragma unroll
            for (int n = 0; n < 2; ++n) { const int c = (col0 + bj * HALF + n * 4) & 1023; bv[bj][n] = ty == 0 ? *(const f32x4*)(w0 + c) : (ty == 1 ? *(const f32x4*)(a0 + c) : (f32x4){0.f, 0.f, 0.f, 0.f}); }
#pragma unroll
        for (int ai = 0; ai < 2; ++ai)
#pragma unroll
            for (int m = 0; m < 4; ++m) {
                bf16_t* rowp = O + (size_t)(row0 + ai * HALF + m * 16) * NLORA + col0;
#pragma unroll
                for (int bj = 0; bj < 2; ++bj)
#pragma unroll
                    for (int n = 0; n < 2; ++n) {
                        f32x4 v = acc[ai][bj][m][n] + bv[bj][n];
                        if (ty == 0) {
#pragma unroll
                            for (int i = 0; i < 4; ++i) v[i] = -0.60653065971f * sigm(v[i]);
                        } else if (ty == 1) {
#pragma unroll
                            for (int i = 0; i < 4; ++i) v[i] = sigm(v[i]);
                        }
                        u32x2 w2_; w2_.x = cvt_pk_bf16(v[0], v[1]); w2_.y = cvt_pk_bf16(v[2], v[3]); *(u32x2*)(rowp + bj * HALF + n * 4) = w2_;
                    }
            }
    }
};
struct EpiOddIn {
    static constexpr bool PERM = true, AFTER_DRAIN = false;
    bf16_t* GATE; bf16_t* XB; const float* rstd; bf16_t* SLAB;
    __device__ __forceinline__ void operator()(const f32x4 (&acc)[2][2][4][2], const Unit& u, int wr, int wc, int fr, int fq) const {
        if (u.slab >= 0) {
            bf16_t* base = SLAB + (size_t)u.slab * 65536 + (wr * 64 + fr) * 256 + wc * 32 + 8 * fq;
#pragma unroll
            for (int ai = 0; ai < 2; ++ai)
#pragma unroll
                for (int m = 0; m < 4; ++m)
#pragma unroll
                    for (int bj = 0; bj < 2; ++bj) { const f32x4 v0 = acc[ai][bj][m][0], v1 = acc[ai][bj][m][1];
                        u32x4 w; w.x = cvt_pk_bf16(v0[0], v0[1]); w.y = cvt_pk_bf16(v0[2], v0[3]); w.z = cvt_pk_bf16(v1[0], v1[1]); w.w = cvt_pk_bf16(v1[2], v1[3]);
                        *(u32x4*)(base + (ai * HALF + m * 16) * 256 + bj * HALF) = w; }
            return;
        }
        const int row0 = u.pm * BM + wr * 64 + fr, col0 = (u.pn & 7) * BM + wc * 32 + 8 * fq; const bool isg = u.pn < 8;
        bf16_t* dst = isg ? GATE : XB;
        float rsv[2][4];
#pragma unroll
        for (int ai = 0; ai < 2; ++ai)
#pragma unroll
            for (int m = 0; m < 4; ++m) rsv[ai][m] = rstd[row0 + ai * HALF + m * 16];
#pragma unroll
        for (int ai = 0; ai < 2; ++ai)
#pragma unroll
            for (int m = 0; m < 4; ++m) {
                const size_t ro = (size_t)(row0 + ai * HALF + m * 16) * 2048 + col0; const float rs = rsv[ai][m];
#pragma unroll
                for (int bj = 0; bj < 2; ++bj) {
                    f32x4 v0 = acc[ai][bj][m][0] * rs, v1 = acc[ai][bj][m][1] * rs;
                    if (isg) {
#pragma unroll
                        for (int q = 0; q < 4; ++q) { v0[q] = gelu_tanh(v0[q]); v1[q] = gelu_tanh(v1[q]); } }
                    u32x4 w; w.x = cvt_pk_bf16(v0[0], v0[1]); w.y = cvt_pk_bf16(v0[2], v0[3]); w.z = cvt_pk_bf16(v1[0], v1[1]); w.w = cvt_pk_bf16(v1[2], v1[3]);
                    *(u32x4*)(dst + ro + bj * HALF) = w;
                }
            }
    }
};
struct EpiLru {
    static constexpr bool PERM = true, AFTER_DRAIN = false;
    const bf16_t* XC; bf16_t* OA; bf16_t* OB; const float* ba; const float* bx; const float* lam;
    __device__ __forceinline__ void operator()(const f32x4 (&acc)[2][2][4][2], const Unit& u, int wr, int wc, int fr, int fq) const {
        const int row0 = u.pm * BM + wr * 64 + fr, ch0 = u.pn * HALF + wc * 32 + 8 * fq;
#pragma unroll
        for (int n = 0; n < 2; ++n) {
            const f32x4 vba = *(const f32x4*)(ba + ch0 + n * 4), vbx = *(const f32x4*)(bx + ch0 + n * 4), l = *(const f32x4*)(lam + ch0 + n * 4); f32x4 vsl;
#pragma unroll
            for (int i = 0; i < 4; ++i) vsl[i] = -8.0f * softplus_(-l[i]);
            u32x2 xw[2][4];
#pragma unroll
            for (int ai = 0; ai < 2; ++ai)
#pragma unroll
                for (int m = 0; m < 4; ++m) xw[ai][m] = *(const u32x2*)(XC + (size_t)(row0 + ai * HALF + m * 16) * 2048 + ch0 + n * 4);
#pragma unroll
            for (int ai = 0; ai < 2; ++ai)
#pragma unroll
                for (int m = 0; m < 4; ++m) {
                    const size_t ro = (size_t)(row0 + ai * HALF + m * 16) * 2048 + ch0 + n * 4;
                    const f32x4 ga = acc[ai][0][m][n] + vba, gx = acc[ai][1][m][n] + vbx; const u32x2 w2 = xw[ai][m];
                    const f32x4 xc = {__builtin_bit_cast(float, w2.x << 16), __builtin_bit_cast(float, w2.x & 0xffff0000u), __builtin_bit_cast(float, w2.y << 16), __builtin_bit_cast(float, w2.y & 0xffff0000u)};
                    f32x4 la, b;
#pragma unroll
                    for (int i = 0; i < 4; ++i) { la[i] = vsl[i] * sigm(ga[i]); b[i] = sqrtf(neg_expm1(2.0f * la[i])) * sigm(gx[i]) * xc[i]; }
                    u32x2 wa_, wb_; wa_.x = cvt_pk_bf16(la[0], la[1]); wa_.y = cvt_pk_bf16(la[2], la[3]); wb_.x = cvt_pk_bf16(b[0], b[1]); wb_.y = cvt_pk_bf16(b[2], b[3]);
                    *(u32x2*)(OA + ro) = wa_; *(u32x2*)(OB + ro) = wb_;
                }
        }
    }
};

template <class Epi, class Sched, bool ALIGN_EPI = false, bool SP2 = false>
__device__ __forceinline__ void gemm_phase(PG8_LAS unsigned char* lds, const Gemm g, const Sched& S, const Epi& E) {
    int tid_ = threadIdx.x; asm volatile("" : "+v"(tid_));
    const int tid = tid_, wid = __builtin_amdgcn_readfirstlane(tid >> 6), lane = tid & 63, wr = wid >> 2, wc = wid & 3, fr = lane & 15, fq = lane >> 4;
    const int lda = g.lda, ldb = g.ldb;
    unsigned voffA[2], voffB[2];
#pragma unroll
    for (int i = 0; i < 2; ++i) { int R, C; stage_rc(tid * 16 + i * 8192, R, C); const int Rb = Epi::PERM ? ((R & ~31) + perm32(R & 31)) : R;
        voffA[i] = (unsigned)(R * lda + C) * 2u; voffB[i] = (unsigned)(Rb * ldb + C) * 2u; }
    const size_t kstep = (size_t)(BK * 2);
    const size_t hstepA = (size_t)HALF * lda * 2, hstepB = (size_t)HALF * ldb * 2;
    const size_t tstepA = 2 * hstepA, tstepB = 2 * hstepB;
    const unsigned ldsw = (unsigned)wid * 1024u;
    const int aoff = lds_byte(wr * 64 + fr, fq * 8), boff = lds_byte(wc * 32 + fr, fq * 8);
#define PG8_SA(b, h) (((b) * 2 + (h)) * HTB)
#define PG8_SB(b, h) ((4 + (b) * 2 + (h)) * HTB)
#define PG8_STAGE(bufoff, gbase, voff) do { _Pragma("unroll") for (int _i = 0; _i < 2; ++_i) \
        __builtin_amdgcn_global_load_lds((const unsigned*)((const char*)(gbase) + (voff)[_i]), (PG8_LAS unsigned*)(lds + (bufoff) + ldsw + _i * 8192), 16, 0, 0); } while (0)
#define PG8_LDA(dst, b, h) do { _Pragma("unroll") for (int m = 0; m < 4; ++m) _Pragma("unroll") for (int k = 0; k < 2; ++k) dst[m][k] = *(const PG8_LAS bf16x8*)(lds + PG8_SA(b, h) + aoff + m * 2048 + k * 1024); } while (0)
#define PG8_LDB(dst, b, h) do { _Pragma("unroll") for (int n = 0; n < 2; ++n) _Pragma("unroll") for (int k = 0; k < 2; ++k) dst[n][k] = *(const PG8_LAS bf16x8*)(lds + PG8_SB(b, h) + boff + n * 2048 + k * 1024); } while (0)
#define PG8_MMA(ai, bj, At, Bt) do { __builtin_amdgcn_s_setprio(1); _Pragma("unroll") for (int m = 0; m < 4; ++m) _Pragma("unroll") for (int n = 0; n < 2; ++n) _Pragma("unroll") for (int k = 0; k < 2; ++k) \
        acc[ai][bj][m][n] = __builtin_amdgcn_mfma_f32_16x16x32_bf16(Bt[n][k], At[m][k], acc[ai][bj][m][n], 0, 0, 0); __builtin_amdgcn_s_setprio(0); } while (0)
#define PG8_WAIT_V(n) asm volatile("s_waitcnt vmcnt(" #n ")" ::: "memory")
#define PG8_WAIT_L(n) asm volatile("s_waitcnt lgkmcnt(" #n ")" ::: "memory")
#define PG8_BAR __builtin_amdgcn_s_barrier()
#define PG8_SCHED __builtin_amdgcn_sched_barrier(0)
    Unit cur, nxt; int ui = 0;
    if (!S.next(0, cur)) return;
    f32x4 acc[2][2][4][2];
#pragma unroll
    for (int a = 0; a < 2; ++a)
#pragma unroll
        for (int b = 0; b < 2; ++b)
#pragma unroll
            for (int m = 0; m < 4; ++m)
#pragma unroll
                for (int n = 0; n < 2; ++n) acc[a][b][m][n] = (f32x4){0.f, 0.f, 0.f, 0.f};
    bf16x8 At[4][2], B0[2][2], B1[2][2];
    const char* cA = (const char*)g.A + (size_t)cur.pm * tstepA + (size_t)cur.ka * 2; const char* cB = (const char*)g.Bt + (size_t)cur.pn * tstepB + (size_t)cur.kb * 2; int nt = cur.nt;
    S.a_ready(cur);
    if constexpr (SP2) {
        PG8_STAGE(PG8_SB(0, 0), cB, voffB); PG8_STAGE(PG8_SB(0, 1), cB + hstepB, voffB); PG8_STAGE(PG8_SA(0, 0), cA, voffA); PG8_STAGE(PG8_SA(0, 1), cA + hstepA, voffA);
        if (wr == 1) PG8_BAR;
        PG8_WAIT_V(2); PG8_BAR;
        PG8_STAGE(PG8_SB(1, 0), cB + kstep, voffB); PG8_STAGE(PG8_SA(1, 0), cA + kstep, voffA); PG8_STAGE(PG8_SB(1, 1), cB + hstepB + kstep, voffB);
        PG8_WAIT_V(6); PG8_BAR;
    } else {
        PG8_STAGE(PG8_SB(0, 0), cB, voffB); PG8_STAGE(PG8_SA(0, 0), cA, voffA); PG8_STAGE(PG8_SB(0, 1), cB + hstepB, voffB); PG8_STAGE(PG8_SA(0, 1), cA + hstepA, voffA);
        if (wr == 1) PG8_BAR;
        PG8_WAIT_V(4); PG8_BAR;
        PG8_STAGE(PG8_SB(1, 0), cB + kstep, voffB); PG8_STAGE(PG8_SA(1, 0), cA + kstep, voffA); PG8_STAGE(PG8_SB(1, 1), cB + hstepB + kstep, voffB);
        PG8_WAIT_V(6); PG8_BAR;
    }
    for (;;) {
        const bool has_next = S.next(ui + 1, nxt);
        const char* nA = has_next ? (const char*)g.A + (size_t)nxt.pm * tstepA + (size_t)nxt.ka * 2 : cA; const char* nB = has_next ? (const char*)g.Bt + (size_t)nxt.pn * tstepB + (size_t)nxt.kb * 2 : cB;
        for (int t = 0; t < nt; t += 2) {
            const bool last = (t == nt - 2);
            const char* a1 = cA + (size_t)(t + 1) * kstep;
            const char* a2 = last ? nA : cA + (size_t)(t + 2) * kstep; const char* b2 = last ? nB : cB + (size_t)(t + 2) * kstep;
            const char* a3 = a2 + kstep; const char* b3 = b2 + kstep;
            if (last && has_next) S.a_ready(nxt);
            if constexpr (SP2) {
            PG8_LDB(B0, 0, 0); PG8_LDB(B1, 0, 1); PG8_SCHED; PG8_LDA(At, 0, 0); PG8_STAGE(PG8_SA(1, 1), a1 + hstepA, voffA);
            PG8_WAIT_V(8); PG8_WAIT_L(0); PG8_BAR; PG8_MMA(0, 0, At, B0); PG8_MMA(0, 1, At, B1); PG8_BAR; PG8_SCHED;
            PG8_LDA(At, 0, 1); PG8_STAGE(PG8_SB(0, 0), b2, voffB); PG8_STAGE(PG8_SB(0, 1), b2 + hstepB, voffB); PG8_STAGE(PG8_SA(0, 0), a2, voffA);
            PG8_WAIT_V(8); PG8_WAIT_L(0); PG8_BAR; PG8_MMA(1, 0, At, B0); PG8_MMA(1, 1, At, B1); PG8_BAR; PG8_SCHED;
            PG8_LDB(B0, 1, 0); PG8_LDB(B1, 1, 1); PG8_SCHED; PG8_LDA(At, 1, 0); PG8_STAGE(PG8_SA(0, 1), a2 + hstepA, voffA);
            PG8_WAIT_V(8); PG8_WAIT_L(0); PG8_BAR; PG8_MMA(0, 0, At, B0); PG8_MMA(0, 1, At, B1); PG8_BAR; PG8_SCHED;
            PG8_LDA(At, 1, 1); PG8_STAGE(PG8_SB(1, 0), b3, voffB); PG8_STAGE(PG8_SB(1, 1), b3 + hstepB, voffB); PG8_STAGE(PG8_SA(1, 0), a3, voffA);
            PG8_WAIT_V(8); PG8_WAIT_L(0); PG8_BAR; PG8_MMA(1, 0, At, B0); PG8_MMA(1, 1, At, B1); PG8_BAR; PG8_SCHED;
            } else {
            PG8_LDB(B0, 0, 0); PG8_SCHED; PG8_LDA(At, 0, 0); PG8_STAGE(PG8_SA(1, 1), a1 + hstepA, voffA);
            PG8_WAIT_L(8); PG8_BAR; PG8_WAIT_L(0); PG8_MMA(0, 0, At, B0); PG8_BAR; PG8_SCHED;
            PG8_LDB(B1, 0, 1); PG8_STAGE(PG8_SB(0, 0), b2, voffB);
            PG8_BAR; PG8_WAIT_L(0); PG8_MMA(0, 1, At, B1); PG8_BAR;
            PG8_LDA(At, 0, 1); PG8_STAGE(PG8_SA(0, 0), a2, voffA);
            PG8_BAR; PG8_WAIT_L(0); PG8_MMA(1, 0, At, B0); PG8_BAR; PG8_SCHED;
            PG8_STAGE(PG8_SB(0, 1), b2 + hstepB, voffB);
            PG8_WAIT_V(6); PG8_BAR; PG8_MMA(1, 1, At, B1); PG8_BAR;
            PG8_LDB(B0, 1, 0); PG8_SCHED; PG8_LDA(At, 1, 0); PG8_STAGE(PG8_SA(0, 1), a2 + hstepA, voffA);
            PG8_WAIT_L(8); PG8_BAR; PG8_WAIT_L(0); PG8_MMA(0, 0, At, B0); PG8_BAR; PG8_SCHED;
            PG8_LDB(B1, 1, 1); PG8_STAGE(PG8_SB(1, 0), b3, voffB);
            PG8_BAR; PG8_WAIT_L(0); PG8_MMA(0, 1, At, B1); PG8_BAR;
            PG8_LDA(At, 1, 1); PG8_STAGE(PG8_SA(1, 0), a3, voffA);
            PG8_BAR; PG8_WAIT_L(0); PG8_MMA(1, 0, At, B0); PG8_BAR; PG8_SCHED;
            PG8_STAGE(PG8_SB(1, 1), b3 + hstepB, voffB);
            PG8_WAIT_V(6); PG8_BAR; PG8_MMA(1, 1, At, B1); PG8_BAR;
            }
        }
        if constexpr (ALIGN_EPI) { if (wr == 0) PG8_BAR; }
        if constexpr (!Epi::AFTER_DRAIN) { E(acc, cur, wr, wc, fr, fq); if (EPI_REP > 1) { asm volatile("" ::: "memory"); E(acc, cur, wr, wc, fr, fq); } S.done(cur); }
        if (!has_next) break;
#pragma unroll
        for (int a = 0; a < 2; ++a)
#pragma unroll
            for (int b = 0; b < 2; ++b)
#pragma unroll
                for (int m = 0; m < 4; ++m)
#pragma unroll
                    for (int n = 0; n < 2; ++n) acc[a][b][m][n] = (f32x4){0.f, 0.f, 0.f, 0.f};
        cur = nxt; cA = nA; cB = nB; nt = cur.nt; ++ui;
        if constexpr (ALIGN_EPI) { if (wr == 1) PG8_BAR; }
    }
    PG8_WAIT_V(0);
    if constexpr (!ALIGN_EPI) { if (wr == 0) PG8_BAR; }
    PG8_BAR;
    if constexpr (Epi::AFTER_DRAIN) { E.fused(acc, cur, wr, wc, fr, fq, lds, wid, lane); S.done(cur); }
#undef PG8_SA
#undef PG8_SB
#undef PG8_STAGE
#undef PG8_LDA
#undef PG8_LDB
#undef PG8_MMA
#undef PG8_WAIT_V
#undef PG8_WAIT_L
#undef PG8_BAR
#undef PG8_SCHED
}
}

constexpr size_t MiB = 1u << 20;
constexpr size_t WS_CTL = 0, CTL_ZERO_BYTES = 512 * 1024;
constexpr size_t SZ_WGU = (size_t)2 * FF * D * 2, SZ_WDN = (size_t)D * FF * 2;
constexpr size_t SZ_WEVIN = (size_t)NEV * D * 2, SZ_WSQ = (size_t)D * D * 2, SZ_WODIN = (size_t)2 * D * D * 2;
constexpr size_t SZ_WLORA = (size_t)NLORA * KLORA * 2, SZ_WLRU = (size_t)4096 * 256 * 2;
constexpr size_t WS_WGU = 1 * MiB;
constexpr size_t WS_WDN = WS_WGU + 8 * SZ_WGU;
constexpr size_t WS_WEVIN = WS_WDN + 8 * SZ_WDN;
constexpr size_t WS_WEVOUT = WS_WEVIN + 2 * SZ_WEVIN;
constexpr size_t WS_WODIN = WS_WEVOUT + 2 * SZ_WSQ;
constexpr size_t WS_WODOUT = WS_WODIN + 2 * SZ_WODIN;
constexpr size_t WS_WLORA = WS_WODOUT + 2 * SZ_WSQ;
constexpr size_t WS_WLRU = WS_WLORA + 2 * SZ_WLORA;
constexpr size_t WS_X = WS_WLRU + 2 * SZ_WLRU;
constexpr size_t WS_XN = WS_X + (size_t)M * D * 4;
constexpr size_t WS_H = WS_XN + (size_t)M * D * 2;
constexpr size_t WS_YIN = WS_H + (size_t)M * FF * 2;
constexpr size_t WS_MIX = WS_YIN + (size_t)M * D * 2;
constexpr size_t WS_PROJ = WS_MIX;
constexpr size_t WS_WAG = WS_PROJ + (size_t)M * NEV * 4;
constexpr size_t WS_LA = WS_WAG + (size_t)M * NLORA * 4;
constexpr size_t WS_HU = WS_LA + (size_t)M * KLORA * 2;
constexpr size_t WS_HD = WS_HU + (size_t)1024 * 16384 * 4;
constexpr size_t WS_PST = WS_HD + (size_t)1024 * 128 * 4;
constexpr size_t WS_QST = WS_PST + (size_t)8192 * 4096 * 2;
constexpr size_t WS_OB2 = WS_QST + (size_t)8192 * 4096 * 4;
constexpr size_t WS_SSP = WS_OB2 + (size_t)MP * 1024 * 4;
constexpr size_t WS_RSTD = WS_SSP + (size_t)M * 32 * 4;
constexpr size_t WS_EVEN_END = WS_RSTD + (size_t)M * 4;
constexpr size_t WS_OI = WS_H, WS_QT = WS_H + (size_t)MP * 1024 * 4;
constexpr size_t WS_RQ = WS_QT + (size_t)MP * 1024 * 4;
constexpr size_t WS_OB = WS_XN;
static_assert(WS_RQ + (size_t)8192 * 1024 * 2 <= WS_YIN, "OI/QT/RQ overlay fits in H");
constexpr size_t WS_SLAB = WS_MIX;
constexpr size_t WS_OSLAB = WS_PST;
constexpr size_t WS_XB = WS_MIX;
constexpr size_t WS_GATE = WS_XB + (size_t)M * 2048 * 4;
constexpr size_t WS_XC = WS_GATE + (size_t)M * 2048 * 2;
constexpr size_t WS_XCB = WS_XC + (size_t)M * 2048 * 4;
constexpr size_t WS_LRA = WS_XCB + (size_t)M * 2048 * 2;
constexpr size_t WS_LRB = WS_LRA + (size_t)M * 2048 * 4;
constexpr size_t WS_CP = WS_LRB + (size_t)M * 2048 * 4;
constexpr size_t WS_CH = WS_CP + (size_t)4 * 32 * 2048 * 4;
constexpr size_t WS_ODD_END = WS_CH + (size_t)4 * 32 * 2048 * 4;
constexpr size_t WS_END = WS_EVEN_END > WS_ODD_END ? WS_EVEN_END : WS_ODD_END;
constexpr int CW_BAR = 4096;
constexpr int PAR_FFN1N = 0, PAR_MIXN = 8192, PAR_FFN2N = 16384, PAR_FINN = 24576, PAR_MU = 26624, PAR_W0 = 33664, PAR_A0 = 35712, PAR_KK = 37760, PAR_KA = 39808,
              PAR_RK = 41856, PAR_LNW = 43904, PAR_LNB = 45952, PAR_HGLB = 48000, PAR_HGN = 50048, PAR_CONVW = 52096, PAR_CONVB = 68480, PAR_BA = 72576, PAR_BX = 76672,
              PAR_LAM = 80768, PAR_END = 84864;
constexpr size_t WS_PAR = 512 * 1024;

constexpr size_t O_Y = 0, O_PSHIFT = (size_t)M * D, O_PRWKV = O_PSHIFT + (size_t)BP * 2 * PRW, O_PHGRN = O_PRWKV + (size_t)BP * 2 * 16 * 4096,
                 O_PCONV = O_PHGRN + (size_t)BP * 2 * 8 * 16384, O_PLRU = O_PCONV + (size_t)BP * 2 * 3 * 2048, O_SSHIFT = O_PLRU + (size_t)BP * 2 * 2048,
                 O_SRWKV = O_SSHIFT + (size_t)BS * 2 * PRW, O_SHGRN = O_SRWKV + (size_t)BS * 2 * 16 * 4096, O_SCONV = O_SHGRN + (size_t)BS * 2 * 8 * 16384,
                 O_SLRU = O_SCONV + (size_t)BS * 2 * 3 * 2048, O_END = O_SLRU + (size_t)BS * 2 * 2048;

constexpr int LDS_BYTES = 155648;
constexpr int MISC_OFF = 153600;

#define GAS __attribute__((address_space(1)))
#define LAS __attribute__((address_space(3)))
typedef unsigned short bf16;
typedef unsigned v4u __attribute__((ext_vector_type(4)));
typedef unsigned v2u __attribute__((ext_vector_type(2)));
typedef float f32x4 __attribute__((ext_vector_type(4)));
typedef float f32x2 __attribute__((ext_vector_type(2)));
using pg8::sigm; using pg8::silu_; using pg8::softplus_; using pg8::cvt_pk_bf16;
#define LDS_WAIT() asm volatile("s_waitcnt lgkmcnt(0)" ::: "memory")
#define VM_WAIT() asm volatile("s_waitcnt vmcnt(0)" ::: "memory")
__device__ __forceinline__ unsigned f2bf(float f) { unsigned u = __builtin_bit_cast(unsigned, f); return (u + 0x7fffu + ((u >> 16) & 1u)) >> 16; }
__device__ __forceinline__ unsigned pk2(float lo, float hi) { return f2bf(lo) | (f2bf(hi) << 16); }
__device__ __forceinline__ float bf2f(unsigned h) { return __builtin_bit_cast(float, h << 16); }
template <int CTRL> __device__ __forceinline__ float dppf(float v) { return __builtin_bit_cast(float, __builtin_amdgcn_update_dpp(0, __builtin_bit_cast(int, v), CTRL, 0xf, 0xf, true)); }
__device__ __forceinline__ float red8(float x) { x += dppf<0xB1>(x); x += dppf<0x4E>(x); x += dppf<0x141>(x); return x; }
__device__ __forceinline__ float red16(float x) { x = red8(x); x += dppf<0x140>(x); return x; }
__device__ __forceinline__ float wave_sum(float v) {
#pragma unroll
    for (int o = 1; o < 64; o <<= 1) v += __shfl_xor(v, o);
    return v;
}
#define XB_TMO      128
#define XB_XCNT(j)  (256  + 64 * (j))
#define XB_XSUB(j)  (1280 + 64 * (j))
#define XB_XGEN(j)  (2304 + 64 * (j))
#define XB_TOP      3328
#define XB_TOPGEN   3392
#define XCD_BAR_WORDS 3456
#define XB_SPIN_CAP (1u << 18)

__device__ __forceinline__ unsigned xb_ld(unsigned* p)              { return __hip_atomic_load(p, __ATOMIC_RELAXED, __HIP_MEMORY_SCOPE_AGENT); }
__device__ __forceinline__ unsigned xb_add(unsigned* p, unsigned v) { return __hip_atomic_fetch_add(p, v, __ATOMIC_RELAXED, __HIP_MEMORY_SCOPE_AGENT); }
__device__ __forceinline__ unsigned xb_xcc_id() { return (unsigned)__builtin_amdgcn_s_getreg((3 << 11) | 20) & 0xFu; }
#define XB_SPIN(cond, bar) do { unsigned _sp = 0; while (cond) { __builtin_amdgcn_s_sleep(1); \
    if ((++_sp & 255u) == 0u) { if (xb_ld(&(bar)[XB_TMO])) break; if (_sp > XB_SPIN_CAP) { atomicAdd(&(bar)[XB_TMO], 1u); break; } } } } while (0)

struct XcdBarrier {
    unsigned* bar; unsigned x;
    volatile LAS unsigned* st;
};

__device__ __forceinline__ XcdBarrier xcd_barrier_post(unsigned* bar, volatile LAS unsigned* st) {
    XcdBarrier b; b.bar = bar; b.x = xb_xcc_id(); b.st = st;
    if (threadIdx.x == 0) (void)xb_add(&bar[XB_XCNT(b.x)], 1u);
    return b;
}
__device__ __forceinline__ void xcd_barrier_complete(unsigned* bar, unsigned x, unsigned& nloc, unsigned& nx) {
    const unsigned G = gridDim.x * gridDim.y * gridDim.z;
    unsigned sum, cnt, mine, sp = 0u;
    for (;;) {
        sum = 0u; cnt = 0u; mine = 0u;
#pragma unroll
        for (unsigned j = 0; j < 16; ++j) { const unsigned c = xb_ld(&bar[XB_XCNT(j)]); sum += c; cnt += (c > 0u) ? 1u : 0u; mine = (j == x) ? c : mine; }
        if (sum == G) break;
        __builtin_amdgcn_s_sleep(1);
        if ((++sp & 255u) == 0u) { if (xb_ld(&bar[XB_TMO])) break; if (sp > XB_SPIN_CAP) { atomicAdd(&bar[XB_TMO], 1u); break; } }
    }
    nloc = mine > 0u ? mine : 1u; nx = cnt > 0u ? cnt : 1u;
}

__device__ __forceinline__ void xcd_barrier(const XcdBarrier& b) {
    asm volatile("s_waitcnt vmcnt(0)" ::: "memory");
    __syncthreads();
    if (threadIdx.x == 0) {
        unsigned* bar = b.bar;
        __builtin_amdgcn_s_waitcnt(0);
        unsigned nloc = b.st[0], nx = b.st[1];
        if (nloc == 0u) { xcd_barrier_complete(bar, b.x, nloc, nx); b.st[0] = nloc; b.st[1] = nx; }
        const unsigned old = xb_add(&bar[XB_XSUB(b.x)], 1u);
        const unsigned gen = old / nloc;
        if (old + 1u == (gen + 1u) * nloc) {
            __builtin_amdgcn_fence(__ATOMIC_RELEASE, "agent");
            asm volatile("s_waitcnt vmcnt(0)" ::: "memory");
            const unsigned og = xb_add(&bar[XB_TOP], 1u);
            const unsigned tg = og / nx;
            if (og + 1u == (tg + 1u) * nx) xb_add(&bar[XB_TOPGEN], 1u);
            else XB_SPIN(xb_ld(&bar[XB_TOPGEN]) == tg, bar);
            __builtin_amdgcn_fence(__ATOMIC_ACQUIRE, "agent");
            xb_add(&bar[XB_XGEN(b.x)], 1u);
            asm volatile("s_waitcnt vmcnt(0)" ::: "memory");
        } else {
            XB_SPIN(xb_ld(&bar[XB_XGEN(b.x)]) == gen, bar);
            __builtin_amdgcn_fence(__ATOMIC_ACQUIRE, "agent");
            asm volatile("s_waitcnt vmcnt(0)" ::: "memory");
        }
    }
    __syncthreads();
}


#define GAS __attribute__((address_space(1)))
struct Args { const float* in[39]; GAS float* out; GAS unsigned char* ws; int ph_lo, ph_hi, li, pad; };
#define AOUT ((float*)A.out)
struct Frame { LAS unsigned char* lds; int tid, lane, wave, G, blk; };
#define PARP(off) ((const float*)(A.ws + WS_PAR) + (off))
__device__ __forceinline__ f32x4 ld4(const float* p) { return *(const f32x4*)p; }
__device__ __forceinline__ f32x4 ldp4(const bf16* p) { const v2u w = *(const v2u*)p; return (f32x4){bf2f(w.x & 0xffffu), bf2f(w.x >> 16), bf2f(w.y & 0xffffu), bf2f(w.y >> 16)}; }
__device__ __forceinline__ f32x4 cvq(const v2u w) { return (f32x4){bf2f(w.x & 0xffffu), bf2f(w.x >> 16), bf2f(w.y & 0xffffu), bf2f(w.y >> 16)}; }
__device__ __forceinline__ void st4bf(bf16* p, f32x4 v) { v2u w; w.x = cvt_pk_bf16(v[0], v[1]); w.y = cvt_pk_bf16(v[2], v[3]); *(v2u*)p = w; }

__device__ __forceinline__ void tr_item(const float* src, int Nsrc, int srcc0, int k0, bf16* dst, int ldd, int n0, LAS float* scr, int lane, const float* gk = nullptr) {
    const int r4 = lane >> 4, q = lane & 15;
    if (srcc0 >= 0) {
        f32x4 v[16];
#pragma unroll
        for (int i = 0; i < 16; ++i) v[i] = ld4(src + (size_t)(k0 + 4 * i + r4) * Nsrc + srcc0 + 4 * q);
#pragma unroll
        for (int i = 0; i < 16; ++i) { const float gf = gk ? gk[k0 + 4 * i + r4] : 1.0f; LAS float* s = scr + (4 * i + r4) * 65 + 4 * q; s[0] = v[i][0] * gf; s[1] = v[i][1] * gf; s[2] = v[i][2] * gf; s[3] = v[i][3] * gf; }
    } else {
#pragma unroll 4
        for (int i = 0; i < 16; ++i) { const int k = 4 * i + r4; LAS float* s = scr + k * 65 + 4 * q; s[0] = 0.f; s[1] = 0.f; s[2] = 0.f; s[3] = 0.f; }
    }
    LDS_WAIT(); asm volatile("" ::: "memory");
    const int c = lane & 7;
#pragma unroll
    for (int j = 0; j < 8; ++j) { const int n = (lane >> 3) + 8 * j; const LAS float* s = scr + (8 * c) * 65 + n;
        v4u o; o.x = pk2(s[0 * 65], s[1 * 65]); o.y = pk2(s[2 * 65], s[3 * 65]); o.z = pk2(s[4 * 65], s[5 * 65]); o.w = pk2(s[6 * 65], s[7 * 65]);
        *(v4u*)(dst + (size_t)(n0 + n) * ldd + k0 + 8 * c) = o; }
    LDS_WAIT(); asm volatile("" ::: "memory");
}
constexpr int IT_GU = 32 * 176, IT_DN = 88 * 32, IT_EVIN = 32 * 120, IT_SQ = 32 * 32, IT_ODIN = 32 * 64;
constexpr int IT_TOTAL = 8 * IT_GU + 8 * IT_DN + 2 * IT_EVIN + 2 * IT_SQ + 2 * IT_ODIN + 2 * IT_SQ;

__device__ __forceinline__ void norm_row(const float* xrow, const bf16* xrow16, const float* gain, bf16* xn, float* y, bf16* xcopy, int lane, int sf = 0, float scale = 0.f, const float* slab = nullptr, int m = 0, bf16* xrow_w = nullptr, float* rstd_out = nullptr) {
    f32x4 v[8]; float s = 0.f;
#pragma unroll
    for (int j = 0; j < 8; ++j) v[j] = xrow16 ? ldp4(xrow16 + 4 * lane + 256 * j) : ld4(xrow + 4 * lane + 256 * j);
    if (sf > 0 && m >= MP) {
        const int r = m & 255, j0 = ((m >> 8) - 32) * 8;
#pragma unroll
        for (int jj = 0; jj < 8; ++jj) { f32x4 add = {0.f, 0.f, 0.f, 0.f};
            for (int p = 0; p < sf; ++p) { const v2u w2 = *(const v2u*)((const bf16*)slab + (size_t)((j0 + jj) * sf + p) * 65536 + r * 256 + 4 * lane); add += (f32x4){bf2f(w2.x & 0xffffu), bf2f(w2.x >> 16), bf2f(w2.y & 0xffffu), bf2f(w2.y >> 16)}; }
            v[jj] += add * scale; st4bf(xrow_w + 4 * lane + 256 * jj, v[jj]); }
    }
#pragma unroll
    for (int j = 0; j < 8; ++j) s += (v[j][0] * v[j][0] + v[j][1] * v[j][1]) + (v[j][2] * v[j][2] + v[j][3] * v[j][3]);
    const float rstd = 1.0f / sqrtf(wave_sum(s) * (1.0f / D) + 1e-6f);
#pragma unroll
    for (int j = 0; j < 8; ++j) {
        if (xcopy) st4bf(xcopy + 4 * lane + 256 * j, v[j]);
        const f32x4 gq = ld4(gain + 4 * lane + 256 * j), o = v[j] * rstd * gq;
        if (xn) st4bf(xn + 4 * lane + 256 * j, rstd_out ? v[j] * gq : o);
        if (y) *(f32x4*)(y + 4 * lane + 256 * j) = o;
    }
    if (rstd_out && lane == 0) *rstd_out = rstd;
}

#ifndef PRO_2X4
#define PRO_2X4 1
#endif
#if PRO_2X4
#define PRO_MAP(r, NB, kb, nb) do { const int g_ = (r) >> 3, w_ = (r) & 7; nb = (g_ % ((NB) / 4)) * 4 + (w_ & 3); kb = (g_ / ((NB) / 4)) * 2 + (w_ >> 2); } while (0)
#else
#define PRO_MAP(r, NB, kb, nb) do { kb = (r) / (NB); nb = (r) % (NB); } while (0)
#endif
__device__ __forceinline__ void p0_prologue(const Args& A, Frame& F) {
    LAS float* scr = (LAS float*)(F.lds + F.wave * 16640);
    const int gw = F.blk * NWAVES + F.wave, NGW = F.G * NWAVES;
    bf16* Wgu = (bf16*)(A.ws + WS_WGU); bf16* Wdn = (bf16*)(A.ws + WS_WDN); bf16* Wevin = (bf16*)(A.ws + WS_WEVIN); bf16* Wevout = (bf16*)(A.ws + WS_WEVOUT);
    bf16* Wodin = (bf16*)(A.ws + WS_WODIN); bf16* Wodout = (bf16*)(A.ws + WS_WODOUT);
    for (int it = gw; it < IT_TOTAL; it += NGW) {
        int r = it;
        if (r < 8 * IT_GU) { const int mat = r / IT_GU; r -= mat * IT_GU; int kb, nb; PRO_MAP(r, 176, kb, nb); const int n0 = nb * 64, pn = n0 >> 8, c = n0 & 255;
            const int srcc = c < 128 ? pn * 128 + c : FF + pn * 128 + (c - 128);
            tr_item(((mat & 1) ? A.in[12] : A.in[8]) + (size_t)(mat >> 1) * D * 2 * FF, 2 * FF, srcc, kb * 64, Wgu + (size_t)mat * (SZ_WGU / 2), D, n0, scr, F.lane, ((mat & 1) ? A.in[11] : A.in[7]) + (size_t)(mat >> 1) * D); continue; }
        r -= 8 * IT_GU;
        if (r < 8 * IT_DN) { const int mat = r / IT_DN; r -= mat * IT_DN; int kb, nb; PRO_MAP(r, 32, kb, nb);
            tr_item(((mat & 1) ? A.in[13] : A.in[9]) + (size_t)(mat >> 1) * FF * D, D, nb * 64, kb * 64, Wdn + (size_t)mat * (SZ_WDN / 2), FF, nb * 64, scr, F.lane); continue; }
        r -= 8 * IT_DN;
        if (r < 2 * IT_EVIN) { const int mat = r / IT_EVIN; r -= mat * IT_EVIN; int kb, nb; PRO_MAP(r, 120, kb, nb);
            tr_item(A.in[14] + (size_t)mat * D * PEV, PEV, nb * 64 < PEV ? nb * 64 : -1, kb * 64, Wevin + (size_t)mat * (SZ_WEVIN / 2), D, nb * 64, scr, F.lane, A.in[10] + (size_t)(2 * mat) * D); continue; }
        r -= 2 * IT_EVIN;
        if (r < 2 * IT_SQ) { const int mat = r / IT_SQ; r -= mat * IT_SQ; int kb, nb; PRO_MAP(r, 32, kb, nb);
            tr_item(A.in[28] + (size_t)mat * D * D, D, nb * 64, kb * 64, Wevout + (size_t)mat * (SZ_WSQ / 2), D, nb * 64, scr, F.lane); continue; }
        r -= 2 * IT_SQ;
        if (r < 2 * IT_ODIN) { const int mat = r / IT_ODIN; r -= mat * IT_ODIN; int kb, nb; PRO_MAP(r, 64, kb, nb);
            tr_item(A.in[29] + (size_t)mat * D * 2 * D, 2 * D, nb * 64, kb * 64, Wodin + (size_t)mat * (SZ_WODIN / 2), D, nb * 64, scr, F.lane, A.in[10] + (size_t)(2 * mat + 1) * D); continue; }
        r -= 2 * IT_ODIN;
        { const int mat = r / IT_SQ; r -= mat * IT_SQ; int kb, nb; PRO_MAP(r, 32, kb, nb);
            tr_item(A.in[37] + (size_t)mat * D * D, D, nb * 64, kb * 64, Wodout + (size_t)mat * (SZ_WSQ / 2), D, nb * 64, scr, F.lane); }
    }
    const int gt = F.blk * NTHR + F.tid, NGT = F.G * NTHR;
    for (int idx = gt; idx < 2 * NLORA * (KLORA / 8); idx += NGT) {
        const int e = idx / (NLORA * (KLORA / 8)); int r = idx - e * (NLORA * (KLORA / 8)); const int n = r % NLORA, k8 = r / NLORA;
        const int ty = n >> 10, nn = n & 1023; float v[8];
#pragma unroll
        for (int i = 0; i < 8; ++i) { const int k = 8 * k8 + i; float x = 0.f;
            if (ty == 0) { if (k < 96) x = A.in[17][((size_t)e * 96 + k) * 1024 + nn]; }
            else if (ty == 1) { if (k >= 96 && k < 192) x = A.in[19][((size_t)e * 96 + (k - 96)) * 1024 + nn]; }
            else { if (k >= 192 && k < 448) x = A.in[20][((size_t)e * 256 + (k - 192)) * 1024 + nn]; }
            v[i] = x; }
        v4u o; o.x = pk2(v[0], v[1]); o.y = pk2(v[2], v[3]); o.z = pk2(v[4], v[5]); o.w = pk2(v[6], v[7]);
        *(v4u*)((bf16*)(A.ws + WS_WLORA) + (size_t)e * NLORA * KLORA + (size_t)n * KLORA + 8 * k8) = o;
    }
    for (int idx = gt; idx < 2 * 4096 * 32; idx += NGT) {
        const int o_ = idx / (4096 * 32); int r = idx - o_ * (4096 * 32); const int rr = r % 4096, k8 = r / 4096;
        const int j = rr >> 8, c = rr & 255, n = j >> 1, cc = (j & 1) * 128 + (c & 127);
        const float* src = (c < 128 ? A.in[32] : A.in[34]) + ((size_t)(o_ * 8 + n) * 256) * 256 + cc; float v[8];
#pragma unroll
        for (int i = 0; i < 8; ++i) v[i] = src[(size_t)(8 * k8 + i) * 256];
        v4u o; o.x = pk2(v[0], v[1]); o.y = pk2(v[2], v[3]); o.z = pk2(v[4], v[5]); o.w = pk2(v[6], v[7]);
        *(v4u*)((bf16*)(A.ws + WS_WLRU) + (size_t)o_ * 4096 * 256 + (size_t)rr * 256 + 8 * k8) = o;
    }
    {
        float* P = (float*)(A.ws + WS_PAR);
#define CPPAR(off, src, n) for (int i_ = gt; i_ < (n); i_ += NGT) P[(off) + i_] = (src)[i_];
        CPPAR(PAR_FFN1N, A.in[7], 8192) CPPAR(PAR_MIXN, A.in[10], 8192) CPPAR(PAR_FFN2N, A.in[11], 8192) CPPAR(PAR_FINN, A.in[38], 2048)
        CPPAR(PAR_MU, A.in[15], 7040) CPPAR(PAR_W0, A.in[16], 2048) CPPAR(PAR_A0, A.in[18], 2048) CPPAR(PAR_KK, A.in[21], 2048) CPPAR(PAR_KA, A.in[22], 2048)
        CPPAR(PAR_RK, A.in[23], 2048) CPPAR(PAR_LNW, A.in[24], 2048) CPPAR(PAR_LNB, A.in[25], 2048) CPPAR(PAR_HGLB, A.in[26], 2048) CPPAR(PAR_HGN, A.in[27], 2048)
        CPPAR(PAR_CONVW, A.in[30], 16384) CPPAR(PAR_CONVB, A.in[31], 4096) CPPAR(PAR_BA, A.in[33], 4096) CPPAR(PAR_BX, A.in[35], 4096) CPPAR(PAR_LAM, A.in[36], 4096)
#undef CPPAR
    }
    bf16* X = (bf16*)(A.ws + WS_X); bf16* XN = (bf16*)(A.ws + WS_XN);
    for (int m = gw; m < M; m += NGW) {
        const float* src = m < MP ? A.in[0] + (size_t)m * D : A.in[1] + (size_t)(m - MP) * D;
        norm_row(src, nullptr, A.in[7], nullptr, nullptr, X + (size_t)m * D, F.lane, 0, 0.f, nullptr, 0, nullptr, (float*)(A.ws + WS_RSTD) + m);
    }
}

__device__ __forceinline__ void norm_phase(const Args& A, Frame& F, const float* gain, bool final_, int sf, float scale) {
    const int gw = F.blk * NWAVES + F.wave, NGW = F.G * NWAVES;
    bf16* X = (bf16*)(A.ws + WS_X); bf16* XN = (bf16*)(A.ws + WS_XN);
    for (int m = gw; m < M; m += NGW)
        norm_row(nullptr, X + (size_t)m * D, gain, final_ ? nullptr : XN + (size_t)m * D, final_ ? AOUT + O_Y + (size_t)m * D : nullptr, nullptr, F.lane, sf, scale, (const float*)(A.ws + WS_SLAB), m, X + (size_t)m * D);
}

__device__ __forceinline__ void rstd_phase(const Args& A, Frame& F, const float* gain, int sf, float scale) {
    bf16* X = (bf16*)(A.ws + WS_X); bf16* XN = (bf16*)(A.ws + WS_XN); float* RSTD = (float*)(A.ws + WS_RSTD); const float* SSP = (const float*)(A.ws + WS_SSP);
    if (sf > 0) {
        LAS float* red = (LAS float*)F.lds; const bf16* slab = (const bf16*)(A.ws + WS_SLAB); const int jj = F.wave, lane = F.lane;
        for (int m0 = MP + F.blk; m0 < M; m0 += 2 * F.G) {
            f32x4 v[2], add[2]; const f32x4 gq = ld4(gain + 256 * jj + 4 * lane);
#pragma unroll
            for (int q = 0; q < 2; ++q) { const int m = m0 + q * F.G; add[q] = (f32x4){0.f, 0.f, 0.f, 0.f}; v[q] = add[q];
                if (m < M) { v[q] = ldp4(X + (size_t)m * D + 256 * jj + 4 * lane);
                    const bf16* sp = slab + (size_t)(((m >> 8) - 32) * 8 + jj) * sf * 65536 + (m & 255) * 256 + 4 * lane;
                    if (sf == 16) {
#pragma unroll
                        for (int p = 0; p < 16; ++p) add[q] += ldp4(sp + (size_t)p * 65536);
                    } else { for (int p = 0; p < sf; ++p) add[q] += ldp4(sp + (size_t)p * 65536); } } }
#pragma unroll
            for (int q = 0; q < 2; ++q) { const int m = m0 + q * F.G;
                if (m < M) { v[q] += add[q] * scale; st4bf(X + (size_t)m * D + 256 * jj + 4 * lane, v[q]); }
                const float s = wave_sum((v[q][0] * v[q][0] + v[q][1] * v[q][1]) + (v[q][2] * v[q][2] + v[q][3] * v[q][3]));
                if (lane == 0) red[q * 8 + jj] = s; }
            __syncthreads();
            if (F.tid < 2) { const int m = m0 + F.tid * F.G; const LAS float* rr = red + F.tid * 8;
                if (m < M) RSTD[m] = 1.0f / sqrtf(((rr[0] + rr[1]) + (rr[2] + rr[3]) + (rr[4] + rr[5]) + (rr[6] + rr[7])) * (1.0f / D) + 1e-6f); }
            __syncthreads();
        }
    }
    const int r1 = sf > 0 ? MP : M;
    for (int m = F.blk * NTHR + F.tid; m < r1; m += F.G * NTHR) { float s = 0.f;
#pragma unroll
        for (int q = 0; q < 8; ++q) { const f32x4 t = ld4(SSP + (size_t)m * 32 + 4 * q); s += (t[0] + t[1]) + (t[2] + t[3]); }
        RSTD[m] = 1.0f / sqrtf(s * (1.0f / D) + 1e-6f); }
}

__device__ __forceinline__ void e2_prep(const Args& A, Frame& F, int e) {
    const bf16* PROJ = (const bf16*)(A.ws + WS_PROJ); bf16* LA = (bf16*)(A.ws + WS_LA);
    const int gt = F.blk * NTHR + F.tid, NGT = F.G * NTHR;
    for (int idx = gt; idx < (M / 8) * 128; idx += NGT) {
        const int c4 = (idx & 127) * 4, m0 = (idx >> 7) * 8;
        if (c4 >= 448) {
#pragma unroll
            for (int r = 0; r < 8; ++r) st4bf(LA + (size_t)(m0 + r) * KLORA + c4, (f32x4){0.f, 0.f, 0.f, 0.f});
            continue; }
        const int col = 3072 + c4; f32x4 x[9];
#pragma unroll
        for (int r = 0; r < 8; ++r) x[r + 1] = ldp4(PROJ + (size_t)(m0 + r) * NEV + col);
        const bool prompt = m0 < MP;
        if (prompt) x[0] = (m0 & (TP - 1)) ? ldp4(PROJ + (size_t)(m0 - 1) * NEV + col) : (f32x4){0.f, 0.f, 0.f, 0.f};
        else x[0] = ld4(A.in[2] + (size_t)(((m0 - MP) >> 2) * 2 + e) * PRW + col);
        f32x4 xs4 = {0.f, 0.f, 0.f, 0.f}; if (!prompt) xs4 = ld4(A.in[2] + (size_t)((((m0 - MP) >> 2) + 1) * 2 + e) * PRW + col);
        const f32x4 mu = ld4(PARP(PAR_MU) + (size_t)e * PRW + col);
#pragma unroll
        for (int r = 0; r < 8; ++r) {
            const f32x4 pv = (!prompt && r == 4) ? xs4 : x[r], p = x[r + 1], z = p + (pv - p) * mu; f32x4 o;
#pragma unroll
            for (int i = 0; i < 4; ++i) o[i] = c4 < 96 ? 2.0f * sigm(2.0f * z[i]) - 1.0f : (c4 < 192 ? z[i] : sigm(z[i]));
            st4bf(LA + (size_t)(m0 + r) * KLORA + c4, o);
        }
    }
    for (int idx = gt; idx < NSEQ * (PRW / 4); idx += NGT) {
        const int q = idx / (PRW / 4), c4 = (idx % (PRW / 4)) * 4;
        const int m = q < BP ? q * TP + TP - 1 : MP + (q - BP) * TS + TS - 1;
        float* o = AOUT + (q < BP ? O_PSHIFT + (size_t)(q * 2 + e) * PRW : O_SSHIFT + (size_t)((q - BP) * 2 + e) * PRW) + c4;
        *(f32x4*)o = ldp4(PROJ + (size_t)m * NEV + c4);
    }
}

struct RwRaw { f32x4 pr, pk, pv, qr, qk, qv, wd, wa; };
__device__ __forceinline__ void rwkv_unit(const Args& A, Frame& F, int e, int q, int h) {
    const int tid = F.tid, hi = tid >> 4, lo = tid & 15;
    const bool prompt = q < BP; const int T = prompt ? TP : TS, row0 = prompt ? q * TP : MP + (q - BP) * TS, bs = q - BP;
    const bf16* PROJ = (const bf16*)(A.ws + WS_PROJ); const float* WAG = (const float*)(A.ws + WS_WAG); bf16* YIN = (bf16*)(A.ws + WS_YIN);
    LAS float* cb = (LAS float*)F.lds; LAS float* ob = cb + 2 * 32 * 384;
    const int hc = h * 64 + 4 * lo;
    const float* mu = PARP(PAR_MU) + (size_t)e * PRW;
    const f32x4 mu_r = ld4(mu + hc), mu_k = ld4(mu + 1024 + hc), mu_v = ld4(mu + 2048 + hc);
    const f32x4 k_k = ld4(PARP(PAR_KK) + e * 1024 + hc), k_a = ld4(PARP(PAR_KA) + e * 1024 + hc);
    const int hs = (tid >> 3) & 31, ls = tid & 7; const bool stepper = tid < 256;
    f32x4 S[2][2];
#pragma unroll
    for (int i = 0; i < 2; ++i)
#pragma unroll
        for (int c = 0; c < 2; ++c) {
            S[i][c] = (f32x4){0.f, 0.f, 0.f, 0.f};
            if (!prompt && stepper) S[i][c] = ld4(A.in[3] + ((size_t)(bs * 2 + e) * 16 + h) * 4096 + (2 * hs + i) * 64 + 8 * ls + 4 * c);
        }
    const int nch = (T + 31) / 32;
    RwRaw raw = {};
#define RW_LOAD_RAW(ci_) do { const int t_ = (ci_) * 32 + hi; \
        if (t_ < T) { const size_t m_ = (size_t)(row0 + t_); \
            raw.pr = ldp4(PROJ + m_ * NEV + hc); raw.pk = ldp4(PROJ + m_ * NEV + 1024 + hc); raw.pv = ldp4(PROJ + m_ * NEV + 2048 + hc); \
            raw.wd = ld4(WAG + m_ * NLORA + hc); raw.wa = ld4(WAG + m_ * NLORA + 1024 + hc); \
            if (t_ > 0) { raw.qr = ldp4(PROJ + (m_ - 1) * NEV + hc); raw.qk = ldp4(PROJ + (m_ - 1) * NEV + 1024 + hc); raw.qv = ldp4(PROJ + (m_ - 1) * NEV + 2048 + hc); } \
            else if (!prompt) { const float* sh_ = A.in[2] + (size_t)(bs * 2 + e) * PRW; raw.qr = ld4(sh_ + hc); raw.qk = ld4(sh_ + 1024 + hc); raw.qv = ld4(sh_ + 2048 + hc); } \
            else { raw.qr = (f32x4){0.f, 0.f, 0.f, 0.f}; raw.qk = raw.qr; raw.qv = raw.qr; } } } while (0)
    RW_LOAD_RAW(0);
    for (int ci = 0; ci < nch; ++ci) {
        const int t0 = ci * 32, t = t0 + hi; const bool valid = t < T;
        LAS float* cbb = cb + (ci & 1) * (32 * 384); LAS float* obb = ob + (ci & 1) * (32 * 64);
        if (valid) {
            const f32x4 zr = raw.pr + (raw.qr - raw.pr) * mu_r, zk = raw.pk + (raw.qk - raw.pk) * mu_k, zv = raw.pv + (raw.qv - raw.pv) * mu_v;
            f32x4 kk = zk * k_k;
            const float ss = red16((kk[0] * kk[0] + kk[1] * kk[1]) + (kk[2] * kk[2] + kk[3] * kk[3]));
            kk = kk * (1.0f / fmaxf(sqrtf(ss), 1e-12f));
            const f32x4 kp = zk * (1.0f + (raw.wa - 1.0f) * k_a), bb = kk * raw.wa;
            LAS float* p = cbb + hi * 384 + 4 * lo;
            *(LAS f32x4*)(p) = zr; *(LAS f32x4*)(p + 64) = raw.wd; *(LAS f32x4*)(p + 128) = kp; *(LAS f32x4*)(p + 192) = kk; *(LAS f32x4*)(p + 256) = bb; *(LAS f32x4*)(p + 320) = zv;
        }
        __syncthreads();
        if (ci + 1 < nch) RW_LOAD_RAW(ci + 1);
        const int ns = (T - t0) < 32 ? (T - t0) : 32;
        if (stepper) {
            f32x4 r4[2], w4[2], kp4[2], kk4[2], bb4[2]; f32x2 v2;
#define RW_LD(s_) do { const LAS float* p_ = cbb + (s_) * 384 + 8 * ls; \
            r4[0] = *(const LAS f32x4*)(p_); r4[1] = *(const LAS f32x4*)(p_ + 4); w4[0] = *(const LAS f32x4*)(p_ + 64); w4[1] = *(const LAS f32x4*)(p_ + 68); \
            kp4[0] = *(const LAS f32x4*)(p_ + 128); kp4[1] = *(const LAS f32x4*)(p_ + 132); kk4[0] = *(const LAS f32x4*)(p_ + 192); kk4[1] = *(const LAS f32x4*)(p_ + 196); \
            bb4[0] = *(const LAS f32x4*)(p_ + 256); bb4[1] = *(const LAS f32x4*)(p_ + 260); v2 = *(const LAS f32x2*)(cbb + (s_) * 384 + 320 + 2 * hs); } while (0)
            RW_LD(0);
            for (int s = 0; s < ns; ++s) {
                const f32x4 cr0 = r4[0], cr1 = r4[1], cw0 = w4[0], cw1 = w4[1], ck0 = kp4[0], ck1 = kp4[1], cq0 = kk4[0], cq1 = kk4[1], cb0 = bb4[0], cb1 = bb4[1]; const f32x2 cv = v2;
                if (s + 1 < ns) RW_LD(s + 1);
                float sa[2], o[2];
#pragma unroll
                for (int i = 0; i < 2; ++i) { const f32x4 t = S[i][0] * cq0 + S[i][1] * cq1; sa[i] = -red8((t[0] + t[1]) + (t[2] + t[3])); }
#pragma unroll
                for (int i = 0; i < 2; ++i) { S[i][0] = S[i][0] * cw0 + cb0 * sa[i] + ck0 * cv[i]; S[i][1] = S[i][1] * cw1 + cb1 * sa[i] + ck1 * cv[i]; }
#pragma unroll
                for (int i = 0; i < 2; ++i) { const f32x4 t = S[i][0] * cr0 + S[i][1] * cr1; o[i] = red8((t[0] + t[1]) + (t[2] + t[3])); }
                if (ls == 0) *(LAS f32x2*)(obb + s * 64 + 2 * hs) = (f32x2){o[0], o[1]};
            }
#undef RW_LD
        }
        __syncthreads();
        if (valid) {
            const size_t m = (size_t)(row0 + t);
            const f32x4 o4 = *(const LAS f32x4*)(obb + hi * 64 + 4 * lo);
            const float mean = red16((o4[0] + o4[1]) + (o4[2] + o4[3])) * (1.0f / 64.0f);
            const f32x4 d = o4 - mean;
            const float var = red16((d[0] * d[0] + d[1] * d[1]) + (d[2] * d[2] + d[3] * d[3])) * (1.0f / 64.0f);
            const float rs = 1.0f / sqrtf(var + 64e-5f);
            const LAS float* p = cbb + hi * 384 + 4 * lo;
            const f32x4 r4 = *(const LAS f32x4*)(p), kp4 = *(const LAS f32x4*)(p + 128), v4 = *(const LAS f32x4*)(p + 320);
            const f32x4 rk = ld4(PARP(PAR_RK) + e * 1024 + hc);
            const float bonus = red16((r4[0] * kp4[0] * rk[0] + r4[1] * kp4[1] * rk[1]) + (r4[2] * kp4[2] * rk[2] + r4[3] * kp4[3] * rk[3]));
            const f32x4 on = d * rs * ld4(PARP(PAR_LNW) + e * 1024 + hc) + ld4(PARP(PAR_LNB) + e * 1024 + hc) + v4 * bonus;
            st4bf(YIN + m * D + hc, on * ld4(WAG + m * NLORA + 2048 + hc));
        }
    }
    float* so = AOUT + (prompt ? O_PRWKV + ((size_t)(q * 2 + e) * 16 + h) * 4096 : O_SRWKV + ((size_t)(bs * 2 + e) * 16 + h) * 4096);
    if (stepper) {
#pragma unroll
        for (int i = 0; i < 2; ++i)
#pragma unroll
            for (int c = 0; c < 2; ++c) *(f32x4*)(so + (2 * hs + i) * 64 + 8 * ls + 4 * c) = S[i][c];
    }
    __syncthreads();
}

__device__ __forceinline__ float hg_lb(const Args& A, int e, int ch) {
    if (e == 0) return 0.f;
    const float l0 = PARP(PAR_HGLB)[ch], l1 = PARP(PAR_HGLB)[1024 + ch]; return sigm(l1 - l0);
}
constexpr int HG_S = 130, HG_VS = 132;
typedef short hbf16x8 __attribute__((ext_vector_type(8)));
__device__ __forceinline__ hbf16x8 pack8_strided(const LAS float* p, int st) {
    v4u o; o.x = cvt_pk_bf16(p[0], p[st]); o.y = cvt_pk_bf16(p[2 * st], p[3 * st]); o.z = cvt_pk_bf16(p[4 * st], p[5 * st]); o.w = cvt_pk_bf16(p[6 * st], p[7 * st]); return __builtin_bit_cast(hbf16x8, o); }
__device__ __forceinline__ void hgrn_chunk_unit(const Args& A, Frame& F, int e, int b, int h, int c) {
    const int tid = F.tid, lane = F.lane, w = F.wave, g = lane >> 4, i = lane & 15;
    const bf16* PROJ = (const bf16*)(A.ws + WS_PROJ);
    float* OI = (float*)(A.ws + WS_OI); float* QT = (float*)(A.ws + WS_QT); float* HU = (float*)(A.ws + WS_HU); float* HD = (float*)(A.ws + WS_HD);
    LAS float* Qs = (LAS float*)F.lds; LAS float* Ks = Qs + 64 * HG_S; LAS float* Vs = Ks + 64 * HG_S; LAS float* Gs = Vs + 64 * HG_VS; LAS float* As = Gs;
    LAS float* GB = Gs + 64 * HG_S; LAS float* EJ = GB + 5 * 128;
    const int m0 = b * TP + c * 64, unit = (b * 8 + h) * 32 + c;
    f32x4 lbv;
#pragma unroll
    for (int j = 0; j < 4; ++j) lbv[j] = hg_lb(A, e, h * 128 + (tid & 31) * 4 + j);
    f32x4 qv4[4], fv4[4], iv4[4];
#pragma unroll
    for (int it = 0; it < 4; ++it) { const int idx = tid + 512 * it, row = idx >> 5, c4 = (idx & 31) * 4;
        const bf16* pr = PROJ + (size_t)(m0 + row) * NEV + PRW + h * 128 + c4; qv4[it] = ldp4(pr); fv4[it] = ldp4(pr + 1024); iv4[it] = ldp4(pr + 2048); }
#pragma unroll
    for (int it = 0; it < 4; ++it) {
        const int idx = tid + 512 * it, row = idx >> 5, c4 = (idx & 31) * 4;
        const f32x4 qv = qv4[it], fv = fv4[it], iv = iv4[it];
#pragma unroll
        for (int j = 0; j < 4; ++j) {
            const float lb = lbv[j], sg = fmaxf(sigm(fv[j]), 1e-37f);
            Qs[row * HG_S + c4 + j] = silu_(qv[j]);
            Gs[row * HG_S + c4 + j] = __logf(lb + (1.0f - lb) * sg);
            Ks[row * HG_S + c4 + j] = (1.0f - lb) * (1.0f - sg);
        }
        *(LAS f32x4*)(Vs + row * HG_VS + c4) = iv;
    }
    __syncthreads();
    LAS float* TQ = EJ + 512;
    { const int k = tid & 127, I = tid >> 7; float run = 0.f;
#pragma unroll
        for (int t = 0; t < 16; ++t) { run += Gs[(16 * I + t) * HG_S + k]; Gs[(16 * I + t) * HG_S + k] = run; }
        TQ[tid] = run; }
    __syncthreads();
    { const int J = tid >> 7, k = tid & 127; const float t0 = TQ[k], t1 = TQ[128 + k], t2 = TQ[256 + k], t3 = TQ[384 + k];
      const float gbJ = J == 0 ? 0.f : (J == 1 ? t0 : (J == 2 ? t0 + t1 : (t0 + t1) + t2)), gl = ((t0 + t1) + t2) + t3;
      GB[J * 128 + k] = gbJ; if (J == 3) GB[4 * 128 + k] = gl; EJ[tid] = __expf(gl - gbJ); if (J == 0) HD[unit * 128 + k] = __expf(gl); }
#pragma unroll
    for (int it = 0; it < 4; ++it) {
        const int idx = tid + 512 * it, row = idx >> 5, c4 = (idx & 31) * 4, I = row >> 4; f32x4 o;
#pragma unroll
        for (int j = 0; j < 4; ++j) { const int kc = c4 + j; const float q = Qs[row * HG_S + kc], G = Gs[row * HG_S + kc];
            const float gb = I == 0 ? 0.f : (I == 1 ? TQ[kc] : (I == 2 ? TQ[kc] + TQ[128 + kc] : (TQ[kc] + TQ[128 + kc]) + TQ[256 + kc]));
            o[j] = q * __expf(G + gb); Qs[row * HG_S + kc] = q * __expf(G); Ks[row * HG_S + kc] *= __expf(fminf(-G, 80.0f)); }
        *(f32x4*)(QT + (size_t)(m0 + row) * 1024 + h * 128 + c4) = o;
    }
    __syncthreads();
    for (int pi = w; pi < 10; pi += 8) {
        const int I = pi < 1 ? 0 : (pi < 3 ? 1 : (pi < 6 ? 2 : 3)), J = pi - (I * (I + 1)) / 2;
        f32x4 acc = {0.f, 0.f, 0.f, 0.f};
#pragma unroll 8
        for (int s = 0; s < 32; ++s) { const int k = 4 * s + g;
            float av = Qs[(16 * I + i) * HG_S + k]; if (I != J) av *= __expf(GB[I * 128 + k] - GB[J * 128 + k]);
            acc = __builtin_amdgcn_mfma_f32_16x16x4f32(av, Ks[(16 * J + i) * HG_S + k], acc, 0, 0, 0); }
#pragma unroll
        for (int r = 0; r < 4; ++r) As[(16 * I + 4 * g + r) * 66 + 16 * J + i] = (I != J || i <= 4 * g + r) ? acc[r] : 0.f;
    }
    __syncthreads();
    {
        hbf16x8 vB[2];
#pragma unroll
        for (int ks = 0; ks < 2; ++ks) vB[ks] = pack8_strided(Vs + (32 * ks + 8 * g) * HG_VS + 16 * w + i, HG_VS);
#pragma unroll
        for (int I = 0; I < 4; ++I) {
            f32x4 acc = {0.f, 0.f, 0.f, 0.f};
#pragma unroll
            for (int ks = 0; ks < 2; ++ks) if (32 * ks < 16 * (I + 1)) {
                hbf16x8 aA = pack8_strided(As + (16 * I + i) * 66 + 32 * ks + 8 * g, 1);
                if (32 * ks + 8 * g >= 16 * (I + 1)) aA = (hbf16x8){0, 0, 0, 0, 0, 0, 0, 0};
                acc = __builtin_amdgcn_mfma_f32_16x16x32_bf16(aA, vB[ks], acc, 0, 0, 0); }
#pragma unroll
            for (int r = 0; r < 4; ++r) OI[(size_t)(m0 + 16 * I + 4 * g + r) * 1024 + h * 128 + 16 * w + i] = acc[r];
        }
        hbf16x8 kA[2];
#pragma unroll
        for (int ks = 0; ks < 2; ++ks) { const LAS float* p = Ks + (32 * ks + 8 * g) * HG_S + 16 * w + i; const int J = (32 * ks + 8 * g) >> 4; const float ej = EJ[J * 128 + 16 * w + i];
            v4u o; o.x = cvt_pk_bf16(p[0] * ej, p[HG_S] * ej); o.y = cvt_pk_bf16(p[2 * HG_S] * ej, p[3 * HG_S] * ej); o.z = cvt_pk_bf16(p[4 * HG_S] * ej, p[5 * HG_S] * ej); o.w = cvt_pk_bf16(p[6 * HG_S] * ej, p[7 * HG_S] * ej);
            kA[ks] = __builtin_bit_cast(hbf16x8, o); }
#pragma unroll 2
        for (int vb = 0; vb < 8; ++vb) {
            f32x4 acc = {0.f, 0.f, 0.f, 0.f};
#pragma unroll
            for (int ks = 0; ks < 2; ++ks) acc = __builtin_amdgcn_mfma_f32_16x16x32_bf16(kA[ks], pack8_strided(Vs + (32 * ks + 8 * g) * HG_VS + 16 * vb + i, HG_VS), acc, 0, 0, 0);
#pragma unroll
            for (int r = 0; r < 4; ++r) HU[(size_t)unit * 16384 + (16 * w + 4 * g + r) * 128 + 16 * vb + i] = acc[r];
        }
    }
    __syncthreads();
}
constexpr int HC_S = 132, HC_T = 72;
#define HC_SW(rc_, t_) ((rc_) * HC_T + ((((t_) >> 3) ^ (((rc_) >> 2) & 7)) << 3) + ((t_) & 7))
__device__ __forceinline__ hbf16x8 pk8f(const f32x4& a, const f32x4& b) { v4u o; o.x = cvt_pk_bf16(a[0], a[1]); o.y = cvt_pk_bf16(a[2], a[3]); o.z = cvt_pk_bf16(b[0], b[1]); o.w = cvt_pk_bf16(b[2], b[3]); return __builtin_bit_cast(hbf16x8, o); }
__device__ __forceinline__ void hgrn_chunk_unit2(const Args& A, Frame& F, int e, int b, int h, int c) {
    const int tid = F.tid, lane = F.lane, w = F.wave, g = lane >> 4, i = lane & 15;
    const bf16* PROJ = (const bf16*)(A.ws + WS_PROJ);
    float* OI = (float*)(A.ws + WS_OI); float* QT = (float*)(A.ws + WS_QT); float* HU = (float*)(A.ws + WS_HU); float* HD = (float*)(A.ws + WS_HD);
    LAS float* Qs = (LAS float*)F.lds; LAS float* Ks = Qs + 64 * HC_S; LAS float* Gs = Ks + 64 * HC_S;
    LAS unsigned short* AsB = (LAS unsigned short*)Gs;
    LAS unsigned short* VT = (LAS unsigned short*)(Gs + 64 * HC_S);
    LAS unsigned short* KT = VT + 128 * HC_T;
    LAS float* GB = (LAS float*)(KT + 128 * HC_T); LAS float* TQ = GB + 5 * 128;
    const int m0 = b * TP + c * 64, unit = (b * 8 + h) * 32 + c;
    f32x4 lbv;
#pragma unroll
    for (int j = 0; j < 4; ++j) lbv[j] = hg_lb(A, e, h * 128 + (tid & 31) * 4 + j);
    v2u qr4[4], fr4[4], ir4[4];
#pragma unroll
    for (int it = 0; it < 4; ++it) { const int idx = tid + 512 * it, row = idx >> 5, c4 = (idx & 31) * 4;
        const bf16* pr = PROJ + (size_t)(m0 + row) * NEV + PRW + h * 128 + c4; qr4[it] = *(const v2u*)pr; fr4[it] = *(const v2u*)(pr + 1024); ir4[it] = *(const v2u*)(pr + 2048); }
#pragma unroll
    for (int it = 0; it < 4; ++it) {
        const int idx = tid + 512 * it, row = idx >> 5, c4 = (idx & 31) * 4;
        const f32x4 qv = {bf2f(qr4[it].x & 0xffffu), bf2f(qr4[it].x >> 16), bf2f(qr4[it].y & 0xffffu), bf2f(qr4[it].y >> 16)};
        const f32x4 fv = {bf2f(fr4[it].x & 0xffffu), bf2f(fr4[it].x >> 16), bf2f(fr4[it].y & 0xffffu), bf2f(fr4[it].y >> 16)};
        f32x4 Q4, G4, K4;
#pragma unroll
        for (int j = 0; j < 4; ++j) { const float lb = lbv[j], sg = fmaxf(sigm(fv[j]), 1e-37f);
            Q4[j] = silu_(qv[j]); G4[j] = __logf(lb + (1.0f - lb) * sg); K4[j] = (1.0f - lb) * (1.0f - sg); }
        *(LAS f32x4*)(Qs + row * HC_S + c4) = Q4; *(LAS f32x4*)(Gs + row * HC_S + c4) = G4; *(LAS f32x4*)(Ks + row * HC_S + c4) = K4;
        VT[HC_SW(c4 + 0, row)] = (unsigned short)(ir4[it].x & 0xffffu); VT[HC_SW(c4 + 1, row)] = (unsigned short)(ir4[it].x >> 16);
        VT[HC_SW(c4 + 2, row)] = (unsigned short)(ir4[it].y & 0xffffu); VT[HC_SW(c4 + 3, row)] = (unsigned short)(ir4[it].y >> 16);
    }
    __syncthreads();
    { const int k = tid & 127, I = tid >> 7; float run = 0.f;
#pragma unroll
        for (int t = 0; t < 16; ++t) { run += Gs[(16 * I + t) * HC_S + k]; Gs[(16 * I + t) * HC_S + k] = run; }
        TQ[tid] = run; }
    __syncthreads();
    { const int J = tid >> 7, k = tid & 127; const float t0 = TQ[k], t1 = TQ[128 + k], t2 = TQ[256 + k], t3 = TQ[384 + k];
      const float gbJ = J == 0 ? 0.f : (J == 1 ? t0 : (J == 2 ? t0 + t1 : (t0 + t1) + t2)), gl = ((t0 + t1) + t2) + t3;
      GB[J * 128 + k] = gbJ; if (J == 3) GB[4 * 128 + k] = gl; if (J == 0) HD[unit * 128 + k] = __expf(gl); }
#pragma unroll
    for (int it = 0; it < 4; ++it) {
        const int idx = tid + 512 * it, row = idx >> 5, c4 = (idx & 31) * 4, I = row >> 4;
        const f32x4 q4 = *(const LAS f32x4*)(Qs + row * HC_S + c4), G4 = *(const LAS f32x4*)(Gs + row * HC_S + c4), K4 = *(const LAS f32x4*)(Ks + row * HC_S + c4);
        const f32x4 t0 = *(const LAS f32x4*)(TQ + c4), t1 = *(const LAS f32x4*)(TQ + 128 + c4), t2 = *(const LAS f32x4*)(TQ + 256 + c4), t3 = *(const LAS f32x4*)(TQ + 384 + c4);
        const f32x4 z4 = {0.f, 0.f, 0.f, 0.f};
        const f32x4 gb = I == 0 ? z4 : (I == 1 ? t0 : (I == 2 ? t0 + t1 : (t0 + t1) + t2)), gl = ((t0 + t1) + t2) + t3;
        f32x4 o, Qn, Kn, ke;
#pragma unroll
        for (int j = 0; j < 4; ++j) { o[j] = q4[j] * __expf(G4[j] + gb[j]); Qn[j] = q4[j] * __expf(G4[j]); Kn[j] = K4[j] * __expf(fminf(-G4[j], 80.0f)); ke[j] = Kn[j] * __expf(gl[j] - gb[j]); }
        st4bf((bf16*)QT + (size_t)(m0 + row) * 1024 + h * 128 + c4, o);
        *(LAS f32x4*)(Qs + row * HC_S + c4) = Qn; *(LAS f32x4*)(Ks + row * HC_S + c4) = Kn;
        const unsigned k01 = cvt_pk_bf16(ke[0], ke[1]), k23 = cvt_pk_bf16(ke[2], ke[3]);
        KT[HC_SW(c4 + 0, row)] = (unsigned short)(k01 & 0xffffu); KT[HC_SW(c4 + 1, row)] = (unsigned short)(k01 >> 16);
        KT[HC_SW(c4 + 2, row)] = (unsigned short)(k23 & 0xffffu); KT[HC_SW(c4 + 3, row)] = (unsigned short)(k23 >> 16);
    }
    __syncthreads();
    for (int pi = w; pi < 10; pi += 8) {
        const int I = pi < 1 ? 0 : (pi < 3 ? 1 : (pi < 6 ? 2 : 3)), J = pi - (I * (I + 1)) / 2;
        f32x4 acc = {0.f, 0.f, 0.f, 0.f};
#pragma unroll
        for (int ks = 0; ks < 4; ++ks) { const int kb = 32 * ks + 8 * g;
            f32x4 a0 = *(const LAS f32x4*)(Qs + (16 * I + i) * HC_S + kb), a1 = *(const LAS f32x4*)(Qs + (16 * I + i) * HC_S + kb + 4);
            if (I != J) { const f32x4 d0 = *(const LAS f32x4*)(GB + I * 128 + kb) - *(const LAS f32x4*)(GB + J * 128 + kb), d1 = *(const LAS f32x4*)(GB + I * 128 + kb + 4) - *(const LAS f32x4*)(GB + J * 128 + kb + 4);
#pragma unroll
                for (int j = 0; j < 4; ++j) { a0[j] *= __expf(d0[j]); a1[j] *= __expf(d1[j]); } }
            const f32x4 b0 = *(const LAS f32x4*)(Ks + (16 * J + i) * HC_S + kb), b1 = *(const LAS f32x4*)(Ks + (16 * J + i) * HC_S + kb + 4);
            acc = __builtin_amdgcn_mfma_f32_16x16x32_bf16(pk8f(a0, a1), pk8f(b0, b1), acc, 0, 0, 0); }
#pragma unroll
        for (int r = 0; r < 4; ++r) { const int t = 4 * g + r; const float v = (I != J || i <= t) ? acc[r] : 0.f;
            AsB[(16 * I + t) * HC_T + 16 * J + i] = (unsigned short)(cvt_pk_bf16(v, 0.f) & 0xffffu); }
    }
    __syncthreads();
    {
        hbf16x8 vB[2];
#pragma unroll
        for (int ks = 0; ks < 2; ++ks) vB[ks] = *(const LAS hbf16x8*)(VT + HC_SW(16 * w + i, 32 * ks + 8 * g));
#pragma unroll
        for (int I = 0; I < 4; ++I) {
            f32x4 acc = {0.f, 0.f, 0.f, 0.f};
#pragma unroll
            for (int ks = 0; ks < 2; ++ks) if (32 * ks < 16 * (I + 1)) {
                hbf16x8 aA = *(const LAS hbf16x8*)(AsB + (16 * I + i) * HC_T + 32 * ks + 8 * g);
                if (32 * ks + 8 * g >= 16 * (I + 1)) aA = (hbf16x8){0, 0, 0, 0, 0, 0, 0, 0};
                acc = __builtin_amdgcn_mfma_f32_16x16x32_bf16(vB[ks], aA, acc, 0, 0, 0); }
            st4bf((bf16*)OI + (size_t)(m0 + 16 * I + i) * 1024 + h * 128 + 16 * w + 4 * g, acc);
        }
        hbf16x8 kA[2];
#pragma unroll
        for (int ks = 0; ks < 2; ++ks) kA[ks] = *(const LAS hbf16x8*)(KT + HC_SW(16 * w + i, 32 * ks + 8 * g));
#pragma unroll
        for (int vb = 0; vb < 8; ++vb) {
            f32x4 acc = {0.f, 0.f, 0.f, 0.f};
#pragma unroll
            for (int ks = 0; ks < 2; ++ks) acc = __builtin_amdgcn_mfma_f32_16x16x32_bf16(*(const LAS hbf16x8*)(VT + HC_SW(16 * vb + i, 32 * ks + 8 * g)), kA[ks], acc, 0, 0, 0);
            st4bf((bf16*)HU + (size_t)unit * 16384 + (16 * w + i) * 128 + 16 * vb + 4 * g, acc);
        }
    }
    __syncthreads();
}
__device__ __forceinline__ void hgrn_sample_unit(const Args& A, Frame& F, int e, int bs, int h) {
    const int tid = F.tid;
    const bf16* PROJ = (const bf16*)(A.ws + WS_PROJ); bf16* YIN = (bf16*)(A.ws + WS_YIN);
    LAS float* sq = (LAS float*)F.lds; LAS float* sf = sq + 512; LAS float* sk = sf + 512; LAS float* po = sk + 512; LAS float* pn = po + 2048;
    const int mrow = MP + bs * TS;
    { const int t = tid >> 7, k = tid & 127; const bf16* pr = PROJ + (size_t)(mrow + t) * NEV + PRW + h * 128 + k;
      const float qv = bf2f(pr[0]), fv = bf2f(pr[1024]), lb = hg_lb(A, e, h * 128 + k);
      sq[tid] = silu_(qv); sf[tid] = lb + (1.0f - lb) * sigm(fv); sk[tid] = (1.0f - lb) * sigm(-fv); }
    const int v = tid & 127, kq = tid >> 7;
    const size_t sbase = (((size_t)(bs * 2 + e) * 8 + h) * 128) * 128;
    float S[32];
#pragma unroll
    for (int j = 0; j < 32; ++j) S[j] = A.in[4][sbase + (size_t)(32 * kq + j) * 128 + v];
    float vt[4];
#pragma unroll
    for (int t = 0; t < 4; ++t) vt[t] = bf2f(PROJ[(size_t)(mrow + t) * NEV + PRW + 2048 + h * 128 + v]);
    __syncthreads();
#pragma unroll
    for (int t = 0; t < 4; ++t) { float o = 0.f;
#pragma unroll
        for (int j = 0; j < 32; ++j) { const int k = t * 128 + 32 * kq + j; S[j] = sf[k] * S[j] + sk[k] * vt[t]; o += S[j] * sq[k]; }
        po[(t * 4 + kq) * 128 + v] = o; }
    __syncthreads();
    { const int t = tid >> 7; const float o = (po[(t * 4 + 0) * 128 + v] + po[(t * 4 + 1) * 128 + v]) + (po[(t * 4 + 2) * 128 + v] + po[(t * 4 + 3) * 128 + v]);
      const float ss = wave_sum(o * o); if (F.lane == 0) pn[F.wave] = ss;
      __syncthreads();
      const float tot = pn[(F.wave & ~1)] + pn[(F.wave | 1)];
      const size_t m = (size_t)(mrow + t);
      const float og = bf2f(PROJ[m * NEV + PRW + 3072 + h * 128 + v]);
      const float y = o * (1.0f / sqrtf(tot * (1.0f / 128.0f) + 1e-5f)) * PARP(PAR_HGN)[e * 1024 + h * 128 + v] * silu_(og);
      YIN[m * D + 1024 + h * 128 + v] = (bf16)f2bf(y); }
    float* so = AOUT + O_SHGRN + sbase;
#pragma unroll
    for (int j = 0; j < 32; ++j) so[(size_t)(32 * kq + j) * 128 + v] = S[j];
    __syncthreads();
}
__device__ __forceinline__ void hgrn_state_scan(const Args& A, Frame& F, int e) {
    float* HU = (float*)(A.ws + WS_HU); const float* HD = (const float*)(A.ws + WS_HD);
    const int gt = F.blk * NTHR + F.tid, NGT = F.G * NTHR;
    for (int idx = gt; idx < BP * 8 * 128 * 32; idx += NGT) {
        const int v4 = (idx & 31) * 4, k = (idx >> 5) & 127, bh = idx >> 12;
        f32x4 S = {0.f, 0.f, 0.f, 0.f};
#pragma unroll 1
        for (int c0 = 0; c0 < 32; c0 += 8) {
            f32x4 u[8]; float dcy[8];
#pragma unroll
            for (int q = 0; q < 8; ++q) { const int unit = bh * 32 + c0 + q; u[q] = ldp4((const bf16*)HU + (size_t)unit * 16384 + k * 128 + v4); dcy[q] = HD[unit * 128 + k]; }
#pragma unroll
            for (int q = 0; q < 8; ++q) { const int unit = bh * 32 + c0 + q; st4bf((bf16*)HU + (size_t)unit * 16384 + k * 128 + v4, S); S = S * dcy[q] + u[q]; }
        }
        const int b = bh >> 3, h = bh & 7;
        *(f32x4*)(AOUT + O_PHGRN + (((size_t)(b * 2 + e) * 8 + h) * 128 + k) * 128 + v4) = S;
    }
}
struct HfRaw { v2u qt[4], hu[8]; };
__device__ __forceinline__ void hgrn_finish_load(const Args& A, Frame& F, int b, int h, int c, HfRaw& r) {
    const float* QT = (const float*)(A.ws + WS_QT); const float* HU = (const float*)(A.ws + WS_HU);
    const int tid = F.tid, m0 = b * TP + c * 64, unit = (b * 8 + h) * 32 + c;
#pragma unroll
    for (int it = 0; it < 4; ++it) { const int idx = tid + 512 * it, row = idx >> 5, c4 = (idx & 31) * 4; r.qt[it] = *(const v2u*)((const bf16*)QT + (size_t)(m0 + row) * 1024 + h * 128 + c4); }
#pragma unroll
    for (int it = 0; it < 8; ++it) { const int idx = tid + 512 * it, row = idx >> 5, c4 = (idx & 31) * 4; r.hu[it] = *(const v2u*)((const bf16*)HU + (size_t)unit * 16384 + row * 128 + c4); }
}
__device__ __forceinline__ void hgrn_finish_unit(const Args& A, Frame& F, int e, int b, int h, int c, const HfRaw& raw, bool has_next, int nb, int nh, int nc, HfRaw& nraw) {
    const int tid = F.tid, lane = F.lane, w = F.wave, g = lane >> 4, i = lane & 15;
    const bf16* PROJ = (const bf16*)(A.ws + WS_PROJ); const float* OI = (const float*)(A.ws + WS_OI); bf16* YIN = (bf16*)(A.ws + WS_YIN);
    LAS float* Qt = (LAS float*)F.lds; LAS float* Ss = Qt + 64 * HG_S; LAS float* Os = Ss + 128 * HG_VS;
    LAS unsigned short* QtB = (LAS unsigned short*)Qt;
    const int m0 = b * TP + c * 64;
#pragma unroll
    for (int it = 0; it < 4; ++it) { const int idx = tid + 512 * it, row = idx >> 5, c4 = (idx & 31) * 4; *(LAS v2u*)(QtB + row * 136 + c4) = raw.qt[it]; }
#pragma unroll
    for (int it = 0; it < 8; ++it) { const int idx = tid + 512 * it, row = idx >> 5, c4 = (idx & 31) * 4; *(LAS f32x4*)(Ss + row * HG_VS + c4) = cvq(raw.hu[it]); }
    __syncthreads();
    v2u oi[4];
#pragma unroll
    for (int tb = 0; tb < 4; ++tb) oi[tb] = *(const v2u*)((const bf16*)OI + (size_t)(m0 + 16 * tb + i) * 1024 + h * 128 + 16 * w + 4 * g);
    const int t = tid >> 3, vg = tid & 7; const size_t m = (size_t)(m0 + t);
    f32x4 og[4], gn[4];
#pragma unroll
    for (int jj = 0; jj < 4; ++jj) { const int ch = h * 128 + 4 * vg + 32 * jj; og[jj] = ldp4(PROJ + m * NEV + PRW + 3072 + ch); gn[jj] = ld4(PARP(PAR_HGN) + e * 1024 + ch); }
    if (has_next) hgrn_finish_load(A, F, nb, nh, nc, nraw);
    {
        hbf16x8 sB[4];
#pragma unroll
        for (int ks = 0; ks < 4; ++ks) sB[ks] = pack8_strided(Ss + (32 * ks + 8 * g) * HG_VS + 16 * w + i, HG_VS);
#pragma unroll
        for (int tb = 0; tb < 4; ++tb) {
            f32x4 acc = cvq(oi[tb]);
#pragma unroll
            for (int ks = 0; ks < 4; ++ks) acc = __builtin_amdgcn_mfma_f32_16x16x32_bf16(sB[ks], *(const LAS hbf16x8*)(QtB + (16 * tb + i) * 136 + 32 * ks + 8 * g), acc, 0, 0, 0);
            *(LAS f32x4*)(Os + (16 * tb + i) * HG_VS + 16 * w + 4 * g) = acc;
        }
    }
    __syncthreads();
    f32x4 acc[4]; float ss = 0.f;
#pragma unroll
    for (int jj = 0; jj < 4; ++jj) {
#pragma unroll
        for (int q = 0; q < 4; ++q) acc[jj][q] = Os[t * HG_VS + 4 * vg + 32 * jj + q];
        ss += (acc[jj][0] * acc[jj][0] + acc[jj][1] * acc[jj][1]) + (acc[jj][2] * acc[jj][2] + acc[jj][3] * acc[jj][3]); }
    const float rs = 1.0f / sqrtf(red8(ss) * (1.0f / 128.0f) + 1e-5f);
#pragma unroll
    for (int jj = 0; jj < 4; ++jj) { const int ch = h * 128 + 4 * vg + 32 * jj; f32x4 y;
#pragma unroll
        for (int q = 0; q < 4; ++q) y[q] = acc[jj][q] * rs * gn[jj][q] * silu_(og[jj][q]);
        st4bf(YIN + m * D + 1024 + ch, y); }
    __syncthreads();
}

__device__ __forceinline__ f32x4 oddin_sample4(const Args& A, int m, int col) {
    const bf16* sl = (const bf16*)(A.ws + WS_OSLAB) + (size_t)((((m - MP) >> 8) * 16 + (col >> 8)) * 8) * 65536 + ((m - MP) & 255) * 256 + (col & 255);
    f32x4 s = {0.f, 0.f, 0.f, 0.f};
#pragma unroll
    for (int p = 0; p < 8; ++p) s += ldp4(sl + (size_t)p * 65536);
    return s * ((const float*)(A.ws + WS_RSTD))[m];
}
__device__ __forceinline__ void o2_conv(const Args& A, Frame& F, int o_) {
    const bf16* XB = (const bf16*)(A.ws + WS_XB); bf16* XCB = (bf16*)(A.ws + WS_XCB); const bool split = F.G == 256;
    const int gt = F.blk * NTHR + F.tid, NGT = F.G * NTHR;
    if (split) for (int idx = gt; idx < (MP / 32) * 512; idx += NGT) {
        const int ch = (idx & 511) * 4, m0 = (idx >> 9) * 32, t0 = m0 & (TP - 1);
        const f32x4 cb = ld4(PARP(PAR_CONVB) + o_ * 2048 + ch); f32x4 cw[4];
#pragma unroll
        for (int j = 0; j < 4; ++j) cw[j] = ld4(PARP(PAR_CONVW) + (size_t)(o_ * 4 + j) * 2048 + ch);
        f32x4 w0 = {0.f, 0.f, 0.f, 0.f}, w1 = w0, w2 = w0;
        if (t0 > 0) { w0 = ldp4(XB + (size_t)(m0 - 3) * 2048 + ch); w1 = ldp4(XB + (size_t)(m0 - 2) * 2048 + ch); w2 = ldp4(XB + (size_t)(m0 - 1) * 2048 + ch); }
#pragma unroll
        for (int r0 = 0; r0 < 32; r0 += 16) {
            f32x4 x[16];
#pragma unroll
            for (int q = 0; q < 16; ++q) x[q] = ldp4(XB + (size_t)(m0 + r0 + q) * 2048 + ch);
#pragma unroll
            for (int q = 0; q < 16; ++q) { st4bf(XCB + (size_t)(m0 + r0 + q) * 2048 + ch, cb + w0 * cw[0] + w1 * cw[1] + w2 * cw[2] + x[q] * cw[3]); w0 = w1; w1 = w2; w2 = x[q]; }
        }
    }
    else for (int idx = gt; idx < M * 512; idx += NGT) {
        const int ch = (idx & 511) * 4, m = idx >> 9;
        int t, bs; if (m < MP) { t = m & (TP - 1); bs = -1; } else { t = (m - MP) & 3; bs = (m - MP) >> 2; }
        f32x4 acc = ld4(PARP(PAR_CONVB) + o_ * 2048 + ch);
#pragma unroll
        for (int j = 0; j < 4; ++j) { const int ti = t + j - 3; f32x4 x;
            if (ti >= 0) x = (split && m >= MP) ? oddin_sample4(A, m + j - 3, 2048 + ch) : ldp4(XB + (size_t)(m + j - 3) * 2048 + ch);
            else if (bs >= 0) x = ld4(A.in[5] + ((size_t)(bs * 2 + o_) * 3 + (ti + 3)) * 2048 + ch);
            else x = (f32x4){0.f, 0.f, 0.f, 0.f};
            acc += x * ld4(PARP(PAR_CONVW) + (size_t)(o_ * 4 + j) * 2048 + ch); }
        st4bf(XCB + (size_t)m * 2048 + ch, acc);
    }
    if (split) for (int idx = gt; idx < BS * 512; idx += NGT) {
        const int ch = (idx & 511) * 4, bs = idx >> 9, m0 = MP + bs * TS;
        f32x4 xr[7];
#pragma unroll
        for (int i = 0; i < 3; ++i) xr[i] = ld4(A.in[5] + ((size_t)(bs * 2 + o_) * 3 + i) * 2048 + ch);
#pragma unroll
        for (int t = 0; t < 4; ++t) xr[3 + t] = oddin_sample4(A, m0 + t, 2048 + ch);
        const f32x4 cb = ld4(PARP(PAR_CONVB) + o_ * 2048 + ch); f32x4 cw[4];
#pragma unroll
        for (int j = 0; j < 4; ++j) cw[j] = ld4(PARP(PAR_CONVW) + (size_t)(o_ * 4 + j) * 2048 + ch);
#pragma unroll
        for (int t = 0; t < 4; ++t) st4bf(XCB + (size_t)(m0 + t) * 2048 + ch, cb + xr[t] * cw[0] + xr[t + 1] * cw[1] + xr[t + 2] * cw[2] + xr[t + 3] * cw[3]);
#pragma unroll
        for (int i = 0; i < 3; ++i) *(f32x4*)(AOUT + O_SCONV + ((size_t)(bs * 2 + o_) * 3 + i) * 2048 + ch) = xr[4 + i];
    }
    for (int idx = gt; idx < (split ? BP : NSEQ) * 3 * 512; idx += NGT) {
        const int ch = (idx & 511) * 4, r = idx >> 9, i = r % 3, q = r / 3;
        const int T = q < BP ? TP : TS, row0 = q < BP ? q * TP : MP + (q - BP) * TS;
        float* o = AOUT + (q < BP ? O_PCONV + ((size_t)(q * 2 + o_) * 3 + i) * 2048 : O_SCONV + ((size_t)((q - BP) * 2 + o_) * 3 + i) * 2048) + ch;
        *(f32x4*)o = (split && q >= BP) ? oddin_sample4(A, row0 + T - 3 + i, 2048 + ch) : ldp4(XB + (size_t)(row0 + T - 3 + i) * 2048 + ch);
    }
}
__device__ __forceinline__ f32x2 lru_a(const float* LA_, size_t o) { const unsigned w = *(const unsigned*)((const bf16*)LA_ + o); return (f32x2){__expf(bf2f(w & 0xffffu)), __expf(bf2f(w >> 16))}; }
__device__ __forceinline__ f32x2 lru_b(const float* LB_, size_t o) { const unsigned w = *(const unsigned*)((const bf16*)LB_ + o); return (f32x2){bf2f(w & 0xffffu), bf2f(w >> 16)}; }
__device__ __forceinline__ void o4_tail(const Args& A, Frame& F) {
    const float* LA_ = (const float*)(A.ws + WS_LRA); const float* LB_ = (const float*)(A.ws + WS_LRB); float* CP = (float*)(A.ws + WS_CP); float* CHh = (float*)(A.ws + WS_CH);
    __syncthreads();
    const int half = F.tid & 1, cp = (F.tid >> 1) & 63, chunk = F.tid >> 7;
#pragma unroll 1
    for (int L = F.blk; L < 32 * 16; L += F.G) {
        const int pm = L >> 4, pn = L & 15; const int ch = pn * 128 + cp * 2; const int b = pm >> 3, c = (pm & 7) * 4 + chunk;
        f32x2 P = {1.f, 1.f}, H = {0.f, 0.f}; const size_t r0 = (size_t)(pm * 256 + chunk * 64 + half * 32) * 2048 + ch;
#pragma unroll 1
        for (int t0 = 0; t0 < 32; t0 += 8) {
            f32x2 a8[8], b8[8];
#pragma unroll
            for (int q = 0; q < 8; ++q) { a8[q] = lru_a(LA_, r0 + (size_t)(t0 + q) * 2048); b8[q] = lru_b(LB_, r0 + (size_t)(t0 + q) * 2048); }
#pragma unroll
            for (int q = 0; q < 8; ++q) { H = a8[q] * H + b8[q]; P = P * a8[q]; }
        }
        f32x2 Po, Ho; Po.x = __shfl_xor(P.x, 1); Po.y = __shfl_xor(P.y, 1); Ho.x = __shfl_xor(H.x, 1); Ho.y = __shfl_xor(H.y, 1);
        if (half == 0) { *(f32x2*)(CP + (size_t)(b * 32 + c) * 2048 + ch) = P * Po; *(f32x2*)(CHh + (size_t)(b * 32 + c) * 2048 + ch) = Po * H + Ho; }
    }
}
__device__ __forceinline__ void o4_lru_chunks(const Args& A, Frame& F) {
    const float* LA_ = (const float*)(A.ws + WS_LRA); const float* LB_ = (const float*)(A.ws + WS_LRB); float* CP = (float*)(A.ws + WS_CP); float* CHh = (float*)(A.ws + WS_CH);
    const int gt = F.blk * NTHR + F.tid, NGT = F.G * NTHR;
    for (int idx = gt; idx < BP * 32 * 1024; idx += NGT) {
        const int ch = (idx & 1023) * 2, c = (idx >> 10) & 31, b = idx >> 15;
        f32x2 P = {1.f, 1.f}, H = {0.f, 0.f}; const size_t r0 = (size_t)(b * TP + c * 64) * 2048 + ch;
#pragma unroll 1
        for (int t0 = 0; t0 < 64; t0 += 8) {
            f32x2 a8[8], b8[8];
#pragma unroll
            for (int q = 0; q < 8; ++q) { a8[q] = lru_a(LA_, r0 + (size_t)(t0 + q) * 2048); b8[q] = lru_b(LB_, r0 + (size_t)(t0 + q) * 2048); }
#pragma unroll
            for (int q = 0; q < 8; ++q) { H = a8[q] * H + b8[q]; P = P * a8[q]; }
        }
        *(f32x2*)(CP + (size_t)(b * 32 + c) * 2048 + ch) = P; *(f32x2*)(CHh + (size_t)(b * 32 + c) * 2048 + ch) = H;
    }
}
__device__ __forceinline__ void o5_lru_scan(const Args& A, Frame& F, int o_) {
    const float* LA_ = (const float*)(A.ws + WS_LRA); const float* LB_ = (const float*)(A.ws + WS_LRB); const float* CP = (const float*)(A.ws + WS_CP); const float* CHh = (const float*)(A.ws + WS_CH);
    const bf16* GATE = (const bf16*)(A.ws + WS_GATE); bf16* YIN = (bf16*)(A.ws + WS_YIN);
    const int gt = F.blk * NTHR + F.tid, NGT = F.G * NTHR;
    for (int idx = gt; idx < BP * 32 * 1024 + BS * 1024; idx += NGT) {
        int ch, nt_; size_t r0; f32x2 H; float* so = nullptr;
        if (idx < BP * 32 * 1024) {
            ch = (idx & 1023) * 2; const int c = (idx >> 10) & 31, b = idx >> 15; H = (f32x2){0.f, 0.f};
#pragma unroll 1
            for (int cb = 0; cb < c; cb += 8) {
                f32x2 p8[8], h8[8];
#pragma unroll
                for (int q = 0; q < 8; ++q) { const int cc = (cb + q < c) ? cb + q : c - 1; const size_t o = (size_t)(b * 32 + cc) * 2048 + ch; p8[q] = *(const f32x2*)(CP + o); h8[q] = *(const f32x2*)(CHh + o); }
#pragma unroll
                for (int q = 0; q < 8; ++q) if (cb + q < c) H = p8[q] * H + h8[q];
            }
            r0 = (size_t)(b * TP + c * 64) * 2048 + ch; nt_ = 64; if (c == 31) so = AOUT + O_PLRU + (size_t)(b * 2 + o_) * 2048 + ch;
        } else {
            const int r = idx - BP * 32 * 1024; ch = (r & 1023) * 2; const int bs = r >> 10;
            H = *(const f32x2*)(A.in[6] + (size_t)(bs * 2 + o_) * 2048 + ch); r0 = (size_t)(MP + bs * TS) * 2048 + ch; nt_ = TS; so = AOUT + O_SLRU + (size_t)(bs * 2 + o_) * 2048 + ch;
        }
#pragma unroll 1
        for (int t0 = 0; t0 < nt_; t0 += 4) {
            f32x2 a4[4], b4[4]; unsigned g4[4];
#pragma unroll
            for (int q = 0; q < 4; ++q) { const size_t o = r0 + (size_t)(t0 + q) * 2048; a4[q] = lru_a(LA_, o); b4[q] = lru_b(LB_, o);
                if (F.G == 256 && idx >= BP * 32 * 1024) {
                    const int m = (int)(o >> 11); const bf16* sl = (const bf16*)(A.ws + WS_OSLAB) + (size_t)((((m - MP) >> 8) * 16 + (ch >> 8)) * 8) * 65536 + ((m - MP) & 255) * 256 + (ch & 255);
                    unsigned w8[8];
#pragma unroll
                    for (int p = 0; p < 8; ++p) w8[p] = *(const unsigned*)(sl + (size_t)p * 65536);
                    float s0 = 0.f, s1 = 0.f;
#pragma unroll
                    for (int p = 0; p < 8; ++p) { s0 += bf2f(w8[p] & 0xffffu); s1 += bf2f(w8[p] >> 16); }
                    const float rs = ((const float*)(A.ws + WS_RSTD))[m];
                    g4[q] = cvt_pk_bf16(pg8::gelu_tanh(s0 * rs), pg8::gelu_tanh(s1 * rs));
                } else g4[q] = *(const unsigned*)(GATE + o); }
#pragma unroll
            for (int q = 0; q < 4; ++q) { const size_t o = r0 + (size_t)(t0 + q) * 2048; H = a4[q] * H + b4[q];
                *(unsigned*)(YIN + o) = cvt_pk_bf16(H[0] * bf2f(g4[q] & 0xffffu), H[1] * bf2f(g4[q] >> 16)); }
        }
        if (so) *(f32x2*)so = H;
    }
}
#ifndef R1W_SHFL_SCAN
#define R1W_SHFL_SCAN 0
#endif
#ifndef R1W_LDS_TINV
#define R1W_LDS_TINV 1
#endif
#ifndef R1W_MASK
#define R1W_MASK 31
#endif
#define R1O_MASK (31 & ~R1W_MASK)

__device__ __forceinline__ f32x4 mm16(const LAS float* a, int sai, int sak, const LAS float* b, int sbk, int sbj, int K, f32x4 acc, int lane) {
    const int i = lane & 15, g = lane >> 4;
#pragma unroll
    for (int s = 0; s < K / 4; ++s) acc = __builtin_amdgcn_mfma_f32_16x16x4f32(a[i * sai + (4 * s + g) * sak], b[(4 * s + g) * sbk + i * sbj], acc, 0, 0, 0);
    return acc;
}
constexpr int R1_RS = 68, R1_TS = 20, R1_HSZ = 16064;
constexpr int R1_RT = 0, R1_KAP = 1088, R1_BT = 2176, R1_KT = 3264,
              R1_KAPT = 4352, R1_BTT = 5632, R1_KTT = 6912, R1_VVT = 8192, R1_TKT = 9472, R1_W1T = 10752, R1_LKVT = 12032,
              R1_LB = 13312, R1_LK = 13632, R1_MRK = 13952, R1_MRB = 14272, R1_TM = 14592, R1_GAM = 14912, R1_GC = 16000;
__device__ __forceinline__ f32x4 mm4(const LAS float* a, const LAS float* b, f32x4 acc) {
    const f32x4 av = *(const LAS f32x4*)a, bv = *(const LAS f32x4*)b;
#pragma unroll
    for (int s = 0; s < 4; ++s) acc = __builtin_amdgcn_mfma_f32_16x16x4f32(av[s], bv[s], acc, 0, 0, 0);
    return acc;
}
__device__ __forceinline__ v4u pack8(const f32x4& a, const f32x4& b) { v4u o; o.x = cvt_pk_bf16(a[0], a[1]); o.y = cvt_pk_bf16(a[2], a[3]); o.z = cvt_pk_bf16(b[0], b[1]); o.w = cvt_pk_bf16(b[2], b[3]); return o; }

struct R1Raw { f32x4 pr, pk, pv, qr, qk, qv, wd, wa; };
__device__ __forceinline__ void rwkv_r1_load(const Args& A, Frame& F, int b, int h, int cp, R1Raw& r) {
    const bf16* PROJ = (const bf16*)(A.ws + WS_PROJ); const float* WAG = (const float*)(A.ws + WS_WAG);
    const int tt = F.tid >> 4, cg = F.tid & 15, hc = h * 64 + 4 * cg, tabs = cp * 32 + tt; const size_t m = (size_t)b * TP + tabs;
    r.pr = ldp4(PROJ + m * NEV + hc); r.pk = ldp4(PROJ + m * NEV + 1024 + hc); r.pv = ldp4(PROJ + m * NEV + 2048 + hc);
    r.qr = (f32x4){0.f, 0.f, 0.f, 0.f}; r.qk = r.qr; r.qv = r.qr;
    if (tabs > 0) { r.qr = ldp4(PROJ + (m - 1) * NEV + hc); r.qk = ldp4(PROJ + (m - 1) * NEV + 1024 + hc); r.qv = ldp4(PROJ + (m - 1) * NEV + 2048 + hc); }
    r.wd = ld4(WAG + m * NLORA + hc); r.wa = ld4(WAG + m * NLORA + 1024 + hc);
}
__device__ __forceinline__ void rwkv_r1_unit(const Args& A, Frame& F, int e, int b, int h, int cp, const R1Raw& raw) {
    const int tid = F.tid, tt = tid >> 4, cg = tid & 15, ts = tt & 15;
    const int hf = F.wave >> 2, wl = F.wave & 3, lane = F.lane, g = lane >> 4, i = lane & 15;
    LAS float* HS = (LAS float*)F.lds + (tt >> 4) * R1_HSZ;
    LAS float* HM = (LAS float*)F.lds + hf * R1_HSZ;
    const int hc = h * 64 + 4 * cg;
#ifndef R1_REP12
#define R1_REP12 1
#endif
    for (int rp12 = 0; rp12 < R1_REP12; ++rp12) {
    const float* mu = PARP(PAR_MU) + (size_t)e * PRW;
    const f32x4 zr = raw.pr + (raw.qr - raw.pr) * ld4(mu + hc), zk = raw.pk + (raw.qk - raw.pk) * ld4(mu + 1024 + hc), zv = raw.pv + (raw.qv - raw.pv) * ld4(mu + 2048 + hc);
    f32x4 kk = zk * ld4(PARP(PAR_KK) + e * 1024 + hc);
    const float ss = red16((kk[0] * kk[0] + kk[1] * kk[1]) + (kk[2] * kk[2] + kk[3] * kk[3]));
    kk = kk * (1.0f / fmaxf(sqrtf(ss), 1e-12f));
    const f32x4 kp = zk * (1.0f + (raw.wa - 1.0f) * ld4(PARP(PAR_KA) + e * 1024 + hc)), bb = kk * raw.wa;
    *(LAS f32x4*)(HS + R1_GAM + ts * 68 + 4 * cg) = raw.wd;
    {
        const f32x4 rk = ld4(PARP(PAR_RK) + e * 1024 + hc);
        const float bonus = red16((zr[0] * kp[0] * rk[0] + zr[1] * kp[1] * rk[1]) + (zr[2] * kp[2] * rk[2] + zr[3] * kp[3] * rk[3]));
        if (R1O_MASK & 16) *(f32x4*)((float*)(A.ws + WS_WAG) + ((size_t)b * TP + cp * 32 + tt) * NLORA + hc) = zv * bonus;
    }
    __syncthreads();
    {
        f32x4 gm = {1.f, 1.f, 1.f, 1.f}, gp = gm;
#pragma unroll
        for (int j = 0; j < 16; ++j) { const f32x4 wv = *(const LAS f32x4*)(HS + R1_GAM + j * 68 + 4 * cg); if (j <= ts) gm *= wv; if (j < ts) gp *= wv; }
        f32x4 inv;
#pragma unroll
        for (int j = 0; j < 4; ++j) inv[j] = 1.0f / gm[j];
        const f32x4 rt = zr * gm, kap = kk * gp, bt = bb * inv, kt = kp * inv;
        LAS float* pn = HS + ts * R1_RS + 4 * cg;
        *(LAS f32x4*)(pn + R1_RT) = rt; *(LAS f32x4*)(pn + R1_KAP) = kap; *(LAS f32x4*)(pn + R1_BT) = bt; *(LAS f32x4*)(pn + R1_KT) = kt;
        LAS float* pt = HS + (4 * cg) * R1_TS + ts;
#pragma unroll
        for (int j = 0; j < 4; ++j) { pt[R1_KAPT + j * R1_TS] = kap[j]; pt[R1_BTT + j * R1_TS] = bt[j]; pt[R1_KTT + j * R1_TS] = kt[j]; pt[R1_VVT + j * R1_TS] = zv[j]; }
        if (ts == 15) *(LAS f32x4*)(HS + R1_GC + 4 * cg) = gm;
    }
    __syncthreads();
    }
    const f32x4 z4 = {0.f, 0.f, 0.f, 0.f};
#define R1_ROWN(arr_, r_) (HM + (arr_) + (r_) * R1_RS + 16 * g)
#define R1_COLT(arr_, c_) (HM + (arr_) + (c_) * R1_TS + 4 * g)
#define R1_ROWM(arr_, r_) (HM + (arr_) + (r_) * R1_TS + 4 * g)
    {
        const LAS float* a = R1_ROWN((wl < 2) ? R1_KAP : R1_RT, i); const LAS float* bm = R1_ROWN((wl & 1) ? R1_KT : R1_BT, i);
        f32x4 d = z4;
#pragma unroll
        for (int q = 0; q < 4; ++q) d = mm4(a + 4 * q, bm + 4 * q, d);
        LAS float* o = HM + (wl == 0 ? R1_LB : (wl == 1 ? R1_LK : (wl == 2 ? R1_MRB : R1_MRK)));
#pragma unroll
        for (int r = 0; r < 4; ++r) { const int t = 4 * g + r; const bool keep = (wl < 2) ? (i < t) : (i <= t); o[t * R1_TS + i] = keep ? d[r] : 0.f; }
    }
    __syncthreads();
    {
        const f32x4 d = mm4(R1_ROWM(R1_LK, i), R1_COLT(R1_VVT, 16 * wl + i), z4);
        *(LAS f32x4*)(HM + R1_LKVT + (16 * wl + i) * R1_TS + 4 * g) = d;
        if (wl == 0) { float tr[16];
#pragma unroll
            for (int t = 0; t < 16; ++t) { float v = (t == i) ? 1.0f : 0.0f;
#pragma unroll
                for (int j = 0; j < t; ++j) v -= HM[R1_LB + t * R1_TS + j] * tr[j];
                tr[t] = v; HM[R1_TM + t * R1_TS + i] = v; } }
    }
    __syncthreads();
    {
        const f32x4 d1 = mm4(R1_ROWM(R1_TM, i), R1_COLT(R1_KAPT, 16 * wl + i), z4), d2 = mm4(R1_ROWM(R1_TM, i), R1_COLT(R1_LKVT, 16 * wl + i), z4);
        *(LAS f32x4*)(HM + R1_TKT + (16 * wl + i) * R1_TS + 4 * g) = d1; *(LAS f32x4*)(HM + R1_W1T + (16 * wl + i) * R1_TS + 4 * g) = d2;
    }
    __syncthreads();
    {
        const size_t cid = ((size_t)(b * 16 + h) * 128 + cp * 2 + hf);
        const size_t mrow = (size_t)b * TP + cp * 32 + hf * 16;
        {
            const f32x4 d1 = mm4(R1_COLT(R1_VVT, 16 * wl + i), R1_ROWM(R1_MRK, i), z4), d2 = mm4(R1_COLT(R1_W1T, 16 * wl + i), R1_ROWM(R1_MRB, i), z4);
            if (R1O_MASK & 1) *(f32x4*)((float*)(A.ws + WS_OB) + (mrow + i) * 1024 + h * 64 + 16 * wl + 4 * g) = d1 - d2;
        }
        if (wl < 2) {
            f32x4 q[2];
#pragma unroll
            for (int c2 = 0; c2 < 2; ++c2) { const int a = 2 * wl + c2; const f32x4 d = mm4(R1_COLT(R1_TKT, 16 * a + i), R1_ROWM(R1_MRB, i), z4);
                q[c2] = *(const LAS f32x4*)(HM + R1_RT + i * R1_RS + 16 * a + 4 * g) - d; }
            if (R1O_MASK & 2) *(v4u*)((bf16*)(A.ws + WS_RQ) + ((cid * 2 + wl) * 64 + lane) * 8) = pack8(q[0], q[1]);
        }
        const float gci = HM[R1_GC + 16 * wl + i];
#pragma unroll
        for (int kp2 = 0; kp2 < 2; ++kp2) {
            f32x4 q[2];
#pragma unroll
            for (int c2 = 0; c2 < 2; ++c2) { const int a = 2 * kp2 + c2; const f32x4 d = mm4(R1_COLT(R1_TKT, 16 * a + i), R1_COLT(R1_BTT, 16 * wl + i), z4);
#pragma unroll
                for (int r = 0; r < 4; ++r) q[c2][r] = (((a == wl && 4 * g + r == i) ? 1.0f : 0.0f) - d[r]) * gci; }
            if (R1O_MASK & 4) *(v4u*)((bf16*)(A.ws + WS_PST) + (((cid * 4 + wl) * 2 + kp2) * 64 + lane) * 8) = pack8(q[0], q[1]);
        }
        const f32x4 gcr = *(const LAS f32x4*)(HM + R1_GC + 16 * wl + 4 * g);
#pragma unroll
        for (int a = 0; a < 4; ++a) {
            const f32x4 d1 = mm4(R1_COLT(R1_KTT, 16 * wl + i), R1_COLT(R1_VVT, 16 * a + i), z4), d2 = mm4(R1_COLT(R1_BTT, 16 * wl + i), R1_COLT(R1_W1T, 16 * a + i), z4);
            if (R1O_MASK & 8) *(f32x4*)((float*)(A.ws + WS_QST) + (((cid * 4 + a) * 4 + wl) * 64 + lane) * 4) = (d1 - d2) * gcr;
        }
    }
#undef R1_ROWN
#undef R1_COLT
#undef R1_ROWM
    __syncthreads();
}

template <int CTRL> __device__ __forceinline__ float dpp1(float v) {
    return __builtin_bit_cast(float, __builtin_amdgcn_update_dpp(0x3f800000, __builtin_bit_cast(int, v), CTRL, 0xf, 0xf, false)); }
__device__ __forceinline__ f32x4 mmr(const f32x4& av, const f32x4& bv, f32x4 acc) {
#pragma unroll
    for (int s = 0; s < 4; ++s) acc = __builtin_amdgcn_mfma_f32_16x16x4f32(av[s], bv[s], acc, 0, 0, 0);
    return acc;
}
typedef short bf16x4_ __attribute__((ext_vector_type(4)));
__device__ __forceinline__ bf16x4_ tobf4(const f32x4& v) { v2u w; w.x = cvt_pk_bf16(v[0], v[1]); w.y = cvt_pk_bf16(v[2], v[3]); return __builtin_bit_cast(bf16x4_, w); }
constexpr int R1W_LDS = 19200;
constexpr int R1W_GC = 4352, R1W_PARS = 4416;
struct R1WRaw { v2u pr[4], pk[4], pv[4], qr[4], qk[4], qv[4], wd[4], wa[4]; };
__device__ __forceinline__ f32x4 cv4(const v2u w) { return (f32x4){bf2f(w.x & 0xffffu), bf2f(w.x >> 16), bf2f(w.y & 0xffffu), bf2f(w.y >> 16)}; }
__device__ __forceinline__ void rwkv_r1w_load(const Args& A, int lane, int b, int h, int c, R1WRaw& r) {
    const bf16* PROJ = (const bf16*)(A.ws + WS_PROJ); const float* WAG = (const float*)(A.ws + WS_WAG);
    const int g = lane >> 4, i = lane & 15, tabs = c * 16 + i, hc = h * 64 + 4 * g; const size_t m = (size_t)b * TP + tabs, mq = tabs > 0 ? m - 1 : m;
#pragma unroll
    for (int a = 0; a < 4; ++a) { r.pr[a] = *(const v2u*)(PROJ + m * NEV + hc + 16 * a); r.pk[a] = *(const v2u*)(PROJ + m * NEV + 1024 + hc + 16 * a); r.pv[a] = *(const v2u*)(PROJ + m * NEV + 2048 + hc + 16 * a);
        r.qr[a] = *(const v2u*)(PROJ + mq * NEV + hc + 16 * a); r.qk[a] = *(const v2u*)(PROJ + mq * NEV + 1024 + hc + 16 * a); r.qv[a] = *(const v2u*)(PROJ + mq * NEV + 2048 + hc + 16 * a);
        r.wd[a] = *(const v2u*)((const bf16*)WAG + m * NLORA + hc + 16 * a); r.wa[a] = *(const v2u*)((const bf16*)WAG + m * NLORA + 1024 + hc + 16 * a); }
}
__device__ __forceinline__ void rwkv_r1w_unit(const Args& A, Frame& F, int e, int b, int h, int c, const R1WRaw& raw, bool has_next, int nb, int nc, R1WRaw& nraw) {
    const int lane = F.lane, g = lane >> 4, i = lane & 15;
    LAS float* WL = (LAS float*)(F.lds + __builtin_amdgcn_readfirstlane(F.wave) * R1W_LDS);
    float* WAG = (float*)(A.ws + WS_WAG);
    const int tabs = c * 16 + i, hc = h * 64 + 4 * g; const size_t m = (size_t)b * TP + tabs;
    const f32x4 z4 = {0.f, 0.f, 0.f, 0.f};
    const LAS float* PS = WL + R1W_PARS + 4 * g;
    f32x4 zr[4], zk[4], zv[4], wd[4], wa[4];
#pragma unroll
    for (int a = 0; a < 4; ++a) {
        const f32x4 pr = cv4(raw.pr[a]), pk = cv4(raw.pk[a]), pv = cv4(raw.pv[a]);
        f32x4 qr = cv4(raw.qr[a]), qk = cv4(raw.qk[a]), qv = cv4(raw.qv[a]);
        if (tabs == 0) { qr = z4; qk = z4; qv = z4; }
        zr[a] = pr + (qr - pr) * *(const LAS f32x4*)(PS + 16 * a); zk[a] = pk + (qk - pk) * *(const LAS f32x4*)(PS + 64 + 16 * a); zv[a] = pv + (qv - pv) * *(const LAS f32x4*)(PS + 128 + 16 * a);
        { const f32x4 lw = cv4(raw.wd[a]); wd[a] = (f32x4){__expf(lw[0]), __expf(lw[1]), __expf(lw[2]), __expf(lw[3])}; } wa[a] = cv4(raw.wa[a]);
    }
    f32x4 rt[4], kap[4], bt[4], kt[4], gcr[4];
    {
        f32x4 kk[4], kp[4]; float ss = 0.f, bon = 0.f;
#pragma unroll
        for (int a = 0; a < 4; ++a) { kk[a] = zk[a] * *(const LAS f32x4*)(PS + 192 + 16 * a); ss += (kk[a][0] * kk[a][0] + kk[a][1] * kk[a][1]) + (kk[a][2] * kk[a][2] + kk[a][3] * kk[a][3]); }
        ss += __shfl_xor(ss, 16); ss += __shfl_xor(ss, 32);
        const float rn = 1.0f / fmaxf(sqrtf(ss), 1e-12f);
#pragma unroll
        for (int a = 0; a < 4; ++a) { kk[a] = kk[a] * rn; kp[a] = zk[a] * (1.0f + (wa[a] - 1.0f) * *(const LAS f32x4*)(PS + 256 + 16 * a));
            const f32x4 rk = *(const LAS f32x4*)(PS + 320 + 16 * a); const f32x4 t3 = zr[a] * kp[a] * rk; bon += (t3[0] + t3[1]) + (t3[2] + t3[3]); }
        bon += __shfl_xor(bon, 16); bon += __shfl_xor(bon, 32);
        if (R1W_MASK & 16)
#pragma unroll
        for (int a = 0; a < 4; ++a) st4bf((bf16*)WAG + m * NLORA + hc + 16 * a, zv[a] * bon);
#pragma unroll
        for (int a = 0; a < 4; ++a) {
            f32x4 gm, gp;
#if R1W_SHFL_SCAN
            gm = (f32x4){1.f, 1.f, 1.f, 1.f}; gp = gm;
            *(LAS f32x4*)(WL + i * 68 + 16 * a + 4 * g) = wd[a];
#pragma unroll
            for (int j = 0; j < 16; ++j) { const f32x4 wv = *(const LAS f32x4*)(WL + j * 68 + 16 * a + 4 * g); if (j <= i) gm *= wv; if (j < i) gp *= wv; }
#else
#pragma unroll
            for (int r = 0; r < 4; ++r) { float x = wd[a][r]; x *= dpp1<0x111>(x); x *= dpp1<0x112>(x); x *= dpp1<0x114>(x); x *= dpp1<0x118>(x); gm[r] = x; gp[r] = dpp1<0x111>(x); }
#endif
            f32x4 inv;
#pragma unroll
            for (int r = 0; r < 4; ++r) inv[r] = __builtin_amdgcn_rcpf(gm[r]);
            rt[a] = zr[a] * gm; kap[a] = kk[a] * gp; bt[a] = kk[a] * wa[a] * inv; kt[a] = kp[a] * inv;
            if (i == 15) *(LAS f32x4*)(WL + R1W_GC + 16 * a + 4 * g) = gm;
        }
    }
#pragma unroll
    for (int a = 0; a < 4; ++a) { LAS float* pw = WL + i * 68 + 16 * a + 4 * g;
        *(LAS f32x4*)(pw) = zv[a]; *(LAS f32x4*)(pw + 1088) = kap[a]; *(LAS f32x4*)(pw + 2176) = bt[a]; *(LAS f32x4*)(pw + 3264) = kt[a]; }
    f32x4 Lb = z4, Lk = z4, Mrb = z4, Mrk = z4, LbD = z4;
#pragma unroll
    for (int a = 0; a < 4; ++a) { LbD = mmr(kap[a], bt[a], LbD); Lb = mmr(bt[a], kap[a], Lb); Lk = mmr(kt[a], kap[a], Lk); Mrb = mmr(bt[a], rt[a], Mrb); Mrk = mmr(kt[a], rt[a], Mrk); }
#pragma unroll
    for (int r = 0; r < 4; ++r) { const int sc = 4 * g + r; if (!(sc < i)) { Lb[r] = 0.f; Lk[r] = 0.f; } if (!(sc <= i)) { Mrb[r] = 0.f; Mrk[r] = 0.f; } if (!(i < sc)) LbD[r] = 0.f; }
    f32x4 VT[4], KAPT[4], BTT[4], KTT[4]; float gci[4];
#pragma unroll
    for (int a = 0; a < 4; ++a) {
#pragma unroll
        for (int s = 0; s < 4; ++s) { const LAS float* pr_ = WL + (4 * g + s) * 68 + 16 * a + i; VT[a][s] = pr_[0]; KAPT[a][s] = pr_[1088]; BTT[a][s] = pr_[2176]; KTT[a][s] = pr_[3264]; }
        gci[a] = WL[R1W_GC + 16 * a + i]; gcr[a] = *(const LAS f32x4*)(WL + R1W_GC + 16 * a + 4 * g);
    }
    f32x4 LKVT[4];
#pragma unroll
    for (int a = 0; a < 4; ++a) LKVT[a] = mmr(Lk, VT[a], z4);
    f32x4 Trow;
    {
        f32x4 idm;
#pragma unroll
        for (int r = 0; r < 4; ++r) idm[r] = (4 * g + r == i) ? 1.0f : 0.0f;
        const f32x4 L2D = mmr(Lb, LbD, z4), L2r = mmr(LbD, Lb, z4);
        const f32x4 L4D = mmr(L2r, L2D, z4), L4r = mmr(L2D, L2r, z4);
        const f32x4 L8D = mmr(L4r, L4D, z4);
        const f32x4 X1 = mmr(L2D + idm, idm - Lb, z4), X2 = mmr(L4D + idm, X1, z4);
        Trow = mmr(L8D + idm, X2, z4);
    }
    f32x4 TKT[4], W1T[4];
#pragma unroll
    for (int a = 0; a < 4; ++a) { TKT[a] = mmr(Trow, KAPT[a], z4); W1T[a] = mmr(Trow, LKVT[a], z4); }
    __builtin_amdgcn_sched_barrier(0);
    if (has_next) rwkv_r1w_load(A, lane, nb, h, nc, nraw);
    __builtin_amdgcn_sched_barrier(0);
    const size_t cid = (size_t)(b * 16 + h) * 128 + c; const size_t mrow = (size_t)b * TP + c * 16;
#pragma unroll
    for (int wl = 0; wl < 4; ++wl) {
        const f32x4 d1 = mmr(VT[wl], Mrk, z4), d2 = mmr(W1T[wl], Mrb, z4);
        if (R1W_MASK & 1) st4bf((bf16*)(A.ws + WS_OB) + (mrow + i) * 1024 + h * 64 + 16 * wl + 4 * g, d1 - d2);
    }
#pragma unroll
    for (int w2 = 0; w2 < 2; ++w2) {
        const f32x4 q0 = rt[2 * w2] - mmr(TKT[2 * w2], Mrb, z4), q1 = rt[2 * w2 + 1] - mmr(TKT[2 * w2 + 1], Mrb, z4);
        if (R1W_MASK & 2) *(v4u*)((bf16*)(A.ws + WS_RQ) + ((cid * 2 + w2) * 64 + lane) * 8) = pack8(q0, q1);
    }
    bf16x4_ TKb[4], BTb[4], nBTb[4], KTb[4], VTb[4], W1b[4];
#pragma unroll
    for (int a = 0; a < 4; ++a) { TKb[a] = tobf4(TKT[a]); BTb[a] = tobf4(BTT[a]); nBTb[a] = tobf4(z4 - BTT[a]); KTb[a] = tobf4(KTT[a]); VTb[a] = tobf4(VT[a]); W1b[a] = tobf4(W1T[a]); }
#pragma unroll
    for (int wl = 0; wl < 4; ++wl) {
#pragma unroll
        for (int kp2 = 0; kp2 < 2; ++kp2) {
            f32x4 q[2];
#pragma unroll
            for (int c2 = 0; c2 < 2; ++c2) { const int a = 2 * kp2 + c2; const f32x4 d = __builtin_amdgcn_mfma_f32_16x16x16bf16_1k(TKb[a], BTb[wl], z4, 0, 0, 0);
#pragma unroll
                for (int r = 0; r < 4; ++r) q[c2][r] = (((a == wl && 4 * g + r == i) ? 1.0f : 0.0f) - d[r]) * gci[wl]; }
            if (R1W_MASK & 4) *(v4u*)((bf16*)(A.ws + WS_PST) + (((cid * 4 + wl) * 2 + kp2) * 64 + lane) * 8) = pack8(q[0], q[1]);
        }
#pragma unroll
        for (int a = 0; a < 4; ++a) {
            f32x4 d = __builtin_amdgcn_mfma_f32_16x16x16bf16_1k(KTb[wl], VTb[a], z4, 0, 0, 0);
            d = __builtin_amdgcn_mfma_f32_16x16x16bf16_1k(nBTb[wl], W1b[a], d, 0, 0, 0);
            if (R1W_MASK & 8) { const f32x4 qv_ = d * gcr[wl]; v2u qp_; qp_.x = cvt_pk_bf16(qv_[0], qv_[1]); qp_.y = cvt_pk_bf16(qv_[2], qv_[3]);
                *(v2u*)((bf16*)(A.ws + WS_QST) + (((cid * 4 + a) * 4 + wl) * 64 + lane) * 4) = qp_; }
        }
    }
}
__device__ __forceinline__ void rwkv_r1w_phase(const Args& A, Frame& F, int e) {
    const int NGW = F.G * NWAVES, gw = F.blk * NWAVES + F.wave, NU = BP * 16 * 128;
    if (gw >= NU) return;
    const int h = (gw >> 7) & 15;
    {
        LAS float* WL = (LAS float*)(F.lds + __builtin_amdgcn_readfirstlane(F.wave) * R1W_LDS);
        const float* mu = PARP(PAR_MU) + (size_t)e * PRW; const int hl = h * 64 + F.lane;
        const float p0 = mu[hl], p1 = mu[1024 + hl], p2 = mu[2048 + hl], p3 = PARP(PAR_KK)[e * 1024 + hl], p4 = PARP(PAR_KA)[e * 1024 + hl], p5 = PARP(PAR_RK)[e * 1024 + hl];
        __builtin_amdgcn_sched_barrier(0);
        WL[R1W_PARS + F.lane] = p0; WL[R1W_PARS + 64 + F.lane] = p1; WL[R1W_PARS + 128 + F.lane] = p2; WL[R1W_PARS + 192 + F.lane] = p3; WL[R1W_PARS + 256 + F.lane] = p4; WL[R1W_PARS + 320 + F.lane] = p5;
    }
    R1WRaw raw = {}, nraw = {};
    rwkv_r1w_load(A, F.lane, gw >> 11, h, gw & 127, raw);
#pragma unroll 1
    for (int u = gw; u < NU; u += NGW) { asm volatile("" : "+v"(F.lane)); const int un = u + NGW;
        rwkv_r1w_unit(A, F, e, u >> 11, h, u & 127, raw, un < NU, un >> 11, un & 127, nraw); raw = nraw; }
}

#ifndef R2_PF
#define R2_PF 0
#define R2_PF_AHEAD 6
#endif
#if R2_PF
#define R2_PROG(c_) do { if (F.tid == 0) prog[0] = (c_); } while (0)
#else
#define R2_PROG(c_) do { } while (0)
#endif
__device__ __forceinline__ void rwkv_r2_head(const Args& A, Frame& F, int e, int b, int h) {
    typedef short bf16x8 __attribute__((ext_vector_type(8)));
    const int w = F.wave, lane = F.lane, g = lane >> 4, i = lane & 15;
    const size_t cid0 = (size_t)(b * 16 + h) * 128;
    const bf16* PST = (const bf16*)(A.ws + WS_PST); const float* QST = (const float*)(A.ws + WS_QST); const bf16* RQS = (const bf16*)(A.ws + WS_RQ); float* OB = (float*)(A.ws + WS_OB);
#if R2_PF
    LAS volatile int* prog = (LAS volatile int*)(F.lds + 4096);
    if (F.tid == 0) prog[0] = 0;
    __syncthreads();
    if (F.wave >= 4) {
        const int pl = (F.wave - 4) * 64 + lane; unsigned sink = 0;
        const char* base; size_t stride;
        if (pl < 64) { base = (const char*)PST + cid0 * 8192 + pl * 128; stride = 8192; }
        else if (pl < 80) { base = (const char*)RQS + cid0 * 2048 + (pl - 64) * 128; stride = 2048; }
        else if (pl < 208) { base = (const char*)QST + cid0 * 16384 + (pl - 80) * 128; stride = 16384; }
        else { const int r = ((pl - 208) >> 1) & 15, hf = (pl - 208) & 1; base = (const char*)OB + (((size_t)b * TP + r) * 1024 + h * 64) * 4 + hf * 128; stride = 65536; }
#pragma unroll 1
        for (int c0 = 0; c0 < 128; c0 += 8) {
            while (prog[0] + R2_PF_AHEAD < c0) __builtin_amdgcn_s_sleep(8);
            if (pl < 240) { unsigned v[8];
#pragma unroll
                for (int q = 0; q < 8; ++q) v[q] = *(const unsigned*)(base + (size_t)(c0 + q) * stride);
#pragma unroll
                for (int q = 0; q < 8; ++q) sink += v[q]; }
        }
        if (sink == 0x9e3779b9u) prog[1] = (int)sink;
        return;
    }
#else
    if (F.wave >= 4) return;
#endif
    f32x4 S[4];
#pragma unroll
    for (int k = 0; k < 4; ++k) S[k] = (f32x4){0.f, 0.f, 0.f, 0.f};
    struct R2Set { v4u P[4][2], RQ[2]; v2u Q[4], O; };
    R2Set s0 = {}, s1 = {}, s2 = {};
    float* OB2 = (float*)(A.ws + WS_OB2);
#define R2_LOAD(S_, c_) do { const size_t cid_ = cid0 + (c_); \
        _Pragma("unroll") for (int kb_ = 0; kb_ < 4; ++kb_) { _Pragma("unroll") for (int kp_ = 0; kp_ < 2; ++kp_) S_.P[kb_][kp_] = *(const v4u*)(PST + (((cid_ * 4 + kb_) * 2 + kp_) * 64 + lane) * 8); \
            S_.Q[kb_] = *(const v2u*)((const bf16*)QST + (((cid_ * 4 + w) * 4 + kb_) * 64 + lane) * 4); } \
        _Pragma("unroll") for (int kp_ = 0; kp_ < 2; ++kp_) S_.RQ[kp_] = *(const v4u*)(RQS + ((cid_ * 2 + kp_) * 64 + lane) * 8); \
        S_.O = *(const v2u*)((const bf16*)OB + ((size_t)b * TP + (c_) * 16 + i) * 1024 + h * 64 + 16 * w + 4 * g); } while (0)
#define R2_BODY(c_, CUR, NX2) do { R2_PROG(c_); if ((c_) + 2 < 128) R2_LOAD(NX2, (c_) + 2); \
        const v4u s0_ = pack8(S[0], S[1]), s1_ = pack8(S[2], S[3]); \
        const bf16x8 sp0 = __builtin_bit_cast(bf16x8, s0_), sp1 = __builtin_bit_cast(bf16x8, s1_); \
        f32x4 Oc = __builtin_amdgcn_mfma_f32_16x16x32_bf16(sp0, __builtin_bit_cast(bf16x8, CUR.RQ[0]), cv4(CUR.O), 0, 0, 0); \
        Oc = __builtin_amdgcn_mfma_f32_16x16x32_bf16(sp1, __builtin_bit_cast(bf16x8, CUR.RQ[1]), Oc, 0, 0, 0); \
        st4bf((bf16*)OB2 + ((size_t)b * TP + (c_) * 16 + i) * 1024 + h * 64 + 16 * w + 4 * g, Oc); \
        _Pragma("unroll") for (int kb = 0; kb < 4; ++kb) { f32x4 n = cv4(CUR.Q[kb]); \
            n = __builtin_amdgcn_mfma_f32_16x16x32_bf16(__builtin_bit_cast(bf16x8, CUR.P[kb][0]), sp0, n, 0, 0, 0); \
            n = __builtin_amdgcn_mfma_f32_16x16x32_bf16(__builtin_bit_cast(bf16x8, CUR.P[kb][1]), sp1, n, 0, 0, 0); S[kb] = n; } } while (0)
    R2_LOAD(s0, 0); R2_LOAD(s1, 1);
#pragma unroll 1
    for (int c = 0; c < 126; c += 3) { R2_BODY(c, s0, s2); R2_BODY(c + 1, s1, s0); R2_BODY(c + 2, s2, s1); }
    R2_BODY(126, s0, s2); R2_BODY(127, s1, s0);
#undef R2_BODY
#undef R2_LOAD
    float* so = AOUT + O_PRWKV + ((size_t)(b * 2 + e) * 16 + h) * 4096;
#pragma unroll
    for (int kb = 0; kb < 4; ++kb) *(f32x4*)(so + (16 * w + i) * 64 + 16 * kb + 4 * g) = S[kb];
}

__device__ __forceinline__ void rwkv_r2_head_ring(const Args& A, Frame& F, int e, int b, int h) {
    if (F.wave >= 4) return;
    typedef short bf16x8 __attribute__((ext_vector_type(8)));
    const int w = F.wave, lane = F.lane, g = lane >> 4, i = lane & 15;
    const size_t cid0 = (size_t)(b * 16 + h) * 128;
    const bf16* PST = (const bf16*)(A.ws + WS_PST); const bf16* QSTB = (const bf16*)(A.ws + WS_QST); const bf16* RQS = (const bf16*)(A.ws + WS_RQ); const bf16* OB = (const bf16*)(A.ws + WS_OB); bf16* OB2 = (bf16*)(A.ws + WS_OB2);
    LAS unsigned char* ring = F.lds + __builtin_amdgcn_readfirstlane(w) * 32768;
    f32x4 S[4];
#pragma unroll
    for (int k = 0; k < 4; ++k) S[k] = (f32x4){0.f, 0.f, 0.f, 0.f};
    struct R2Reg { v4u RQ[2]; v2u Q[4], O; };
    R2Reg r0 = {}, r1 = {}, r2 = {}, r3 = {};
#define R2R_ISSUE(R_, c_, slot_) do { const size_t cid_ = cid0 + (c_); \
        _Pragma("unroll") for (int j_ = 0; j_ < 8; ++j_) __builtin_amdgcn_global_load_lds((const unsigned*)((const char*)PST + cid_ * 8192 + j_ * 1024 + lane * 16), (LAS unsigned*)(ring + (slot_) * 8192 + j_ * 1024), 16, 0, 0); \
        _Pragma("unroll") for (int kp_ = 0; kp_ < 2; ++kp_) R_.RQ[kp_] = *(const v4u*)(RQS + ((cid_ * 2 + kp_) * 64 + lane) * 8); \
        _Pragma("unroll") for (int kb_ = 0; kb_ < 4; ++kb_) R_.Q[kb_] = *(const v2u*)(QSTB + (((cid_ * 4 + w) * 4 + kb_) * 64 + lane) * 4); \
        R_.O = *(const v2u*)(OB + ((size_t)b * TP + (c_) * 16 + i) * 1024 + h * 64 + 16 * w + 4 * g); } while (0)
#define R2R_BODY(c_, CUR, slot_, NXT, nslot_) do { \
        if ((c_) + 3 < 128) { R2R_ISSUE(NXT, (c_) + 3, nslot_); asm volatile("s_waitcnt vmcnt(45)" ::: "memory"); } else asm volatile("s_waitcnt vmcnt(0)" ::: "memory"); \
        v4u P_[4][2]; \
        _Pragma("unroll") for (int kb = 0; kb < 4; ++kb) { _Pragma("unroll") for (int kp = 0; kp < 2; ++kp) P_[kb][kp] = *(const LAS v4u*)(ring + (slot_) * 8192 + (kb * 2 + kp) * 1024 + lane * 16); } \
        const v4u s0_ = pack8(S[0], S[1]), s1_ = pack8(S[2], S[3]); \
        const bf16x8 sp0 = __builtin_bit_cast(bf16x8, s0_), sp1 = __builtin_bit_cast(bf16x8, s1_); \
        f32x4 Oc = __builtin_amdgcn_mfma_f32_16x16x32_bf16(sp0, __builtin_bit_cast(bf16x8, CUR.RQ[0]), cv4(CUR.O), 0, 0, 0); \
        Oc = __builtin_amdgcn_mfma_f32_16x16x32_bf16(sp1, __builtin_bit_cast(bf16x8, CUR.RQ[1]), Oc, 0, 0, 0); \
        st4bf(OB2 + ((size_t)b * TP + (c_) * 16 + i) * 1024 + h * 64 + 16 * w + 4 * g, Oc); \
        _Pragma("unroll") for (int kb = 0; kb < 4; ++kb) { f32x4 n = cv4(CUR.Q[kb]); \
            n = __builtin_amdgcn_mfma_f32_16x16x32_bf16(__builtin_bit_cast(bf16x8, P_[kb][0]), sp0, n, 0, 0, 0); \
            n = __builtin_amdgcn_mfma_f32_16x16x32_bf16(__builtin_bit_cast(bf16x8, P_[kb][1]), sp1, n, 0, 0, 0); S[kb] = n; } \
        asm volatile("s_waitcnt lgkmcnt(0)" ::: "memory"); } while (0)
    R2R_ISSUE(r0, 0, 0); R2R_ISSUE(r1, 1, 1); R2R_ISSUE(r2, 2, 2);
#pragma unroll 1
    for (int c = 0; c < 128; c += 4) { R2R_BODY(c, r0, 0, r3, 3); R2R_BODY(c + 1, r1, 1, r0, 0); R2R_BODY(c + 2, r2, 2, r1, 1); R2R_BODY(c + 3, r3, 3, r2, 2); }
#undef R2R_BODY
#undef R2R_ISSUE
    float* so = AOUT + O_PRWKV + ((size_t)(b * 2 + e) * 16 + h) * 4096;
#pragma unroll
    for (int kb = 0; kb < 4; ++kb) *(f32x4*)(so + (16 * w + i) * 64 + 16 * kb + 4 * g) = S[kb];
}

struct R3Raw { v2u o4, bv, g4; };
__device__ __forceinline__ void rwkv_r3_load(const Args& A, Frame& F, int b, int h, int cp, R3Raw& r) {
    const float* WAG = (const float*)(A.ws + WS_WAG);
    const int tt = F.tid >> 4, cg = F.tid & 15, hc = h * 64 + 4 * cg; const size_t m = (size_t)b * TP + cp * 32 + tt;
    r.o4 = *(const v2u*)((const bf16*)(A.ws + WS_OB2) + m * 1024 + hc); r.bv = *(const v2u*)((const bf16*)WAG + m * NLORA + hc); r.g4 = *(const v2u*)((const bf16*)WAG + m * NLORA + 2048 + hc);
}
__device__ __forceinline__ void rwkv_r3_finish(const Args& A, Frame& F, int e, int b, int h, int cp, const R3Raw& r) {
    bf16* YIN = (bf16*)(A.ws + WS_YIN);
    const int tt = F.tid >> 4, cg = F.tid & 15, hc = h * 64 + 4 * cg; const size_t m = (size_t)b * TP + cp * 32 + tt;
    const f32x4 o4 = cv4(r.o4);
    const float mean = red16((o4[0] + o4[1]) + (o4[2] + o4[3])) * (1.0f / 64.0f);
    const f32x4 d = o4 - mean;
    const float var = red16((d[0] * d[0] + d[1] * d[1]) + (d[2] * d[2] + d[3] * d[3])) * (1.0f / 64.0f);
    const float rs = 1.0f / sqrtf(var + 64e-5f);
    const f32x4 on = d * rs * ld4(PARP(PAR_LNW) + e * 1024 + hc) + ld4(PARP(PAR_LNB) + e * 1024 + hc) + cv4(r.bv);
    st4bf(YIN + m * D + hc, on * cv4(r.g4));
}

__device__ __forceinline__ void rwkv_sample8(const Args& A, Frame& F, int e, int u8) {
    const int tid = F.tid, hi = tid >> 4, lo = tid & 15, lane = F.lane, wv = F.wave;
    const bf16* PROJ = (const bf16*)(A.ws + WS_PROJ); const float* WAG = (const float*)(A.ws + WS_WAG); bf16* YIN = (bf16*)(A.ws + WS_YIN);
    LAS float* cb = (LAS float*)F.lds; LAS float* ob = cb + 32 * 384;
    const int bs = u8 >> 1, hbase = (u8 & 1) * 8;
    const int hw = hbase + wv; const size_t sidx = ((size_t)(bs * 2 + e) * 16 + hw) * 4096 + lane * 64;
    f32x4 S[16];
#pragma unroll
    for (int q = 0; q < 16; ++q) S[q] = ld4(A.in[3] + sidx + 4 * q);
    {
        const int j = hi >> 2, t = hi & 3, h = hbase + j, hc = h * 64 + 4 * lo; const size_t m = (size_t)(MP + bs * TS + t);
        const float* mu = PARP(PAR_MU) + (size_t)e * PRW;
        const f32x4 pr = ldp4(PROJ + m * NEV + hc), pk = ldp4(PROJ + m * NEV + 1024 + hc), pv = ldp4(PROJ + m * NEV + 2048 + hc);
        f32x4 qr, qk, qv;
        if (t > 0) { qr = ldp4(PROJ + (m - 1) * NEV + hc); qk = ldp4(PROJ + (m - 1) * NEV + 1024 + hc); qv = ldp4(PROJ + (m - 1) * NEV + 2048 + hc); }
        else { const float* sh = A.in[2] + (size_t)(bs * 2 + e) * PRW; qr = ld4(sh + hc); qk = ld4(sh + 1024 + hc); qv = ld4(sh + 2048 + hc); }
        const f32x4 lw_ = ldp4((const bf16*)WAG + m * NLORA + hc), wd = {__expf(lw_[0]), __expf(lw_[1]), __expf(lw_[2]), __expf(lw_[3])}, wa = ldp4((const bf16*)WAG + m * NLORA + 1024 + hc);
        const f32x4 zr = pr + (qr - pr) * ld4(mu + hc), zk = pk + (qk - pk) * ld4(mu + 1024 + hc), zv = pv + (qv - pv) * ld4(mu + 2048 + hc);
        f32x4 kk = zk * ld4(PARP(PAR_KK) + e * 1024 + hc);
        const float ss = red16((kk[0] * kk[0] + kk[1] * kk[1]) + (kk[2] * kk[2] + kk[3] * kk[3]));
        kk = kk * (1.0f / fmaxf(sqrtf(ss), 1e-12f));
        const f32x4 kp = zk * (1.0f + (wa - 1.0f) * ld4(PARP(PAR_KA) + e * 1024 + hc)), bb = kk * wa;
        LAS float* p = cb + hi * 384 + 4 * lo;
        *(LAS f32x4*)(p) = zr; *(LAS f32x4*)(p + 64) = wd; *(LAS f32x4*)(p + 128) = kp; *(LAS f32x4*)(p + 192) = kk; *(LAS f32x4*)(p + 256) = bb; *(LAS f32x4*)(p + 320) = zv;
    }
    __syncthreads();
#pragma unroll 1
    for (int t = 0; t < 4; ++t) {
        const LAS float* p = cb + (wv * 4 + t) * 384; const float vv = p[320 + lane];
        f32x4 a4 = {0.f, 0.f, 0.f, 0.f};
#pragma unroll
        for (int q = 0; q < 16; ++q) a4 += S[q] * *(const LAS f32x4*)(p + 192 + 4 * q);
        const float sa = -((a4[0] + a4[1]) + (a4[2] + a4[3]));
        f32x4 o4 = {0.f, 0.f, 0.f, 0.f};
#pragma unroll
        for (int q = 0; q < 16; ++q) { S[q] = S[q] * *(const LAS f32x4*)(p + 64 + 4 * q) + *(const LAS f32x4*)(p + 256 + 4 * q) * sa + *(const LAS f32x4*)(p + 128 + 4 * q) * vv; o4 += S[q] * *(const LAS f32x4*)(p + 4 * q); }
        ob[(wv * 4 + t) * 64 + lane] = (o4[0] + o4[1]) + (o4[2] + o4[3]);
    }
    {
        float* so = AOUT + O_SRWKV + sidx;
#pragma unroll
        for (int q = 0; q < 16; ++q) *(f32x4*)(so + 4 * q) = S[q];
    }
    __syncthreads();
    {
        const int j = hi >> 2, t = hi & 3, h = hbase + j, hc = h * 64 + 4 * lo; const size_t m = (size_t)(MP + bs * TS + t);
        const f32x4 o4 = *(const LAS f32x4*)(ob + hi * 64 + 4 * lo);
        const float mean = red16((o4[0] + o4[1]) + (o4[2] + o4[3])) * (1.0f / 64.0f);
        const f32x4 d = o4 - mean;
        const float var = red16((d[0] * d[0] + d[1] * d[1]) + (d[2] * d[2] + d[3] * d[3])) * (1.0f / 64.0f);
        const float rs = 1.0f / sqrtf(var + 64e-5f);
        const LAS float* p = cb + hi * 384 + 4 * lo;
        const f32x4 r4 = *(const LAS f32x4*)(p), kp4 = *(const LAS f32x4*)(p + 128), v4 = *(const LAS f32x4*)(p + 320);
        const f32x4 rk = ld4(PARP(PAR_RK) + e * 1024 + hc);
        const float bonus = red16((r4[0] * kp4[0] * rk[0] + r4[1] * kp4[1] * rk[1]) + (r4[2] * kp4[2] * rk[2] + r4[3] * kp4[3] * rk[3]));
        const f32x4 on = d * rs * ld4(PARP(PAR_LNW) + e * 1024 + hc) + ld4(PARP(PAR_LNB) + e * 1024 + hc) + v4 * bonus;
        st4bf(YIN + m * D + hc, on * ldp4((const bf16*)WAG + m * NLORA + 2048 + hc));
    }
    __syncthreads();
}

constexpr int NPH = 61;
#ifndef MK_FUSED
#define MK_FUSED 1
#endif

__global__ void __launch_bounds__(NTHR, 2) mega(Args A) {
    extern __shared__ __attribute__((aligned(16))) unsigned char lds_raw[];
    Frame F; F.lds = (LAS unsigned char*)lds_raw; F.tid = threadIdx.x; F.lane = F.tid & 63; F.wave = __builtin_amdgcn_readfirstlane(F.tid >> 6); F.G = gridDim.x; F.blk = blockIdx.x;
    volatile LAS unsigned* MISC = (volatile LAS unsigned*)(F.lds + MISC_OFF);
    if (F.tid < 32) MISC[F.tid] = 0u;
    __syncthreads();
    const int lo = A.ph_lo, hi = A.ph_hi;
    XcdBarrier bar; bar.bar = (unsigned*)(A.ws + WS_CTL) + CW_BAR + A.li * XCD_BAR_WORDS; bar.x = 0; bar.st = nullptr;
    if (hi - lo > 1) bar = xcd_barrier_post(bar.bar, MISC + 8);
#ifndef SEL_MASK
#define SEL_MASK 0xFFFFFFFFu
#endif
#ifndef REP_MASK
#define REP_MASK 0u
#endif
#ifndef REP_N
#define REP_N 2
#endif
#ifndef FOLD_O4
#define FOLD_O4 1
#endif
#define SITE(n) ((SEL_MASK >> (n)) & 1u)
#define NREP(n) (((REP_MASK >> (n)) & 1u) ? REP_N : 1)
#define PH_BEGIN(n) if (ph >= lo && ph < hi) { asm volatile("" : "+v"(F.tid), "+v"(F.lane), "+s"(F.wave), "+s"(F.blk), "+s"(F.G), "+s"(A.ws), "+s"(A.out)); \
    if (SITE(n)) for (int rep_ = 0; rep_ < NREP(n); ++rep_) { if (rep_) xcd_barrier(bar);
#ifndef BAR_REP
#define BAR_REP 1
#endif
#define PH_END } if (ph + 1 < hi) for (int br_ = 0; br_ < BAR_REP; ++br_) xcd_barrier(bar); } ++ph;
    int ph = 0;
    PH_BEGIN(1) p0_prologue(A, F); PH_END
#pragma nounroll
    for (int l = 0; l < 4; ++l) {
        const int e = l >> 1; const bool even = !(l & 1);
#pragma nounroll
        for (int s = 0; s < 3; ++s) {
            if (s != 1) {
                const int mat = l * 2 + (s >> 1);
                PH_BEGIN(2) {
                    pg8::Gemm g{(const bf16*)(A.ws + WS_X), (const bf16*)(A.ws + WS_WGU) + (size_t)mat * (SZ_WGU / 2), D, D}; pg8::StaticOrder S; S.init(M, 2 * FF, D, F.G, F.blk);
                    pg8::EpiSwiGLU E{(bf16*)(A.ws + WS_H), FF, (const float*)(A.ws + WS_RSTD)};
                    pg8::gemm_phase<pg8::EpiSwiGLU, pg8::StaticOrder, true, true>(F.lds, g, S, E);
                } PH_END
            } else if (even) {
                PH_BEGIN(3) {
                    pg8::Gemm g{(const bf16*)(A.ws + WS_X), (const bf16*)(A.ws + WS_WEVIN) + (size_t)e * (SZ_WEVIN / 2), D, D}; pg8::StaticOrder S; S.init(M, NEV, D, F.G, F.blk);
                    pg8::EpiStoreBf16 E{(bf16*)(A.ws + WS_PROJ), NEV, (const float*)(A.ws + WS_RSTD)};
                    pg8::gemm_phase<pg8::EpiStoreBf16, pg8::StaticOrder, true, true>(F.lds, g, S, E);
                } PH_END
                PH_BEGIN(4) e2_prep(A, F, e); PH_END
                PH_BEGIN(5) {
                    pg8::Gemm g{(const bf16*)(A.ws + WS_LA), (const bf16*)(A.ws + WS_WLORA) + (size_t)e * NLORA * KLORA, KLORA, KLORA}; pg8::LoraOrder S; S.so.init(M, NLORA, KLORA, F.G, F.blk); { int nt4 = 4; asm volatile("" : "+s"(nt4)); S.nt = nt4; }
                    pg8::EpiLora E{(bf16*)(A.ws + WS_WAG), PARP(PAR_W0) + e * 1024, PARP(PAR_A0) + e * 1024};
                    pg8::gemm_phase<pg8::EpiLora, pg8::LoraOrder, true, true>(F.lds, g, S, E);
                } PH_END
#ifndef R1W
#define R1W 1
#endif
#if R1W
                PH_BEGIN(16) {
#if !R1O_MASK
                    rwkv_r1w_phase(A, F, e);
#endif
#if R1O_MASK
                    { R1Raw raw = {}, nraw = {}; if (F.blk < 4096) rwkv_r1_load(A, F, F.blk >> 10, (F.blk >> 6) & 15, F.blk & 63, raw);
                    for (int u = F.blk; u < 4096; u += F.G) { asm volatile("" : "+v"(F.tid), "+v"(F.lane), "+s"(F.wave), "+s"(A.ws)); const int un = u + F.G; if (un < 4096) rwkv_r1_load(A, F, un >> 10, (un >> 6) & 15, un & 63, nraw);
                        rwkv_r1_unit(A, F, e, u >> 10, (u >> 6) & 15, u & 63, raw); raw = nraw; } }
                    xcd_barrier(bar);
                    rwkv_r1w_phase(A, F, e);
#endif
                } PH_END
#else
                PH_BEGIN(16) { R1Raw raw = {}, nraw = {}; if (F.blk < 4096) rwkv_r1_load(A, F, F.blk >> 10, (F.blk >> 6) & 15, F.blk & 63, raw);
                    for (int u = F.blk; u < 4096; u += F.G) { asm volatile("" : "+v"(F.tid), "+v"(F.lane), "+s"(F.wave), "+s"(A.ws)); const int un = u + F.G; if (un < 4096) rwkv_r1_load(A, F, un >> 10, (un >> 6) & 15, un & 63, nraw);
                        rwkv_r1_unit(A, F, e, u >> 10, (u >> 6) & 15, u & 63, raw); raw = nraw; } } PH_END
#endif
                PH_BEGIN(6) {
#ifndef REP_E4A
#define REP_E4A 1
#define REP_E4B 1
#define REP_E4C 1
#define REP_E4D 1
#endif
#ifndef R2_TWICE
#define R2_TWICE 0
#endif
#ifndef R2_ONLY_FIRST_REP
#define R2_ONLY_FIRST_REP 0
#endif
                    if (F.blk < 64 && !(R2_ONLY_FIRST_REP && rep_ > 0)) { rwkv_r2_head(A, F, e, F.blk >> 4, F.blk & 15);
#if R2_TWICE
                        asm volatile("" : "+v"(F.tid), "+v"(F.lane), "+s"(F.wave)); rwkv_r2_head(A, F, e, F.blk >> 4, F.blk & 15);
#endif
                    }
                    {
                        unsigned* ctr = (unsigned*)(A.ws + WS_CTL) + 2048 + 64 * e + 16 * rep_;
                        unsigned nxt = 0;
                        if (F.tid == 0) nxt = __hip_atomic_fetch_add(ctr, 1u, __ATOMIC_RELAXED, __HIP_MEMORY_SCOPE_AGENT);
                        for (;;) {
                            asm volatile("" : "+v"(F.tid), "+v"(F.lane), "+s"(F.wave), "+s"(A.ws));
                            if (F.tid == 0) MISC[16] = nxt;
                            __syncthreads(); const int w = (int)MISC[16]; __syncthreads();
                            if (w >= 2304) break;
                            if (F.tid == 0) nxt = __hip_atomic_fetch_add(ctr, 1u, __ATOMIC_RELAXED, __HIP_MEMORY_SCOPE_AGENT);
                            if (w < 1024) { for (int rq = 0; rq < REP_E4B; ++rq) hgrn_chunk_unit2(A, F, e, w >> 8, (w >> 5) & 7, w & 31); }
                            else if (w < 2048) { for (int rq = 0; rq < REP_E4C; ++rq) hgrn_sample_unit(A, F, e, (w - 1024) >> 3, w & 7); }
                            else rwkv_sample8(A, F, e, w - 2048);
                        }
                    }
                } PH_END
                PH_BEGIN(7) hgrn_state_scan(A, F, e); PH_END
                PH_BEGIN(8) { { HfRaw hr = {}, hn = {}; if (F.blk < 1024) hgrn_finish_load(A, F, F.blk >> 8, (F.blk >> 5) & 7, F.blk & 31, hr);
                    for (int w = F.blk; w < 1024; w += F.G) { asm volatile("" : "+v"(F.tid), "+v"(F.lane), "+s"(F.wave), "+s"(A.ws)); const int wn = w + F.G;
                        hgrn_finish_unit(A, F, e, w >> 8, (w >> 5) & 7, w & 31, hr, wn < 1024, wn >> 8, (wn >> 5) & 7, wn & 31, hn); hr = hn; } }
                    for (int u = F.blk; u < 4096; u += 4 * F.G) {
                        R3Raw r3[4] = {};
#pragma unroll
                        for (int q = 0; q < 4; ++q) { const int uq = u + q * F.G; if (uq < 4096) rwkv_r3_load(A, F, uq >> 10, (uq >> 6) & 15, uq & 63, r3[q]); }
#pragma unroll
                        for (int q = 0; q < 4; ++q) { const int uq = u + q * F.G; if (uq < 4096) rwkv_r3_finish(A, F, e, uq >> 10, (uq >> 6) & 15, uq & 63, r3[q]); }
                    } } PH_END
            } else {
                PH_BEGIN(9) {
                    pg8::Gemm g{(const bf16*)(A.ws + WS_X), (const bf16*)(A.ws + WS_WODIN) + (size_t)e * (SZ_WODIN / 2), D, D}; pg8::OddInOrder S; S.init(F.G, F.blk);
                    pg8::EpiOddIn E{(bf16*)(A.ws + WS_GATE), (bf16*)(A.ws + WS_XB), (const float*)(A.ws + WS_RSTD), (bf16*)(A.ws + WS_OSLAB)};
                    pg8::gemm_phase<pg8::EpiOddIn, pg8::OddInOrder, true, true>(F.lds, g, S, E);
                } PH_END
                PH_BEGIN(10) o2_conv(A, F, e); PH_END
                PH_BEGIN(11) {
                    pg8::Gemm g{(const bf16*)(A.ws + WS_XCB), (const bf16*)(A.ws + WS_WLRU) + (size_t)e * 4096 * 256, 2048, 256}; int nt4 = 4; asm volatile("" : "+s"(nt4)); pg8::LruOrder S{F.G, F.blk, nt4};
                    pg8::EpiLru E{(const bf16*)(A.ws + WS_XCB), (bf16*)(A.ws + WS_LRA), (bf16*)(A.ws + WS_LRB), PARP(PAR_BA) + e * 2048, PARP(PAR_BX) + e * 2048, PARP(PAR_LAM) + e * 2048};
                    pg8::gemm_phase<pg8::EpiLru, pg8::LruOrder, true, true>(F.lds, g, S, E);
#if FOLD_O4
                    o4_tail(A, F);
#endif
                } PH_END
#if FOLD_O4
                PH_BEGIN(13) o5_lru_scan(A, F, e); PH_END
                ph += 3;
#else
                PH_BEGIN(12) o4_lru_chunks(A, F); PH_END
                PH_BEGIN(13) o5_lru_scan(A, F, e); PH_END
                ph += 2;
#endif
            }
            PH_BEGIN(14) {
                const bf16* Ap; const bf16* Bp; int K; float scale;
                if (s != 1) { Ap = (const bf16*)(A.ws + WS_H); K = FF; scale = 0.5f; Bp = (const bf16*)(A.ws + WS_WDN) + (size_t)(l * 2 + (s >> 1)) * (SZ_WDN / 2); }
                else { Ap = (const bf16*)(A.ws + WS_YIN); K = D; scale = 1.0f; Bp = (const bf16*)(A.ws + (even ? WS_WEVOUT : WS_WODOUT)) + (size_t)e * (SZ_WSQ / 2); }
                pg8::Gemm g{Ap, Bp, K, K}; pg8::ResidOrder S; S.init(K, F.G, F.blk);
                const bool fin = (s == 2 && l == 3);
                const float* gnext = s == 0 ? PARP(PAR_MIXN) + l * D : (s == 1 ? PARP(PAR_FFN2N) + l * D : PARP(PAR_FFN1N) + ((l + 1) & 3) * D);
                pg8::EpiResid E{(bf16*)(A.ws + WS_X), D, scale / (float)(NREP(14) * EPI_REP), (float*)(A.ws + WS_SLAB), (bf16*)nullptr, fin ? nullptr : gnext, (float*)(A.ws + WS_SSP)};
                pg8::gemm_phase<pg8::EpiResid, pg8::ResidOrder, true, true>(F.lds, g, S, E);
            } PH_END
            PH_BEGIN(15) {
                const float* gain = s == 0 ? PARP(PAR_MIXN) + l * D : (s == 1 ? PARP(PAR_FFN2N) + l * D : (l < 3 ? PARP(PAR_FFN1N) + (l + 1) * D : PARP(PAR_FINN)));
                const int K = s != 1 ? FF : D, PU = K / 128; const int sf = F.G == 256 ? ((PU / 2) < 16 ? (PU / 2) : 16) : 0;
                if (s == 2 && l == 3) norm_phase(A, F, gain, true, sf, (s != 1 ? 0.5f : 1.0f) / (float)NREP(15)); else rstd_phase(A, F, gain, sf, (s != 1 ? 0.5f : 1.0f) / (float)NREP(15));
            } PH_END
        }
    }
}

extern "C" void kernel_launch(void* const* d_in, const int* in_sizes, int n_in, void* d_out, int out_size, void* d_ws, size_t ws_size, hipStream_t stream) {
    static int grid = 0;
    if (grid == 0) {
        if (n_in != 39 || (size_t)out_size != O_END || ws_size < WS_END) { fprintf(stderr, "kernel_launch: unexpected shapes (n_in %d out %d ws %zu need %zu)\n", n_in, out_size, ws_size, (size_t)WS_END); grid = -1; return; }
        int dev = 0, cus = 0;
        if (hipGetDevice(&dev) != hipSuccess || hipDeviceGetAttribute(&cus, hipDeviceAttributeMultiprocessorCount, dev) != hipSuccess) { grid = -1; return; }
        if (hipFuncSetAttribute((const void*)mega, hipFuncAttributeMaxDynamicSharedMemorySize, LDS_BYTES) != hipSuccess) { fprintf(stderr, "kernel_launch: hipFuncSetAttribute failed\n"); grid = -1; return; }
        int per_cu = 0;
        if (hipOccupancyMaxActiveBlocksPerMultiprocessor(&per_cu, (const void*)mega, NTHR, LDS_BYTES) != hipSuccess || per_cu < 1) fprintf(stderr, "kernel_launch: occupancy query reports %d blocks per CU\n", per_cu);
        (void)hipGetLastError();
        grid = cus;
    }
    if (grid < 0) return;
    (void)hipMemsetAsync((char*)d_ws + WS_CTL, 0, CTL_ZERO_BYTES, stream);
    Args a{};
    for (int i = 0; i < 39; ++i) a.in[i] = (const float*)d_in[i];
    a.out = (GAS float*)d_out; a.ws = (GAS unsigned char*)d_ws; a.li = 0; a.pad = 0;
#if MK_FUSED
    a.ph_lo = 0; a.ph_hi = NPH;
    hipLaunchKernelGGL(mega, dim3(grid), dim3(NTHR), LDS_BYTES, stream, a);
#else
    for (int p = 0; p < NPH; ++p) {
        if (p >= 1 && (((p - 1) % 15) == 8 || ((p - 1) % 15) == 9) && (((p - 1) / 15) & 1)) continue;
        a.ph_lo = p; a.ph_hi = p + 1;
        hipLaunchKernelGGL(mega, dim3(grid), dim3(NTHR), LDS_BYTES, stream, a);
    }
#endif
}
```
